# Optimizing an MI355X kernel written in HIP

```python
import math
import numpy as np
import jax
import jax.numpy as jnp
from jax import lax

D_MODEL = 2048
BATCH = 8
SEQ = 2048
DEPTH = 1

RWKV_HEAD_DIM = 64
RWKV_WIDTH = D_MODEL // 2
RWKV_HEADS = RWKV_WIDTH // RWKV_HEAD_DIM
DECAY_LORA = 64
ICLR_LORA = 64
GATE_LORA = 160
RWKV_GN_EPS = 64e-5

NSA_HEAD_DIM = 64
NSA_WIDTH = D_MODEL // 2
NSA_HEADS = NSA_WIDTH // NSA_HEAD_DIM
NSA_KV_HEADS = 4
NSA_GROUP = NSA_HEADS // NSA_KV_HEADS
NSA_KV_WIDTH = NSA_KV_HEADS * NSA_HEAD_DIM
CMP_BLOCK = 32
CMP_STRIDE = 16
SEL_BLOCK = 64
N_SEL = 8
WINDOW = 512
QUERY_BLOCK = 128

REL_BUCKETS = 32
REL_MAX_DIST = 128

D_FF = 4 * D_MODEL
NORM_EPS = 1e-6
NEG_INF = -1e30
FORCE_SCORE = 1e4

RWKV_COLS = 3 * RWKV_WIDTH + DECAY_LORA + ICLR_LORA + GATE_LORA
NSA_COLS = NSA_WIDTH + 6 * NSA_KV_WIDTH + 3 * NSA_HEADS
MERGE_COLS = 2 * D_MODEL
IN_COLS = RWKV_COLS + NSA_COLS + MERGE_COLS

kernel_name = 'rwkv7_nsa_hybrid_block'


def rms_norm(x, g, eps=NORM_EPS):
    xf = x.astype(jnp.float32)
    y = xf * lax.rsqrt(jnp.mean(xf * xf, axis=-1, keepdims=True) + eps)
    return (y * g.astype(jnp.float32)).astype(x.dtype)


def token_shift(p):
    return jnp.pad(p, ((0, 0), (1, 0), (0, 0)))[:, :-1]


def rel_bucket(rel):
    n = jnp.maximum(rel, 0)
    max_exact = REL_BUCKETS // 2
    nf = jnp.maximum(n, max_exact).astype(jnp.float32)
    large = max_exact + (jnp.log(nf / max_exact) / math.log(REL_MAX_DIST / max_exact)
                         * (REL_BUCKETS - max_exact)).astype(jnp.int32)
    large = jnp.minimum(large, REL_BUCKETS - 1)
    return jnp.where(n < max_exact, n, large)


def masked_softmax(s, mask):
    s = jnp.where(mask, s.astype(jnp.float32), NEG_INF)
    p = jax.nn.softmax(s, axis=-1)
    return jnp.where(mask, p, 0.0)


def cmp_to_sel_matrix(T):
    nc = T // CMP_STRIDE - CMP_BLOCK // CMP_STRIDE + 1
    ns = T // SEL_BLOCK
    cs = np.arange(nc) * CMP_STRIDE
    ss = np.arange(ns) * SEL_BLOCK
    lo = np.maximum(cs[:, None], ss[None, :])
    hi = np.minimum(cs[:, None] + CMP_BLOCK, ss[None, :] + SEL_BLOCK)
    return (np.maximum(hi - lo, 0) / CMP_BLOCK).astype(np.float32)


def compress(x, pe, w1, w2):
    B, T, G, hd = x.shape
    n_sub = CMP_BLOCK // CMP_STRIDE
    nc = T // CMP_STRIDE - n_sub + 1
    sub = x.reshape(B, T // CMP_STRIDE, CMP_STRIDE, G, hd)
    blocks = jnp.concatenate([sub[:, j:j + nc] for j in range(n_sub)], axis=2)
    blocks = blocks + pe[:, None, :]
    flat = jnp.moveaxis(blocks, 3, 2).reshape(B, nc, G, CMP_BLOCK * hd)
    return jax.nn.gelu(flat @ w1) @ w2


def rwkv7_mix(p, mu, w0, w2, a0, a2, g2, k_k, k_a, r_k, ln_w, ln_b):
    B, T, _ = p.shape
    H, N, C = RWKV_HEADS, RWKV_HEAD_DIM, RWKV_WIDTH
    p = (p + (token_shift(p) - p) * mu).astype(jnp.float32)
    cuts = np.cumsum([C, C, C, DECAY_LORA, ICLR_LORA]).tolist()
    r, k, v, xw, xa, xg = jnp.split(p, cuts, axis=-1)
    w = -jax.nn.softplus(-(w0 + jnp.tanh(xw) @ w2)) - 0.5
    a = jax.nn.sigmoid(a0 + xa @ a2)
    g = jax.nn.sigmoid(xg) @ g2
    heads = lambda z: z.reshape(B, T, H, N)
    kk = heads(k * k_k)
    kk = kk / jnp.maximum(jnp.sqrt(jnp.sum(kk * kk, axis=-1, keepdims=True)), 1e-12)
    k = heads(k * (1.0 + (a - 1.0) * k_a))
    r, v, a = heads(r), heads(v), heads(a)
    decay = jnp.exp(-jnp.exp(heads(w)))
    seq = tuple(jnp.moveaxis(z, 1, 0) for z in (r, decay, k, v, -kk, kk * a))

    def step(S, inp):
        r_t, w_t, k_t, v_t, a_t, b_t = inp
        sa = jnp.einsum('bhij,bhj->bhi', S, a_t)
        S = S * w_t[:, :, None, :] + sa[..., None] * b_t[:, :, None, :] + v_t[..., None] * k_t[:, :, None, :]
        return S, jnp.einsum('bhij,bhj->bhi', S, r_t)

    S0 = jnp.zeros((B, H, N, N), jnp.float32)
    _, y = lax.scan(step, S0, seq)
    y = jnp.moveaxis(y, 0, 1)
    mean = jnp.mean(y, axis=-1, keepdims=True)
    var = jnp.mean(jnp.square(y - mean), axis=-1, keepdims=True)
    y = ((y - mean) * lax.rsqrt(var + RWKV_GN_EPS)).reshape(B, T, C) * ln_w + ln_b
    bonus = (jnp.sum(r * k * r_k, axis=-1, keepdims=True) * v).reshape(B, T, C)
    return (y + bonus) * g


def nsa_mix(p, pe_k, w1_k, w2_k, pe_v, w1_v, w2_v, q_g, k_g, rel_bias):
    B, T, _ = p.shape
    G, Hg, hd = NSA_KV_HEADS, NSA_GROUP, NSA_HEAD_DIM
    QB = QUERY_BLOCK
    q = p[..., :NSA_WIDTH].reshape(B, T, G, Hg, hd)
    kv = p[..., NSA_WIDTH:NSA_WIDTH + 6 * NSA_KV_WIDTH].reshape(B, T, 6, G, hd)
    gates = jax.nn.sigmoid(p[..., NSA_WIDTH + 6 * NSA_KV_WIDTH:]).reshape(B, T, G, Hg, 3)
    q = rms_norm(q, q_g) * (hd ** -0.5)
    ns = T // SEL_BLOCK
    kc = rms_norm(compress(kv[:, :, 0], pe_k, w1_k, w2_k), k_g[0])
    vc = compress(kv[:, :, 1], pe_v, w1_v, w2_v)
    nc = kc.shape[1]
    ks = rms_norm(kv[:, :, 2], k_g[1]).reshape(B, ns, SEL_BLOCK, G, hd).transpose(0, 3, 1, 2, 4)
    vs = kv[:, :, 3].reshape(B, ns, SEL_BLOCK, G, hd).transpose(0, 3, 1, 2, 4)
    pad = ((0, 0), (WINDOW, 0), (0, 0), (0, 0))
    kw = jnp.pad(rms_norm(kv[:, :, 4], k_g[2]), pad)
    vw = jnp.pad(kv[:, :, 5], pad)
    table = rel_bias.reshape(REL_BUCKETS, G, Hg)
    table_g = jnp.transpose(table, (1, 0, 2))
    cmp_end = jnp.arange(nc) * CMP_STRIDE + CMP_BLOCK - 1
    sel_m = jnp.asarray(cmp_to_sel_matrix(T))
    k_sel = min(N_SEL, ns)
    b_ix = jnp.arange(B)[:, None, None, None]
    g_ix = jnp.arange(G)[None, :, None, None]
    blk = jnp.arange(ns)

    def query_block(i):
        t0 = i * QB
        t = t0 + jnp.arange(QB)
        qb = lax.dynamic_slice_in_dim(q, t0, QB, axis=1)
        gb = lax.dynamic_slice_in_dim(gates, t0, QB, axis=1)
        rel_c = t[:, None] - cmp_end[None, :]
        bias_c = jnp.transpose(table[rel_bucket(rel_c)], (2, 3, 0, 1))
        s_c = jnp.einsum('btghd,bngd->bghtn', qb, kc) + bias_c
        p_c = masked_softmax(s_c, rel_c >= 0)
        o_c = jnp.einsum('bghtn,bngd->btghd', p_c.astype(vc.dtype), vc)
        imp = jnp.einsum('bghtn,nj->bgtj', p_c, sel_m)
        cur = t[:, None] // SEL_BLOCK
        allowed = blk[None, :] <= cur
        forced = (blk[None, :] == 0) | (blk[None, :] == cur) | (blk[None, :] == cur - 1)
        score = jnp.where(forced, FORCE_SCORE, jnp.where(allowed, imp, -1.0))
        _, idx = lax.top_k(score, k_sel)
        kg = ks[b_ix, g_ix, idx]
        vg = vs[b_ix, g_ix, idx]
        pos = idx[..., None] * SEL_BLOCK + jnp.arange(SEL_BLOCK)
        rel_s = t[None, None, :, None, None] - pos
        bias_s = jnp.moveaxis(table_g[g_ix[..., None], rel_bucket(rel_s)], -1, 2)
        s_s = jnp.einsum('btghd,bgtksd->bghtks', qb, kg) + bias_s
        mask_s = (rel_s >= 0)[:, :, None].reshape(B, G, 1, QB, k_sel * SEL_BLOCK)
        p_s = masked_softmax(s_s.reshape(B, G, Hg, QB, k_sel * SEL_BLOCK), mask_s)
        p_s = p_s.reshape(B, G, Hg, QB, k_sel, SEL_BLOCK).astype(vg.dtype)
        o_s = jnp.einsum('bghtks,bgtksd->btghd', p_s, vg)
        kwb = lax.dynamic_slice_in_dim(kw, t0, QB + WINDOW, axis=1)
        vwb = lax.dynamic_slice_in_dim(vw, t0, QB + WINDOW, axis=1)
        kpos = t0 - WINDOW + jnp.arange(QB + WINDOW)
        rel_w = t[:, None] - kpos[None, :]
        mask_w = (rel_w >= 0) & (rel_w < WINDOW) & (kpos[None, :] >= 0)
        bias_w = jnp.transpose(table[rel_bucket(rel_w)], (2, 3, 0, 1))
        s_w = jnp.einsum('btghd,bsgd->bghts', qb, kwb) + bias_w
        p_w = masked_softmax(s_w, mask_w).astype(vwb.dtype)
        o_w = jnp.einsum('bghts,bsgd->btghd', p_w, vwb)
        return gb[..., 0:1] * o_c + gb[..., 1:2] * o_s + gb[..., 2:3] * o_w

    outs = lax.map(query_block, jnp.arange(T // QB))
    return jnp.moveaxis(outs, 0, 1).reshape(B, T, NSA_WIDTH)


def setup_inputs(seed: int = 0) -> dict:
    key = jax.random.key(seed)
    keys = iter(jax.random.split(key, 40))
    nrm = lambda shape, scale: scale * jax.random.normal(next(keys), shape, jnp.float32)
    L, D, hd = DEPTH, D_MODEL, NSA_HEAD_DIM
    return {
        'x': nrm((BATCH, SEQ, D), 1.0),
        'c': nrm((BATCH, D), 1.0),
        'w_ada': nrm((L, D, 6 * D), 0.5 * D ** -0.5),
        'b_ada': nrm((L, 6 * D), 0.01),
        'norm1_g': 1.0 + nrm((L, D), 0.02),
        'norm2_g': 1.0 + nrm((L, D), 0.02),
        'w_in': nrm((L, D, IN_COLS), D ** -0.5),
        'rwkv_mu': jax.random.uniform(next(keys), (L, RWKV_COLS), jnp.float32),
        'rwkv_w0': jax.random.uniform(next(keys), (L, RWKV_WIDTH), jnp.float32, -6.0, -1.0),
        'rwkv_w2': nrm((L, DECAY_LORA, RWKV_WIDTH), 0.1 * DECAY_LORA ** -0.5),
        'rwkv_a0': nrm((L, RWKV_WIDTH), 0.1),
        'rwkv_a2': nrm((L, ICLR_LORA, RWKV_WIDTH), 0.1 * ICLR_LORA ** -0.5),
        'rwkv_g2': nrm((L, GATE_LORA, RWKV_WIDTH), GATE_LORA ** -0.5),
        'rwkv_k_k': 0.85 + nrm((L, RWKV_WIDTH), 0.05),
        'rwkv_k_a': 1.0 + nrm((L, RWKV_WIDTH), 0.05),
        'rwkv_r_k': nrm((L, RWKV_HEADS, RWKV_HEAD_DIM), 0.1),
        'rwkv_ln_w': 1.0 + nrm((L, RWKV_WIDTH), 0.02),
        'rwkv_ln_b': nrm((L, RWKV_WIDTH), 0.01),
        'cmp_pe_k': nrm((L, CMP_BLOCK, hd), 0.02),
        'cmp_w1_k': nrm((L, CMP_BLOCK * hd, hd), (CMP_BLOCK * hd) ** -0.5),
        'cmp_w2_k': nrm((L, hd, hd), hd ** -0.5),
        'cmp_pe_v': nrm((L, CMP_BLOCK, hd), 0.02),
        'cmp_w1_v': nrm((L, CMP_BLOCK * hd, hd), (CMP_BLOCK * hd) ** -0.5),
        'cmp_w2_v': nrm((L, hd, hd), hd ** -0.5),
        'q_norm_g': 1.0 + nrm((L, hd), 0.02),
        'k_norm_g': 1.0 + nrm((L, 3, hd), 0.02),
        'rel_bias': nrm((REL_BUCKETS, NSA_HEADS), 0.5),
        'w_o_rwkv': nrm((L, RWKV_WIDTH, D), RWKV_WIDTH ** -0.5),
        'w_o_nsa': nrm((L, NSA_WIDTH, D), NSA_WIDTH ** -0.5),
        'w_out': nrm((L, D, D), D ** -0.5),
        'w_up': nrm((L, D, D_FF), D ** -0.5),
        'w_down': nrm((L, D_FF, D), D_FF ** -0.5),
    }


def reference(x, c, w_ada, b_ada, norm1_g, norm2_g, w_in, rwkv_mu, rwkv_w0, rwkv_w2, rwkv_a0, rwkv_a2,
              rwkv_g2, rwkv_k_k, rwkv_k_a, rwkv_r_k, rwkv_ln_w, rwkv_ln_b, cmp_pe_k, cmp_w1_k, cmp_w2_k,
              cmp_pe_v, cmp_w1_v, cmp_w2_v, q_norm_g, k_norm_g, rel_bias, w_o_rwkv, w_o_nsa, w_out,
              w_up, w_down):
    D = D_MODEL
    for l in range(DEPTH):
        mod = jnp.einsum('bd,de->be', jax.nn.silu(c), w_ada[l]) + b_ada[l]
        sh1, sc1, gt1, sh2, sc2, gt2 = jnp.split(mod[:, None, :], 6, axis=-1)
        h = rms_norm(x, norm1_g[l]) * (1.0 + sc1) + sh1
        proj = jnp.einsum('btd,dc->btc', h, w_in[l])
        p_rwkv = proj[..., :RWKV_COLS]
        p_nsa = proj[..., RWKV_COLS:RWKV_COLS + NSA_COLS]
        merge_g = jax.nn.sigmoid(proj[..., RWKV_COLS + NSA_COLS:])
        o_a = rwkv7_mix(p_rwkv, rwkv_mu[l], rwkv_w0[l], rwkv_w2[l], rwkv_a0[l], rwkv_a2[l], rwkv_g2[l],
                        rwkv_k_k[l], rwkv_k_a[l], rwkv_r_k[l], rwkv_ln_w[l], rwkv_ln_b[l]).astype(x.dtype)
        o_b = nsa_mix(p_nsa, cmp_pe_k[l], cmp_w1_k[l], cmp_w2_k[l], cmp_pe_v[l], cmp_w1_v[l], cmp_w2_v[l],
                      q_norm_g[l], k_norm_g[l], rel_bias)
        y_a = o_a @ w_o_rwkv[l]
        y_b = o_b @ w_o_nsa[l]
        mixed = merge_g[..., :D] * y_a + merge_g[..., D:] * y_b
        x = x + gt1 * (mixed @ w_out[l])
        h = rms_norm(x, norm2_g[l]) * (1.0 + sc2) + sh2
        x = x + gt2 * (jnp.square(jax.nn.relu(h @ w_up[l])) @ w_down[l])
    return x
```

```cpp
#include <hip/hip_runtime.h>
#include <cstdio>
#include <cstdint>

#ifndef MK_N_LAUNCHES
#define MK_N_LAUNCHES 1
#endif

#define DI __device__ __forceinline__
#define LAS __attribute__((address_space(3)))
typedef unsigned short bf16_t;
typedef short bf16x8 __attribute__((ext_vector_type(8)));
typedef short s16x4 __attribute__((ext_vector_type(4)));
typedef float f32x2 __attribute__((ext_vector_type(2)));
typedef float f32x4 __attribute__((ext_vector_type(4)));
typedef float f32x16 __attribute__((ext_vector_type(16)));
typedef unsigned u32x2 __attribute__((ext_vector_type(2)));
typedef unsigned u32x4 __attribute__((ext_vector_type(4)));
typedef __bf16 bf16x2_t __attribute__((ext_vector_type(2)));

constexpr int D = 2048, BATCH = 8, T = 2048, M = BATCH * T, DFF = 8192;
constexpr int RW = 1024, RH = 16, HD = 64;
constexpr int NCOLS = 10240;
constexpr int IN_COLS = 10064;
constexpr int NC = 127;
constexpr float NORM_EPS = 1e-6f, GN_EPS = 64e-5f;
constexpr float LOG2E = 1.4426950408889634f;

constexpr size_t MiB = 1u << 20;
constexpr size_t WS_CTL = 0, CTL_ZERO_BYTES = 1 * MiB;
constexpr size_t WS_MOD = 64 * 1024;
constexpr size_t WS_SUMSQ = 512 * 1024;
constexpr size_t WS_C2 = 1 * MiB;
constexpr size_t WS_M2V = WS_C2 + 256 * 1024;
constexpr size_t WS_BIAS = WS_M2V + 64 * 1024;
constexpr size_t WS_CPE = WS_BIAS + 8 * 1024;
constexpr size_t WS_W2T = WS_CPE + 1024;
constexpr size_t WS_A2T = WS_W2T + 128 * 1024;
constexpr size_t WS_G2T = WS_A2T + 128 * 1024;
constexpr size_t WS_CW1K = WS_G2T + 320 * 1024;
constexpr size_t WS_CW1V = WS_CW1K + 256 * 1024;
constexpr size_t WS_CW2K = WS_CW1V + 256 * 1024;
constexpr size_t WS_CW2V = WS_CW2K + 8 * 1024;
constexpr size_t WS_KC = WS_CW2V + 8 * 1024;
constexpr size_t WS_VCT = WS_KC + 512 * 1024;
constexpr size_t WS_BSUM = WS_VCT + 512 * 1024;
constexpr size_t WS_GATES = WS_BSUM + 1 * MiB;
static_assert(WS_GATES + 3 * MiB <= 8 * MiB, "small region");
constexpr size_t WS_WOA = 8 * MiB, WS_WOB = 12 * MiB, WS_WOUT = 16 * MiB, WS_WUP = 24 * MiB, WS_WDOWN = 56 * MiB, WS_WIN = 88 * MiB;
constexpr size_t WS_H = 128 * MiB;
constexpr size_t WS_PR = 192 * MiB, WS_PK = 224 * MiB, WS_PV = 256 * MiB, WS_PQ = 288 * MiB, WS_PKV = 320 * MiB, WS_PMG = 368 * MiB, WS_PMISC = 496 * MiB;
constexpr size_t WS_END = 512 * MiB;
constexpr size_t WS_GRW = 88 * MiB, WS_VST = 120 * MiB, WS_VWT = 128 * MiB;
constexpr size_t DO_OAB = 0;
constexpr size_t WS_STASH = 192 * MiB;
constexpr size_t WS_MIXED = 88 * MiB;
constexpr size_t WS_X1M = 368 * MiB;
constexpr size_t WS_U = 88 * MiB;
static_assert(WS_U + (size_t)M * DFF * 2 <= WS_X1M, "u vs x1m");
constexpr size_t DO_AT = 0, DO_BT = 32 * MiB, DO_KT = 64 * MiB, DO_RT = 96 * MiB;
constexpr size_t WS_VM = 136 * MiB, WS_GL = 168 * MiB;

constexpr int LDS_BYTES = 147456;
constexpr int NTHREADS = 512;

DI float bf2f(unsigned v) { return __uint_as_float(v << 16); }
DI unsigned pk2(float lo, float hi) { f32x2 v = {lo, hi}; bf16x2_t b = __builtin_convertvector(v, bf16x2_t); return __builtin_bit_cast(unsigned, b); }
DI unsigned f2bf(float f) { return pk2(f, 0.f) & 0xffffu; }
DI float lo16(unsigned u) { return __uint_as_float(u << 16); }
DI float hi16(unsigned u) { return __uint_as_float(u & 0xffff0000u); }
DI float wave_sum(float v) {
#pragma unroll
    for (int o = 1; o < 64; o <<= 1) v += __shfl_xor(v, o);
    return v;
}
DI void lds_barrier() { asm volatile("s_waitcnt lgkmcnt(0)\n\ts_barrier" ::: "memory"); }
DI float sigmoidf_(float x) { return __builtin_amdgcn_rcpf(1.f + __expf(-x)); }
template <int CTRL> DI float dpp_mov(float v) { return __builtin_bit_cast(float, __builtin_amdgcn_update_dpp(0, __builtin_bit_cast(int, v), CTRL, 0xf, 0xf, true)); }
DI float swap32_sum(float x) { auto r = __builtin_amdgcn_permlane32_swap(__float_as_uint(x), __float_as_uint(x), false, false); return __uint_as_float(r[0]) + __uint_as_float(r[1]); }
DI float swap32_max(float x) { auto r = __builtin_amdgcn_permlane32_swap(__float_as_uint(x), __float_as_uint(x), false, false); return fmaxf(__uint_as_float(r[0]), __uint_as_float(r[1])); }
DI float wave_sum_dpp(float x);
DI float swap16_sum(float x) { auto r = __builtin_amdgcn_permlane16_swap(__float_as_uint(x), __float_as_uint(x), false, false); return __uint_as_float(r[0]) + __uint_as_float(r[1]); }

DI float wave_sum_dpp(float x) {
    x += dpp_mov<0xB1>(x);
    x += dpp_mov<0x4E>(x);
    x += dpp_mov<0x141>(x);
    x += dpp_mov<0x140>(x);
    return swap32_sum(swap16_sum(x));
}

namespace pg8 {
constexpr int BM = 256, BK = 64, HALF = 128, HTB = HALF * BK * 2, STAGE_BYTES = 8 * HTB, NXCD = 8, WGM = 8;
__host__ __device__ __forceinline__ int lds_byte(int r, int c) { const int st = (r >> 4) * 2 + (c >> 5), rr = r & 15, cc = c & 31, ob = rr * 64 + cc * 2; return st * 1024 + (ob ^ (((ob >> 9) & 1) << 5)); }
__host__ __device__ __forceinline__ void stage_rc(int b, int& R, int& C) { const int st = b / 1024, sb = b % 1024, swz = sb ^ (((sb >> 9) & 1) << 5); R = (st >> 1) * 16 + swz / 64; C = (st & 1) * 32 + (swz % 64) / 2; }
__host__ __device__ __forceinline__ int perm32(int rho) { const int n = rho >> 4, i = rho & 15; return 8 * (i >> 2) + 4 * n + (i & 3); }

struct Unit { int pm, pn, z; };
struct Gemm { const bf16_t* A0; const bf16_t* A1; const bf16_t* B0; const bf16_t* B1; int K; };
struct StaticOrder {
    int nM, nN, nwg, G, c, nz;
    __device__ void init(int M_, int N_, int G_, int c_, int nz_) { nM = M_ / BM; nN = N_ / BM; nwg = nM * nN; G = G_; c = c_; nz = nz_; }
    __device__ bool next(int i, Unit& u) const {
        const int ti = i / nz; u.z = i - ti * nz;
        const long L = (long)ti * G + c; if (L >= nwg) return false;
        int wgid = (int)L; { const int q = nwg / NXCD, r = nwg % NXCD, xcd = wgid % NXCD, off = wgid / NXCD; wgid = (xcd < r ? xcd * (q + 1) : r * (q + 1) + (xcd - r) * q) + off; }
        const int nig = WGM * nN, gid = wgid / nig, fm = gid * WGM, gsz = (nM - fm) < WGM ? (nM - fm) : WGM;
        u.pm = fm + ((wgid % nig) % gsz); u.pn = (wgid % nig) / gsz; return true;
    }
};

template <class Epi, bool ALIGN_EPI, bool SP2>
__device__ __forceinline__ void gemm_phase(LAS unsigned char* lds, const Gemm g, const StaticOrder& S, const Epi& E) {
    const int tid = threadIdx.x, wid = __builtin_amdgcn_readfirstlane(tid >> 6), lane = tid & 63, wr = wid >> 2, wc = wid & 3, fr = lane & 15, fq = lane >> 4;
    const int K = g.K, nt = K / BK;
    unsigned voffA[2], voffB[2];
#pragma unroll
    for (int i = 0; i < 2; ++i) { int R, C; stage_rc(tid * 16 + i * 8192, R, C); const int Rb = Epi::PERM ? ((R & ~31) + perm32(R & 31)) : R;
        voffA[i] = (unsigned)(R * K + C) * 2u; voffB[i] = (unsigned)(Rb * K + C) * 2u; }
    const size_t kstep = (size_t)(BK * 2);
    const size_t hstep = (size_t)HALF * K * 2;
    const size_t tstep = 2 * hstep;
    const unsigned ldsw = (unsigned)wid * 1024u;
    const int aoff = lds_byte(wr * 64 + fr, fq * 8), boff = lds_byte(wc * 32 + fr, fq * 8);
#define PG8_SA(b, h) (((b) * 2 + (h)) * HTB)
#define PG8_SB(b, h) ((4 + (b) * 2 + (h)) * HTB)
#define PG8_STAGE(bufoff, gbase, voff) do { _Pragma("unroll") for (int _i = 0; _i < 2; ++_i) \
        __builtin_amdgcn_global_load_lds((const unsigned*)((const char*)(gbase) + (voff)[_i]), (LAS unsigned*)(lds + (bufoff) + ldsw + _i * 8192), 16, 0, 0); } while (0)
#define PG8_LDA(dst, b, h) do { _Pragma("unroll") for (int m = 0; m < 4; ++m) _Pragma("unroll") for (int k = 0; k < 2; ++k) dst[m][k] = *(const LAS bf16x8*)(lds + PG8_SA(b, h) + aoff + m * 2048 + k * 1024); } while (0)
#define PG8_LDB(dst, b, h) do { _Pragma("unroll") for (int n = 0; n < 2; ++n) _Pragma("unroll") for (int k = 0; k < 2; ++k) dst[n][k] = *(const LAS bf16x8*)(lds + PG8_SB(b, h) + boff + n * 2048 + k * 1024); } while (0)
#define PG8_MMA(ai, bj, At, Bt) do { __builtin_amdgcn_s_setprio(1); _Pragma("unroll") for (int m = 0; m < 4; ++m) _Pragma("unroll") for (int n = 0; n < 2; ++n) _Pragma("unroll") for (int k = 0; k < 2; ++k) \
        acc[ai][bj][m][n] = __builtin_amdgcn_mfma_f32_16x16x32_bf16(Bt[n][k], At[m][k], acc[ai][bj][m][n], 0, 0, 0); __builtin_amdgcn_s_setprio(0); } while (0)
#define PG8_WAIT_V(n) asm volatile("s_waitcnt vmcnt(" #n ")" ::: "memory")
#define PG8_WAIT_L(n) asm volatile("s_waitcnt lgkmcnt(" #n ")" ::: "memory")
#define PG8_BAR __builtin_amdgcn_s_barrier()
#define PG8_SCHED __builtin_amdgcn_sched_barrier(0)
    Unit cur, nxt; int ui = 0;
    if (!S.next(0, cur)) return;
    f32x4 acc[2][2][4][2];
#pragma unroll
    for (int a = 0; a < 2; ++a)
#pragma unroll
        for (int b = 0; b < 2; ++b)
#pragma unroll
            for (int m = 0; m < 4; ++m)
#pragma unroll
                for (int n = 0; n < 2; ++n) acc[a][b][m][n] = (f32x4){0.f, 0.f, 0.f, 0.f};
    bf16x8 At[4][2], B0[2][2], B1[2][2];
    const char* cA = (const char*)(cur.z ? g.A1 : g.A0) + (size_t)cur.pm * tstep; const char* cB = (const char*)(cur.z ? g.B1 : g.B0) + (size_t)cur.pn * tstep;
    if constexpr (SP2) {
        PG8_STAGE(PG8_SB(0, 0), cB, voffB); PG8_STAGE(PG8_SB(0, 1), cB + hstep, voffB); PG8_STAGE(PG8_SA(0, 0), cA, voffA); PG8_STAGE(PG8_SA(0, 1), cA + hstep, voffA);
        if (wr == 1) PG8_BAR;
        PG8_WAIT_V(2); PG8_BAR;
        PG8_STAGE(PG8_SB(1, 0), cB + kstep, voffB); PG8_STAGE(PG8_SA(1, 0), cA + kstep, voffA); PG8_STAGE(PG8_SB(1, 1), cB + hstep + kstep, voffB);
        PG8_WAIT_V(6); PG8_BAR;
    } else {
        PG8_STAGE(PG8_SB(0, 0), cB, voffB); PG8_STAGE(PG8_SA(0, 0), cA, voffA); PG8_STAGE(PG8_SB(0, 1), cB + hstep, voffB); PG8_STAGE(PG8_SA(0, 1), cA + hstep, voffA);
        if (wr == 1) PG8_BAR;
        PG8_WAIT_V(4); PG8_BAR;
        PG8_STAGE(PG8_SB(1, 0), cB + kstep, voffB); PG8_STAGE(PG8_SA(1, 0), cA + kstep, voffA); PG8_STAGE(PG8_SB(1, 1), cB + hstep + kstep, voffB);
        PG8_WAIT_V(6); PG8_BAR;
    }
    for (;;) {
        const bool has_next = S.next(ui + 1, nxt);
        const char* nA = has_next ? (const char*)(nxt.z ? g.A1 : g.A0) + (size_t)nxt.pm * tstep : cA; const char* nB = has_next ? (const char*)(nxt.z ? g.B1 : g.B0) + (size_t)nxt.pn * tstep : cB;
        for (int t = 0; t < nt; t += 2) {
            if constexpr (Epi::MID_T > 0) { if (t == Epi::MID_T) { E.mid(acc, cur, wr, wc, fr, fq); asm volatile("s_waitcnt vmcnt(0)" ::: "memory"); } }
            const bool last = (t == nt - 2);
            const char* a1 = cA + (size_t)(t + 1) * kstep;
            const char* a2 = last ? nA : cA + (size_t)(t + 2) * kstep; const char* b2 = last ? nB : cB + (size_t)(t + 2) * kstep;
            const char* a3 = a2 + kstep; const char* b3 = b2 + kstep;
            if constexpr (SP2) {
            PG8_LDB(B0, 0, 0); PG8_LDB(B1, 0, 1); PG8_SCHED; PG8_LDA(At, 0, 0); PG8_STAGE(PG8_SA(1, 1), a1 + hstep, voffA);
            PG8_WAIT_V(8); PG8_WAIT_L(0); PG8_BAR; PG8_MMA(0, 0, At, B0); PG8_MMA(0, 1, At, B1); PG8_BAR; PG8_SCHED;
            PG8_LDA(At, 0, 1); PG8_STAGE(PG8_SB(0, 0), b2, voffB); PG8_STAGE(PG8_SB(0, 1), b2 + hstep, voffB); PG8_STAGE(PG8_SA(0, 0), a2, voffA);
            PG8_WAIT_V(8); PG8_WAIT_L(0); PG8_BAR; PG8_MMA(1, 0, At, B0); PG8_MMA(1, 1, At, B1); PG8_BAR; PG8_SCHED;
            PG8_LDB(B0, 1, 0); PG8_LDB(B1, 1, 1); PG8_SCHED; PG8_LDA(At, 1, 0); PG8_STAGE(PG8_SA(0, 1), a2 + hstep, voffA);
            PG8_WAIT_V(8); PG8_WAIT_L(0); PG8_BAR; PG8_MMA(0, 0, At, B0); PG8_MMA(0, 1, At, B1); PG8_BAR; PG8_SCHED;
            PG8_LDA(At, 1, 1); PG8_STAGE(PG8_SB(1, 0), b3, voffB); PG8_STAGE(PG8_SB(1, 1), b3 + hstep, voffB); PG8_STAGE(PG8_SA(1, 0), a3, voffA);
            PG8_WAIT_V(8); PG8_WAIT_L(0); PG8_BAR; PG8_MMA(1, 0, At, B0); PG8_MMA(1, 1, At, B1); PG8_BAR; PG8_SCHED;
            } else {
            PG8_LDB(B0, 0, 0); PG8_SCHED; PG8_LDA(At, 0, 0); PG8_STAGE(PG8_SA(1, 1), a1 + hstep, voffA);
            PG8_WAIT_L(8); PG8_BAR; PG8_WAIT_L(0); PG8_MMA(0, 0, At, B0); PG8_BAR; PG8_SCHED;
            PG8_LDB(B1, 0, 1); PG8_STAGE(PG8_SB(0, 0), b2, voffB);
            PG8_BAR; PG8_WAIT_L(0); PG8_MMA(0, 1, At, B1); PG8_BAR;
            PG8_LDA(At, 0, 1); PG8_STAGE(PG8_SA(0, 0), a2, voffA);
            PG8_BAR; PG8_WAIT_L(0); PG8_MMA(1, 0, At, B0); PG8_BAR; PG8_SCHED;
            PG8_STAGE(PG8_SB(0, 1), b2 + hstep, voffB);
            PG8_WAIT_V(6); PG8_BAR; PG8_MMA(1, 1, At, B1); PG8_BAR;
            PG8_LDB(B0, 1, 0); PG8_SCHED; PG8_LDA(At, 1, 0); PG8_STAGE(PG8_SA(0, 1), a2 + hstep, voffA);
            PG8_WAIT_L(8); PG8_BAR; PG8_WAIT_L(0); PG8_MMA(0, 0, At, B0); PG8_BAR; PG8_SCHED;
            PG8_LDB(B1, 1, 1); PG8_STAGE(PG8_SB(1, 0), b3, voffB);
            PG8_BAR; PG8_WAIT_L(0); PG8_MMA(0, 1, At, B1); PG8_BAR;
            PG8_LDA(At, 1, 1); PG8_STAGE(PG8_SA(1, 0), a3, voffA);
            PG8_BAR; PG8_WAIT_L(0); PG8_MMA(1, 0, At, B0); PG8_BAR; PG8_SCHED;
            PG8_STAGE(PG8_SB(1, 1), b3 + hstep, voffB);
            PG8_WAIT_V(6); PG8_BAR; PG8_MMA(1, 1, At, B1); PG8_BAR;
            }
        }
        if constexpr (ALIGN_EPI) { if (wr == 0) PG8_BAR; }
        E(acc, cur, wr, wc, fr, fq);
        if (!has_next) break;
#pragma unroll
        for (int a = 0; a < 2; ++a)
#pragma unroll
            for (int b = 0; b < 2; ++b)
#pragma unroll
                for (int m = 0; m < 4; ++m)
#pragma unroll
                    for (int n = 0; n < 2; ++n) acc[a][b][m][n] = (f32x4){0.f, 0.f, 0.f, 0.f};
        cur = nxt; cA = nA; cB = nB; ++ui;
        if constexpr (ALIGN_EPI) { if (wr == 1) PG8_BAR; }
    }
    PG8_WAIT_V(0);
    if constexpr (!ALIGN_EPI) { if (wr == 0) PG8_BAR; }
    PG8_BAR;
#undef PG8_SA
#undef PG8_SB
#undef PG8_STAGE
#undef PG8_LDA
#undef PG8_LDB
#undef PG8_MMA
#undef PG8_WAIT_V
#undef PG8_WAIT_L
#undef PG8_BAR
#undef PG8_SCHED
}
}
using pg8::Unit; using pg8::HALF; using pg8::BM;
typedef const f32x4 (&AccRef)[2][2][4][2];

template <int MODE> struct EpiInProjT {
    static constexpr bool PERM = true; static constexpr int MID_T = 0;
    unsigned char* ws;
    DI void operator()(AccRef acc, const Unit& u, int wr, int wc, int fr, int fq) const {
        if (MODE == 2) { f32x4 t = {0.f, 0.f, 0.f, 0.f};
#pragma unroll
            for (int ai = 0; ai < 2; ++ai)
#pragma unroll
                for (int bj = 0; bj < 2; ++bj)
#pragma unroll
                    for (int m = 0; m < 4; ++m) { t += acc[ai][bj][m][0]; t += acc[ai][bj][m][1]; }
            if (t[0] + t[1] + t[2] + t[3] == 123.456f) *(float*)ws = 1.f; return; }
        const int pn = u.pn; bf16_t* base; int ld, ct; bool sig = false;
        if (pn < 4) { base = (bf16_t*)(ws + WS_PR); ld = 1024; ct = pn; }
        else if (pn < 8) { base = (bf16_t*)(ws + WS_PK); ld = 1024; ct = pn - 4; }
        else if (pn < 12) { base = (bf16_t*)(ws + WS_PV); ld = 1024; ct = pn - 8; }
        else if (pn < 16) { base = (bf16_t*)(ws + WS_PQ); ld = 1024; ct = pn - 12; }
        else if (pn < 22) { base = (bf16_t*)(ws + WS_PKV); ld = 1536; ct = pn - 16; }
        else if (pn < 38) { base = (bf16_t*)(ws + WS_PMG); ld = 4096; ct = pn - 22; sig = true; }
        else { base = (bf16_t*)(ws + WS_PMISC); ld = 512; ct = pn - 38; }
        const int row0 = u.pm * BM + wr * 64 + fr, col0 = ct * BM + wc * 32 + 8 * fq;
#pragma unroll
        for (int ai = 0; ai < 2; ++ai)
#pragma unroll
            for (int m = 0; m < 4; ++m) { bf16_t* rowp = base + (size_t)(row0 + ai * HALF + m * 16) * ld + col0;
#pragma unroll
                for (int bj = 0; bj < 2; ++bj) { f32x4 v0 = acc[ai][bj][m][0], v1 = acc[ai][bj][m][1];
                    if (sig) {
#pragma unroll
                        for (int e = 0; e < 4; ++e) { v0[e] = sigmoidf_(v0[e]); v1[e] = sigmoidf_(v1[e]); } }
                    u32x4 w; w.x = pk2(v0[0], v0[1]); w.y = pk2(v0[2], v0[3]); w.z = pk2(v1[0], v1[1]); w.w = pk2(v1[2], v1[3]);
                    if (MODE == 0) *(u32x4*)(rowp + bj * HALF) = w; else if (w.x == 0x12345678u && w.w == 0x9abcdef0u) *(u32x4*)(rowp + bj * HALF) = w; } }
    }
};
typedef EpiInProjT<0> EpiInProj;
struct EpiMerge {
    static constexpr bool PERM = true;
    static constexpr int MID_T = 16;
    const bf16_t* mg; bf16_t* mixed;
    DI void mid(f32x4 (&acc)[2][2][4][2], const Unit& u, int wr, int wc, int fr, int fq) const {
        int row0 = u.pm * BM + wr * 64 + fr, col0 = u.pn * BM + wc * 32 + 8 * fq;
        asm volatile("" : "+v"(row0), "+v"(col0));
#pragma unroll
        for (int ai = 0; ai < 2; ++ai)
#pragma unroll
            for (int m = 0; m < 4; ++m) { const size_t row = (size_t)(row0 + ai * HALF + m * 16);
#pragma unroll
                for (int bj = 0; bj < 2; ++bj) { const int col = col0 + bj * HALF;
                    const u32x4 ga = *(const u32x4*)(mg + row * 4096 + col), gb = *(const u32x4*)(mg + row * 4096 + 2048 + col);
#pragma unroll
                    for (int e = 0; e < 4; ++e) { const float s0 = lo16(ga[e]) * __builtin_amdgcn_rcpf(fmaxf(lo16(gb[e]), 1e-20f)), s1 = hi16(ga[e]) * __builtin_amdgcn_rcpf(fmaxf(hi16(gb[e]), 1e-20f));
                        acc[ai][bj][m][e >> 1][2 * (e & 1)] *= s0; acc[ai][bj][m][e >> 1][2 * (e & 1) + 1] *= s1; } }
                __builtin_amdgcn_sched_barrier(0); }
    }
    DI void operator()(AccRef acc, const Unit& u, int wr, int wc, int fr, int fq) const {
        const int row0 = u.pm * BM + wr * 64 + fr, col0 = u.pn * BM + wc * 32 + 8 * fq;
#pragma unroll
        for (int ai = 0; ai < 2; ++ai)
#pragma unroll
            for (int m = 0; m < 4; ++m) { const size_t row = (size_t)(row0 + ai * HALF + m * 16);
#pragma unroll
                for (int bj = 0; bj < 2; ++bj) { const int col = col0 + bj * HALF;
                    const u32x4 gb = *(const u32x4*)(mg + row * 4096 + 2048 + col); u32x4 w;
#pragma unroll
                    for (int e = 0; e < 4; ++e) w[e] = pk2(acc[ai][bj][m][e >> 1][2 * (e & 1)] * fmaxf(lo16(gb[e]), 1e-20f), acc[ai][bj][m][e >> 1][2 * (e & 1) + 1] * fmaxf(hi16(gb[e]), 1e-20f));
                    *(u32x4*)(mixed + row * 2048 + col) = w; } }
    }
};
struct EpiWout {
    static constexpr bool PERM = false; static constexpr int MID_T = 0;
    const float* x; const float* mod; const float* m2v; float* x1; bf16_t* x1m; float* sumsq;
    DI void operator()(AccRef acc, const Unit& u, int wr, int wc, int fr, int fq) const {
        const int row0 = u.pm * BM + wr * 64 + fr, col0 = u.pn * BM + wc * 32 + 4 * fq; const int b = (u.pm * BM) / T;
        const float* gt1 = mod + (size_t)b * 12288 + 4096; const float* mv = m2v + (size_t)b * 2048;
        f32x4 gv[2][2], m2[2][2];
#pragma unroll
        for (int bj = 0; bj < 2; ++bj)
#pragma unroll
            for (int n = 0; n < 2; ++n) { gv[bj][n] = *(const f32x4*)(gt1 + col0 + bj * HALF + n * 16); m2[bj][n] = *(const f32x4*)(mv + col0 + bj * HALF + n * 16); }
        f32x4 xn[2][2];
#pragma unroll
        for (int bj = 0; bj < 2; ++bj)
#pragma unroll
            for (int n = 0; n < 2; ++n) xn[bj][n] = *(const f32x4*)(x + (size_t)row0 * D + col0 + bj * HALF + n * 16);
#pragma unroll
        for (int gi = 0; gi < 8; ++gi) { const int ai = gi >> 2, m = gi & 3; const size_t row = (size_t)(row0 + ai * HALF + m * 16); float ss = 0.f;
            f32x4 xc[2][2];
#pragma unroll
            for (int bj = 0; bj < 2; ++bj)
#pragma unroll
                for (int n = 0; n < 2; ++n) xc[bj][n] = xn[bj][n];
            if (gi < 7) { const size_t rown = (size_t)(row0 + ((gi + 1) >> 2) * HALF + ((gi + 1) & 3) * 16);
#pragma unroll
                for (int bj = 0; bj < 2; ++bj)
#pragma unroll
                    for (int n = 0; n < 2; ++n) xn[bj][n] = *(const f32x4*)(x + rown * D + col0 + bj * HALF + n * 16); }
#pragma unroll
            for (int bj = 0; bj < 2; ++bj)
#pragma unroll
                for (int n = 0; n < 2; ++n) { const int col = col0 + bj * HALF + n * 16;
                    const f32x4 v = xc[bj][n] + gv[bj][n] * acc[ai][bj][m][n];
                    *(f32x4*)(x1 + row * D + col) = v; ss += (v[0] * v[0] + v[1] * v[1]) + (v[2] * v[2] + v[3] * v[3]);
                    const f32x4 vm = v * m2[bj][n]; u32x2 w; w.x = pk2(vm[0], vm[1]); w.y = pk2(vm[2], vm[3]); *(u32x2*)(x1m + row * D + col) = w; }
            ss += __shfl_xor(ss, 16); ss += __shfl_xor(ss, 32);
            if (fq == 0) atomicAdd(sumsq + row, ss);
            __builtin_amdgcn_sched_barrier(0); }
    }
};
struct EpiUp {
    static constexpr bool PERM = true; static constexpr int MID_T = 0;
    const float* sumsq; const float* c2; bf16_t* uo;
    DI void operator()(AccRef acc, const Unit& u, int wr, int wc, int fr, int fq) const {
        const int row0 = u.pm * BM + wr * 64 + fr, col0 = u.pn * BM + wc * 32 + 8 * fq; const int b = (u.pm * BM) / T;
        const float* cb = c2 + (size_t)b * DFF + col0;
        f32x4 cv[2][2];
#pragma unroll
        for (int bj = 0; bj < 2; ++bj)
#pragma unroll
            for (int n = 0; n < 2; ++n) cv[bj][n] = *(const f32x4*)(cb + bj * HALF + 4 * n);
#pragma unroll
        for (int ai = 0; ai < 2; ++ai)
#pragma unroll
            for (int m = 0; m < 4; ++m) { const size_t row = (size_t)(row0 + ai * HALF + m * 16);
                const float rstd = rsqrtf(sumsq[row] * (1.f / D) + NORM_EPS);
#pragma unroll
                for (int bj = 0; bj < 2; ++bj) { f32x4 v0 = acc[ai][bj][m][0] * rstd + cv[bj][0], v1 = acc[ai][bj][m][1] * rstd + cv[bj][1];
#pragma unroll
                    for (int e = 0; e < 4; ++e) { const float a0 = fmaxf(v0[e], 0.f), a1 = fmaxf(v1[e], 0.f); v0[e] = a0 * a0; v1[e] = a1 * a1; }
                    u32x4 w; w.x = pk2(v0[0], v0[1]); w.y = pk2(v0[2], v0[3]); w.z = pk2(v1[0], v1[1]); w.w = pk2(v1[2], v1[3]);
                    *(u32x4*)(uo + row * DFF + col0 + bj * HALF) = w; } }
    }
};
struct EpiDown {
    static constexpr bool PERM = false; static constexpr int MID_T = 0;
    const float* mod; float* out;
    DI void operator()(AccRef acc, const Unit& u, int wr, int wc, int fr, int fq) const {
        const int row0 = u.pm * BM + wr * 64 + fr, col0 = u.pn * BM + wc * 32 + 4 * fq; const int b = (u.pm * BM) / T;
        const float* gt2 = mod + (size_t)b * 12288 + 10240;
        f32x4 gv[2][2];
#pragma unroll
        for (int bj = 0; bj < 2; ++bj)
#pragma unroll
            for (int n = 0; n < 2; ++n) gv[bj][n] = *(const f32x4*)(gt2 + col0 + bj * HALF + n * 16);
        f32x4 xn[2][2];
#pragma unroll
        for (int bj = 0; bj < 2; ++bj)
#pragma unroll
            for (int n = 0; n < 2; ++n) xn[bj][n] = *(const f32x4*)(out + (size_t)row0 * D + col0 + bj * HALF + n * 16);
#pragma unroll
        for (int gi = 0; gi < 8; ++gi) { const int ai = gi >> 2, m = gi & 3; const size_t row = (size_t)(row0 + ai * HALF + m * 16);
            f32x4 xc[2][2];
#pragma unroll
            for (int bj = 0; bj < 2; ++bj)
#pragma unroll
                for (int n = 0; n < 2; ++n) xc[bj][n] = xn[bj][n];
            if (gi < 7) { const size_t rown = (size_t)(row0 + ((gi + 1) >> 2) * HALF + ((gi + 1) & 3) * 16);
#pragma unroll
                for (int bj = 0; bj < 2; ++bj)
#pragma unroll
                    for (int n = 0; n < 2; ++n) xn[bj][n] = *(const f32x4*)(out + rown * D + col0 + bj * HALF + n * 16); }
#pragma unroll
            for (int bj = 0; bj < 2; ++bj)
#pragma unroll
                for (int n = 0; n < 2; ++n) *(f32x4*)(out + row * D + col0 + bj * HALF + n * 16) = xc[bj][n] + gv[bj][n] * acc[ai][bj][m][n];
            __builtin_amdgcn_sched_barrier(0); }
    }
};

struct Args { const float* in[32]; float* out; unsigned char* ws; int ph_lo, ph_hi; };
struct Frame {
    unsigned char* lds; LAS unsigned char* lds3;
    int tid, lane, wave, gw, NGW, G, blk;
    const float* const* in; float* out; unsigned char* ws;
};
#define LDS_WAIT() asm volatile("s_waitcnt lgkmcnt(0)" ::: "memory")

DI int win_map(int n) {
    if (n < 3072) return n;
    if (n < 4096) return 3360 + (n - 3072);
    if (n < 5632) return 4384 + (n - 4096);
    if (n < 9728) return 5968 + (n - 5632);
    if (n < 10016) return 3072 + (n - 9728);
    if (n < 10064) return 5920 + (n - 10016);
    return -1;
}
DI void transpose_item(const float* __restrict__ W, int ldW, int K, bf16_t* __restrict__ WT, int ldT, int k0, int n0, bool wmap, unsigned* scr, int lane) {
    const int n4 = lane & 15, kq = lane >> 4; const int nn = n0 + 4 * n4; const int src = wmap ? win_map(nn) : nn;
    f32x4 v[16];
#pragma unroll
    for (int i = 0; i < 16; ++i) { const int k = k0 + 8 * (i >> 1) + 2 * kq + (i & 1);
        v[i] = (f32x4){0.f, 0.f, 0.f, 0.f}; if (src >= 0 && k < K) v[i] = *(const f32x4*)(W + (size_t)k * ldW + src); }
#pragma unroll
    for (int p = 0; p < 8; ++p)
#pragma unroll
        for (int e = 0; e < 4; ++e) scr[(4 * n4 + e) * 33 + 4 * p + kq] = pk2(v[2 * p][e], v[2 * p + 1][e]);
    LDS_WAIT(); asm volatile("" ::: "memory");
    const int c = lane & 7;
    if (k0 + 8 * c < K) {
#pragma unroll
        for (int j = 0; j < 8; ++j) { const int n = (lane >> 3) + 8 * j; const unsigned* sp = scr + n * 33 + 4 * c;
            *(u32x4*)(WT + (size_t)(n0 + n) * ldT + k0 + 8 * c) = (u32x4){sp[0], sp[1], sp[2], sp[3]}; }
    }
    LDS_WAIT(); asm volatile("" ::: "memory");
}
DI int rel_bucket_dev(int rel) {
    if (rel < 16) return rel;
    const int thr[15] = {19, 21, 24, 27, 31, 35, 40, 46, 52, 59, 67, 77, 87, 99, 113};
    int bkt = 16;
#pragma unroll
    for (int i = 0; i < 15; ++i) bkt += (rel >= thr[i]) ? 1 : 0;
    return bkt;
}
DI void phase_a(Frame& F, bool first) {
    unsigned* scr = (unsigned*)(F.lds + F.wave * 8448);
    float* sc = (float*)(F.lds + 73728);
    const float* c = F.in[1];
    for (int i = F.tid; i < BATCH * D; i += NTHREADS) { const int b = i >> 11, d = i & 2047; const float cv = c[i]; sc[d * 8 + b] = cv / (1.f + __expf(-cv)); }
    __syncthreads();
    if (first) {
        const float* w_ada = F.in[2]; const float* b_ada = F.in[3]; float* mod = (float*)(F.ws + WS_MOD);
        for (int item = F.gw; item < 1536; item += F.NGW) {
            const int cgi = item % 48, ds = item / 48, c0 = 256 * cgi + 4 * F.lane, d0 = 64 * ds;
            f32x4 acc[8];
#pragma unroll
            for (int b = 0; b < 8; ++b) acc[b] = (f32x4){0.f, 0.f, 0.f, 0.f};
#pragma unroll 8
            for (int d = d0; d < d0 + 64; ++d) {
                const f32x4 wv = *(const f32x4*)(w_ada + (size_t)d * 12288 + c0);
                const f32x4 s0 = *(const f32x4*)(sc + d * 8), s1 = *(const f32x4*)(sc + d * 8 + 4);
                acc[0] += s0[0] * wv; acc[1] += s0[1] * wv; acc[2] += s0[2] * wv; acc[3] += s0[3] * wv;
                acc[4] += s1[0] * wv; acc[5] += s1[1] * wv; acc[6] += s1[2] * wv; acc[7] += s1[3] * wv;
            }
            f32x4 bv = (f32x4){0.f, 0.f, 0.f, 0.f}; if (ds == 0) bv = *(const f32x4*)(b_ada + c0);
#pragma unroll
            for (int b = 0; b < 8; ++b)
#pragma unroll
                for (int e = 0; e < 4; ++e) atomicAdd(mod + (size_t)b * 12288 + c0 + e, acc[b][e] + bv[e]);
        }
    }
    {
        struct MatD { const float* W; int ldW, K; size_t off; int ldT, nblk, kblk; bool wmap; };
        const MatD mats[13] = {
            {F.in[6], IN_COLS, 2048, WS_WIN, 2048, NCOLS / 64, 32, true},
            {F.in[27], 2048, 1024, WS_WOA, 2048, 32, 16, false},
            {F.in[28], 2048, 1024, WS_WOA + 2048, 2048, 32, 16, false},
            {F.in[29], 2048, 2048, WS_WOUT, 2048, 32, 32, false},
            {F.in[30], 8192, 2048, WS_WUP, 2048, 128, 32, false},
            {F.in[31], 2048, 8192, WS_WDOWN, 8192, 32, 128, false},
            {F.in[9], 1024, 64, WS_W2T, 64, 16, 1, false},
            {F.in[11], 1024, 64, WS_A2T, 64, 16, 1, false},
            {F.in[12], 1024, 160, WS_G2T, 160, 16, 3, false},
            {F.in[19], 64, 2048, WS_CW1K, 2048, 1, 32, false},
            {F.in[22], 64, 2048, WS_CW1V, 2048, 1, 32, false},
            {F.in[20], 64, 64, WS_CW2K, 64, 1, 1, false},
            {F.in[23], 64, 64, WS_CW2V, 64, 1, 1, false}};
        int total = 0;
#pragma unroll
        for (int i = 0; i < 13; ++i) total += mats[i].nblk * mats[i].kblk;
        for (int it = F.gw; it < total; it += F.NGW) {
            int r = it, mi = 0;
#pragma unroll
            for (int i = 0; i < 12; ++i) { const int cnt = mats[i].nblk * mats[i].kblk; if (mi == i && r >= cnt) { r -= cnt; mi = i + 1; } }
            const float* W = mats[0].W; int ldW = mats[0].ldW, K = mats[0].K, ldT = mats[0].ldT, nblk = mats[0].nblk; size_t off = mats[0].off; bool wm = mats[0].wmap;
#pragma unroll
            for (int i = 1; i < 13; ++i) if (mi == i) { W = mats[i].W; ldW = mats[i].ldW; K = mats[i].K; ldT = mats[i].ldT; nblk = mats[i].nblk; off = mats[i].off; wm = mats[i].wmap; }
            const int kb = r / nblk, nb = r % nblk;
            transpose_item(W, ldW, K, (bf16_t*)(F.ws + off), ldT, 64 * kb, 64 * nb, wm, scr, F.lane);
        }
    }
    const int gt = F.blk * NTHREADS + F.tid;
    if (gt < 2048) { const int hq = gt >> 7, rel = gt & 127; const float* rb = F.in[26];
        ((float*)(F.ws + WS_BIAS))[gt] = rb[rel_bucket_dev(rel) * 16 + hq] - rb[31 * 16 + hq]; }
    if (gt >= 4096 && gt < 4096 + 2048) { const int i = gt - 4096, b = i >> 8, e = i & 255; ((bf16_t*)(F.ws + WS_KC))[((size_t)(b * 128 + 127)) * 256 + e] = 0; }
    if (gt >= 8192 && gt < 8192 + 2048) { const int i = gt - 8192; ((bf16_t*)(F.ws + WS_VCT))[(size_t)i * 128 + 127] = 0; }
    if (F.gw == F.NGW - 1 || F.gw == F.NGW - 2) {
        const int kv = (F.gw == F.NGW - 1) ? 0 : 1; const float* pe = F.in[kv ? 21 : 18]; const float* w1 = F.in[kv ? 22 : 19];
        float a = 0.f;
        for (int k = 0; k < 2048; ++k) a += pe[k] * w1[(size_t)k * 64 + F.lane];
        ((float*)(F.ws + WS_CPE))[kv * 64 + F.lane] = a;
    }
}

DI void phase_b(Frame& F) {
    const float* mod = (const float*)(F.ws + WS_MOD);
    const float* x = F.in[0]; const float* g1 = F.in[4]; const float* g2 = F.in[5];
    bf16_t* H = (bf16_t*)(F.ws + WS_H);
    float* sh2 = (float*)F.lds;
    for (int i = F.tid; i < BATCH * D; i += NTHREADS) { const int b = i >> 11, d = i & 2047; sh2[i] = mod[(size_t)b * 12288 + 6144 + d]; }
    __syncthreads();
    for (int m0 = F.gw * 8; m0 < M; m0 += F.NGW * 8) {
        const int b = m0 / T; const float* mb = mod + (size_t)b * 12288;
        f32x4 cf[8], sh[8], v[8], vn[8];
#pragma unroll
        for (int j = 0; j < 8; ++j) { const int col = 4 * F.lane + 256 * j; vn[j] = *(const f32x4*)(x + (size_t)m0 * D + col);
            cf[j] = *(const f32x4*)(g1 + col) * (1.f + *(const f32x4*)(mb + 2048 + col)); sh[j] = *(const f32x4*)(mb + col); }
#pragma unroll 1
        for (int k = 0; k < 8; ++k) { const int m = m0 + k;
#pragma unroll
            for (int j = 0; j < 8; ++j) v[j] = vn[j];
            const int mn = (k < 7) ? m + 1 : m;
#pragma unroll
            for (int j = 0; j < 8; ++j) vn[j] = *(const f32x4*)(x + (size_t)mn * D + 4 * F.lane + 256 * j);
            float ss = 0.f;
#pragma unroll
            for (int j = 0; j < 8; ++j) ss += (v[j][0] * v[j][0] + v[j][1] * v[j][1]) + (v[j][2] * v[j][2] + v[j][3] * v[j][3]);
            const float rstd = rsqrtf(wave_sum_dpp(ss) * (1.f / D) + NORM_EPS);
#pragma unroll
            for (int j = 0; j < 8; ++j) { const int col = 4 * F.lane + 256 * j;
                const f32x4 o = (v[j] * rstd) * cf[j] + sh[j];
                u32x2 w; w.x = pk2(o[0], o[1]); w.y = pk2(o[2], o[3]); *(u32x2*)(H + (size_t)m * D + col) = w; }
        }
    }
    for (int i = F.blk * NTHREADS + F.tid; i < BATCH * D; i += F.G * NTHREADS) { const int b = i >> 11, d = i & 2047;
        ((float*)(F.ws + WS_M2V))[i] = g2[d] * (1.f + mod[(size_t)b * 12288 + 8192 + d]); }
    const bf16_t* wup = (const bf16_t*)(F.ws + WS_WUP); float* c2 = (float*)(F.ws + WS_C2);
    for (int n = F.gw; n < DFF; n += F.NGW) {
        u32x4 wv[4];
#pragma unroll
        for (int j = 0; j < 4; ++j) wv[j] = *(const u32x4*)(wup + (size_t)n * D + 8 * F.lane + 512 * j);
#pragma unroll 1
        for (int b = 0; b < 8; ++b) { float p = 0.f;
#pragma unroll
            for (int j = 0; j < 4; ++j) { const float* s = sh2 + b * 2048 + 8 * F.lane + 512 * j; const f32x4 s0 = *(const f32x4*)s, s1 = *(const f32x4*)(s + 4);
                p += lo16(wv[j].x) * s0[0] + hi16(wv[j].x) * s0[1] + lo16(wv[j].y) * s0[2] + hi16(wv[j].y) * s0[3]
                   + lo16(wv[j].z) * s1[0] + hi16(wv[j].z) * s1[1] + lo16(wv[j].w) * s1[2] + hi16(wv[j].w) * s1[3]; }
            p = wave_sum_dpp(p); if (F.lane == 0) c2[(size_t)b * DFF + n] = p; }
    }
}

DI f32x4 mfma16(bf16x8 a, bf16x8 b, f32x4 c) { return __builtin_amdgcn_mfma_f32_16x16x32_bf16(a, b, c, 0, 0, 0); }
DI f32x16 mfma32(bf16x8 a, bf16x8 b, f32x16 c) { return __builtin_amdgcn_mfma_f32_32x32x16_bf16(a, b, c, 0, 0, 0); }
DI float fast_tanh(float x) { const float xc = fminf(fmaxf(x, -15.f), 15.f); const float t = __expf(2.f * xc); return (t - 1.f) * __builtin_amdgcn_rcpf(t + 1.f); }
DI float gelu_tanh(float x) { const float u = 0.7978845608028654f * (x + 0.044715f * x * x * x); return 0.5f * x * (1.f + fast_tanh(u)); }
DI float softplusf_(float x) { return fmaxf(x, 0.f) + __logf(1.f + __expf(-fabsf(x))); }
DI unsigned short f2h(float f) { return __builtin_bit_cast(unsigned short, (_Float16)f); }
DI float h2f(unsigned short u) { return (float)__builtin_bit_cast(_Float16, u); }

DI void compress_pair(Frame& F, int pair) {
    const int grp = F.wave >> 2, wq = F.wave & 3, it = 2 * pair + grp;
    const int kv = it >> 8, r_ = it & 255, b = r_ >> 5, g = (r_ >> 3) & 3, nb = r_ & 7;
    const int m = F.lane & 15, q = F.lane >> 4, n = 16 * nb + m; const bool nvalid = n < NC;
    const bf16_t* PKV = (const bf16_t*)(F.ws + WS_PKV);
    const bf16_t* xbase = PKV + (size_t)(b * T + 16 * n) * 1536 + kv * 256 + g * 64;
    const bf16_t* w1t = (const bf16_t*)(F.ws + (kv ? WS_CW1V : WS_CW1K));
    const bf16_t* w2t = (const bf16_t*)(F.ws + (kv ? WS_CW2V : WS_CW2K));
    const float* cpe = (const float*)(F.ws + WS_CPE) + kv * 64;
    f32x4* part = (f32x4*)F.lds;
    f32x4 acc[4];
#pragma unroll
    for (int i = 0; i < 4; ++i) acc[i] = (f32x4){0.f, 0.f, 0.f, 0.f};
#pragma unroll 4
    for (int ks = 16 * wq; ks < 16 * wq + 16; ++ks) {
        const int k = 32 * ks + 8 * q, tok = k >> 6, d = k & 63;
        bf16x8 bfr = (bf16x8){0, 0, 0, 0, 0, 0, 0, 0};
        if (nvalid) bfr = *(const bf16x8*)(xbase + (size_t)tok * 1536 + d);
#pragma unroll
        for (int ht = 0; ht < 4; ++ht) { const bf16x8 afr = *(const bf16x8*)(w1t + (size_t)(16 * ht + m) * 2048 + k); acc[ht] = mfma16(afr, bfr, acc[ht]); }
    }
#pragma unroll
    for (int ht = 0; ht < 4; ++ht) part[((grp * 4 + wq) * 4 + ht) * 64 + F.lane] = acc[ht];
    __syncthreads();
    if (wq == 0) {
#pragma unroll
        for (int ht = 0; ht < 4; ++ht) { acc[ht] = (part[((grp * 4 + 0) * 4 + ht) * 64 + F.lane] + part[((grp * 4 + 1) * 4 + ht) * 64 + F.lane]) + (part[((grp * 4 + 2) * 4 + ht) * 64 + F.lane] + part[((grp * 4 + 3) * 4 + ht) * 64 + F.lane]);
            const f32x4 cp = *(const f32x4*)(cpe + 16 * ht + 4 * q);
#pragma unroll
            for (int e = 0; e < 4; ++e) acc[ht][e] = gelu_tanh(acc[ht][e] + cp[e]); }
        f32x4 out[4];
#pragma unroll
        for (int i = 0; i < 4; ++i) out[i] = (f32x4){0.f, 0.f, 0.f, 0.f};
#pragma unroll
        for (int kk2 = 0; kk2 < 2; ++kk2) {
            u32x4 bw; bw.x = pk2(acc[2 * kk2][0], acc[2 * kk2][1]); bw.y = pk2(acc[2 * kk2][2], acc[2 * kk2][3]); bw.z = pk2(acc[2 * kk2 + 1][0], acc[2 * kk2 + 1][1]); bw.w = pk2(acc[2 * kk2 + 1][2], acc[2 * kk2 + 1][3]);
            const bf16x8 bfr = __builtin_bit_cast(bf16x8, bw);
#pragma unroll
            for (int dt = 0; dt < 4; ++dt) { const bf16_t* wp = w2t + (size_t)(16 * dt + m) * 64 + 32 * kk2 + 4 * q;
                const u32x2 lo = *(const u32x2*)wp, hi = *(const u32x2*)(wp + 16); u32x4 aw = {lo.x, lo.y, hi.x, hi.y};
                out[dt] = mfma16(__builtin_bit_cast(bf16x8, aw), bfr, out[dt]); }
        }
        if (kv == 0) {
            float ss = 0.f;
#pragma unroll
            for (int dt = 0; dt < 4; ++dt)
#pragma unroll
                for (int e = 0; e < 4; ++e) ss += out[dt][e] * out[dt][e];
            ss += __shfl_xor(ss, 16); ss += __shfl_xor(ss, 32);
            const float rstd = rsqrtf(ss * (1.f / 64.f) + NORM_EPS); const float* kg = F.in[25];
            if (nvalid) {
                bf16_t* kc = (bf16_t*)(F.ws + WS_KC) + ((size_t)(b * 128 + n) * 4 + g) * 64;
#pragma unroll
                for (int dt = 0; dt < 4; ++dt) { const int d = 16 * dt + 4 * q; const f32x4 gv = *(const f32x4*)(kg + d); const f32x4 o = out[dt] * rstd * gv;
                    u32x2 w; w.x = pk2(o[0], o[1]); w.y = pk2(o[2], o[3]); *(u32x2*)(kc + d) = w; }
            }
        } else if (nvalid) {
            bf16_t* vct = (bf16_t*)(F.ws + WS_VCT) + (size_t)(b * 4 + g) * 64 * 128 + n;
#pragma unroll
            for (int dt = 0; dt < 4; ++dt)
#pragma unroll
                for (int e = 0; e < 4; ++e) vct[(size_t)(16 * dt + 4 * q + e) * 128] = (bf16_t)f2bf(out[dt][e]);
        }
    }
    __syncthreads();
}

template <int N> DI float row_shr(float v) { return __builtin_bit_cast(float, __builtin_amdgcn_update_dpp(0, __builtin_bit_cast(int, v), 0x110 + N, 0xf, 0xf, true)); }
DI float row_bcast15(float v) { return __builtin_bit_cast(float, __builtin_amdgcn_update_dpp(0, __builtin_bit_cast(int, v), 0x150 + 15, 0xf, 0xf, true)); }
template <int DMODE, int SV = 0> DI void phase_d(Frame& F) {
    constexpr bool first = (DMODE == 0);
    if (DMODE != 3) for (int pr = F.blk; pr < 256; pr += F.G) compress_pair(F, pr);
    const bf16_t* PR = (const bf16_t*)(F.ws + WS_PR); const bf16_t* PK = (const bf16_t*)(F.ws + WS_PK); const bf16_t* PV = (const bf16_t*)(F.ws + WS_PV);
    const bf16_t* PMISC = (const bf16_t*)(F.ws + WS_PMISC);
    bf16_t* PQ = (bf16_t*)(F.ws + WS_PQ); bf16_t* PKV = (bf16_t*)(F.ws + WS_PKV);
    bf16_t* AT = (bf16_t*)((char*)F.out + DO_AT); bf16_t* BT = (bf16_t*)((char*)F.out + DO_BT); bf16_t* KT = (bf16_t*)((char*)F.out + DO_KT); bf16_t* RT = (bf16_t*)((char*)F.out + DO_RT);
    bf16_t* VM = (bf16_t*)(F.ws + WS_VM); float* GL = (float*)(F.ws + WS_GL);
    bf16_t* GRW = (bf16_t*)(F.ws + WS_GRW); float* BSUM = (float*)(F.ws + WS_BSUM); float* GATES = (float*)(F.ws + WS_GATES);
    const bf16_t* W2T = (const bf16_t*)(F.ws + WS_W2T); const bf16_t* A2T = (const bf16_t*)(F.ws + WS_A2T); const bf16_t* G2T = (const bf16_t*)(F.ws + WS_G2T);
    const float* mu = F.in[7]; const float* w0 = F.in[8]; const float* a0 = F.in[10]; const float* k_k = F.in[13]; const float* k_a = F.in[14]; const float* r_k = F.in[15];
    const float* q_g = F.in[24]; const float* k_g = F.in[25];
    bf16_t* XW = (bf16_t*)F.lds; bf16_t* XA = (bf16_t*)(F.lds + 9216); bf16_t* XG = (bf16_t*)(F.lds + 18432); bf16_t* VT = (bf16_t*)(F.lds + 40960);
    const int q = F.lane >> 4, l16 = F.lane & 15;
    for (int tl = F.blk; tl < M / 64; tl += F.G) {
        const int rowbase = tl * 64, b = rowbase / T, t0 = rowbase % T;
        int tidl = threadIdx.x; asm volatile("" : "+v"(tidl));
#pragma unroll 10
        for (int idx = tidl; idx < 64 * 160; idx += NTHREADS) { const int tok = idx / 160, c = 128 + (idx - tok * 160); const size_t row = rowbase + tok;
            const float cur = bf2f(PMISC[row * 512 + c]); const float prev = (t0 + tok > 0) ? bf2f(PMISC[(row - 1) * 512 + c]) : 0.f;
            const float mv = cur + (prev - cur) * mu[3072 + c];
            XG[tok * 168 + c - 128] = (bf16_t)f2bf(sigmoidf_(mv)); }
#pragma unroll 3
        for (int idx = tidl; idx < 64 * 48; idx += NTHREADS) { const int tok = idx / 48, j = idx - tok * 48; const size_t row = rowbase + tok;
            GATES[row * 48 + j] = sigmoidf_(bf2f(PMISC[row * 512 + 288 + j])); }
#pragma unroll
        for (int i = 0; i < 8; ++i) { const int idx = tidl + NTHREADS * i, s = idx >> 11, rem = idx & 2047, tok = rem >> 5, ch8 = rem & 31;
            const u32x4 v = *(const u32x4*)(PKV + (size_t)(rowbase + tok) * 1536 + (3 + 2 * s) * 256 + ch8 * 8);
            *(u32x4*)(VT + (size_t)(s * 64 + tok) * 264 + ch8 * 8) = v; }
        __syncthreads();
        if (DMODE != 3) { const int s = tidl >> 8, gd = tidl & 255;
          bf16_t* dst = (bf16_t*)(F.ws + (s ? WS_VWT : WS_VST)) + ((size_t)(b * 4 + (gd >> 6)) * 64 + (gd & 63)) * 2048 + t0;
#pragma unroll
          for (int i = 0; i < 8; ++i) { unsigned pk[4];
#pragma unroll
              for (int e = 0; e < 4; ++e) pk[e] = (unsigned)VT[(size_t)(s * 64 + 8 * i + 2 * e) * 264 + gd] | ((unsigned)VT[(size_t)(s * 64 + 8 * i + 2 * e + 1) * 264 + gd] << 16);
              *(u32x4*)(dst + 8 * i) = (u32x4){pk[0], pk[1], pk[2], pk[3]}; } }
#pragma unroll 1
        for (int hh = 0; hh < ((DMODE == 2) ? 0 : 2); ++hh) {
            const int head = 2 * F.wave + hh;
            const unsigned rowoff0 = (unsigned)(rowbase + l16) * 1024u + (unsigned)(head * 64 + 4 * q);
            bf16x8 fgn[5];
#pragma unroll
            for (int ks = 0; ks < 5; ++ks) fgn[ks] = *(const bf16x8*)(G2T + (size_t)(head * 64 + l16) * 160 + 32 * ks + 8 * q);
#pragma unroll 1
            for (int ct = 0; ct < 4; ++ct) {
                bf16x8 fg[5];
#pragma unroll
                for (int ks = 0; ks < 5; ++ks) fg[ks] = fgn[ks];
                { const int ctn = (ct < 3) ? ct + 1 : ct;
#pragma unroll
                  for (int ks = 0; ks < 5; ++ks) fgn[ks] = *(const bf16x8*)(G2T + (size_t)(head * 64 + 16 * ctn + l16) * 160 + 32 * ks + 8 * q); }
#pragma unroll
                for (int tt = 0; tt < 4; ++tt) { const int tokl = 16 * tt + l16; f32x4 ag = {0.f, 0.f, 0.f, 0.f};
#pragma unroll
                    for (int ks = 0; ks < 5; ++ks) ag = mfma16(fg[ks], *(const bf16x8*)(XG + tokl * 168 + 32 * ks + 8 * q), ag);
                    u32x2 w; w.x = pk2(ag[0], ag[1]); w.y = pk2(ag[2], ag[3]); *(u32x2*)(GRW + (rowoff0 + (unsigned)(tt * 16384) + (unsigned)(ct * 16))) = w; }
            }
        }
#pragma unroll 8
        for (int it = 0; it < (first ? 32 : 0); ++it) { const int pair = (F.wave * 32 + it) * 4 + q, tok = pair >> 4, head = pair & 15;
            bf16_t* p = PQ + (size_t)(rowbase + tok) * 1024 + head * 64 + 4 * l16; const u32x2 v = *(const u32x2*)p;
            f32x4 f = {lo16(v.x), hi16(v.x), lo16(v.y), hi16(v.y)}; float ss = (f[0] * f[0] + f[1] * f[1]) + (f[2] * f[2] + f[3] * f[3]);
            ss += __shfl_xor(ss, 1); ss += __shfl_xor(ss, 2); ss += __shfl_xor(ss, 4); ss += __shfl_xor(ss, 8);
            const float rstd = rsqrtf(ss * (1.f / 64.f) + NORM_EPS) * (0.125f * LOG2E); f = f * rstd * *(const f32x4*)(q_g + 4 * l16);
            u32x2 w; w.x = pk2(f[0], f[1]); w.y = pk2(f[2], f[3]); *(u32x2*)p = w; }
#pragma unroll 8
        for (int it = 0; it < (first ? 16 : 0); ++it) { const int pair = (F.wave * 16 + it) * 4 + q, tok = pair >> 3, sg = pair & 7, slot = (sg >> 2) ? 4 : 2, g = sg & 3;
            bf16_t* p = PKV + (size_t)(rowbase + tok) * 1536 + slot * 256 + g * 64 + 4 * l16; const u32x2 v = *(const u32x2*)p;
            f32x4 f = {lo16(v.x), hi16(v.x), lo16(v.y), hi16(v.y)}; float ss = (f[0] * f[0] + f[1] * f[1]) + (f[2] * f[2] + f[3] * f[3]);
            ss += __shfl_xor(ss, 1); ss += __shfl_xor(ss, 2); ss += __shfl_xor(ss, 4); ss += __shfl_xor(ss, 8);
            const float rstd = rsqrtf(ss * (1.f / 64.f) + NORM_EPS); f = f * rstd * *(const f32x4*)(k_g + ((slot == 2) ? 64 : 128) + 4 * l16);
            u32x2 w; w.x = pk2(f[0], f[1]); w.y = pk2(f[2], f[3]); *(u32x2*)p = w; }
        __syncthreads();
    }
}

typedef short s16x4v __attribute__((ext_vector_type(4)));
DI f32x4 mfma16k(s16x4v a, s16x4v b, f32x4 c) { return __builtin_amdgcn_mfma_f32_16x16x16bf16_1k(a, b, c, 0, 0, 0); }
DI s16x4v packbf4(f32x4 v) { u32x2 w = {pk2(v[0], v[1]), pk2(v[2], v[3])}; return __builtin_bit_cast(s16x4v, w); }
DI f32x4 unpackbf4(s16x4v v) { const u32x2 w = __builtin_bit_cast(u32x2, v); return (f32x4){lo16(w.x), hi16(w.x), lo16(w.y), hi16(w.y)}; }
DI s16x4v trread(LAS unsigned char* p) { return __builtin_bit_cast(s16x4v, __builtin_amdgcn_ds_read_tr16_b64_v4i16((LAS s16x4v*)p)); }
constexpr int RC_AT = 0, RC_BT = 9216, RC_KT = 18432, RC_RT = 27648, RC_VV = 36864;
constexpr int RC_MAB = 46080, RC_T = 54272, RC_YO = 46080;
constexpr int RC_MBR = 63488, RC_GY = 71680, RC_GS = 79872, RC_HY = 88064, RC_HS = 96256, RC_S = 104448;
DI f32x4 tile_ch64(const unsigned char* Am, int a0, const unsigned char* Bm, int b0, int c16, int g) {
    f32x4 acc = {0.f, 0.f, 0.f, 0.f};
#pragma unroll
    for (int ks = 0; ks < 2; ++ks) acc = mfma16(*(const bf16x8*)(Am + (a0 + c16) * 144 + (32 * ks + 8 * g) * 2), *(const bf16x8*)(Bm + (b0 + c16) * 144 + (32 * ks + 8 * g) * 2), acc);
    return acc;
}
constexpr int RC_XW = 46080, RC_XA = 55296;
constexpr int RC_RAWR = 64512, RC_RAWK = 73872, RC_RAWV = 83232;
constexpr int RC_RAWX = 120832;
constexpr int RC_SSK = 138512, RC_BSP = 139536, RC_GLV = 140560, RC_BS = 140816, RC_PRM = 141072, RC_CARRY = 143120, RC_MUX = 143760;
DI void rwkv_head(Frame& F, int hd) {
    const int b = hd >> 4, h = hd & 15;
    unsigned char* L = F.lds; LAS unsigned char* L3 = F.lds3;
    const int lane0 = F.lane, w = F.wave;
    const bf16_t* PR = (const bf16_t*)(F.ws + WS_PR); const bf16_t* PK = (const bf16_t*)(F.ws + WS_PK); const bf16_t* PV = (const bf16_t*)(F.ws + WS_PV); const bf16_t* PMISC = (const bf16_t*)(F.ws + WS_PMISC);
    const bf16_t* GRW = (const bf16_t*)(F.ws + WS_GRW);
    bf16_t* OA = (bf16_t*)((char*)F.out + DO_OAB);
    const float* ln_w = F.in[16]; const float* ln_b = F.in[17]; const float* mu = F.in[7];
    float* SSK = (float*)(L + RC_SSK); float* BSP = (float*)(L + RC_BSP); float* GLV = (float*)(L + RC_GLV); float* BS = (float*)(L + RC_BS); float* PRM = (float*)(L + RC_PRM);
    u32x4 pre[5];
    auto fetch = [&](int c, int tid_) { const int srow = tid_ >> 3, sch = tid_ & 7, xrow = tid_ >> 4, xch = tid_ & 15; const size_t row = (size_t)b * T + 64 * c;
        const size_t off = (row + srow) * 1024 + h * 64 + 8 * sch;
        pre[0] = *(const u32x4*)(PR + off); pre[1] = *(const u32x4*)(PK + off); pre[2] = *(const u32x4*)(PV + off);
        pre[3] = *(const u32x4*)(PMISC + (row + xrow) * 512 + 8 * xch); pre[4] = *(const u32x4*)(PMISC + (row + xrow + 32) * 512 + 8 * xch); };
    auto commit = [&](int tid_) { const int srow = tid_ >> 3, sch = tid_ & 7, xrow = tid_ >> 4, xch = tid_ & 15;
        *(u32x4*)(L + RC_RAWR + (srow + 1) * 144 + sch * 16) = pre[0]; *(u32x4*)(L + RC_RAWK + (srow + 1) * 144 + sch * 16) = pre[1]; *(u32x4*)(L + RC_RAWV + (srow + 1) * 144 + sch * 16) = pre[2];
        *(u32x4*)(L + RC_RAWX + (xrow + 1) * 272 + xch * 16) = pre[3]; *(u32x4*)(L + RC_RAWX + (xrow + 33) * 272 + xch * 16) = pre[4];
        if (tid_ < 24) *(u32x4*)(L + RC_RAWR + (tid_ >> 3) * 9360 + (tid_ & 7) * 16) = *(const u32x4*)(L + RC_CARRY + tid_ * 16);
        if (tid_ >= 32 && tid_ < 48) *(u32x4*)(L + RC_RAWX + (tid_ & 15) * 16) = *(const u32x4*)(L + RC_CARRY + 384 + (tid_ & 15) * 16); };
    for (int i = F.tid; i < 8192 / 4; i += NTHREADS) ((unsigned*)(L + RC_S))[i] = 0u;
    if (F.tid < 40) *(u32x4*)(L + RC_CARRY + F.tid * 16) = (u32x4){0u, 0u, 0u, 0u};
    __syncthreads();
    { const float* w0 = F.in[8]; const float* a0 = F.in[10]; const float* k_k = F.in[13]; const float* k_a = F.in[14]; const float* r_k = F.in[15];
      const int arr = F.tid >> 6, ch = h * 64 + (F.tid & 63);
      PRM[F.tid] = (arr < 3) ? mu[arr * 1024 + ch] : (arr == 3) ? w0[ch] : (arr == 4) ? a0[ch] : (arr == 5) ? k_k[ch] : (arr == 6) ? k_a[ch] : r_k[ch]; }
    fetch(0, F.tid); commit(F.tid);
    const int ct = w & 3, th = w >> 2;
    bf16x8 fw[2], fa[2];
    { const bf16_t* W2T = (const bf16_t*)(F.ws + WS_W2T); const bf16_t* A2T = (const bf16_t*)(F.ws + WS_A2T); const int c16 = lane0 & 15, g = lane0 >> 4; const int chr = h * 64 + 16 * ct + c16;
#pragma unroll
      for (int ks = 0; ks < 2; ++ks) { fw[ks] = *(const bf16x8*)(W2T + (size_t)chr * 64 + 32 * ks + 8 * g); fa[ks] = *(const bf16x8*)(A2T + (size_t)chr * 64 + 32 * ks + 8 * g); } }
    __syncthreads();
    const int mytile = (w < 4) ? w : (w - 4);
    if (F.tid < 128) ((float*)(L + RC_MUX))[F.tid] = mu[3072 + F.tid];
    const float lnw = ln_w[h * 64 + lane0], lnb = ln_b[h * 64 + lane0];
    asm volatile("" :: "v"(lnw), "v"(lnb), "v"(fw[0]), "v"(fw[1]), "v"(fa[0]), "v"(fa[1]));
    __syncthreads();
#pragma unroll 1
    for (int c = 0; c < T / 64; ++c) {
        const int sb_cur = (c & 1) * 8192, sb_nxt = 8192 - sb_cur;
        int lane = lane0; asm volatile("" : "+v"(lane));
        const int c16 = lane & 15, g = lane >> 4;
        int tidl = F.tid; asm volatile("" : "+v"(tidl));
        if (c + 1 < T / 64) fetch(c + 1, tidl);
        unsigned short pgr[8];
#pragma unroll
        for (int it = 0; it < 8; ++it) { const size_t row = (size_t)b * T + 64 * c + w * 8 + it; pgr[it] = GRW[row * 1024 + h * 64 + lane]; }
        const f32x4 mxa = *(const f32x4*)(L + RC_MUX + (F.tid & 15) * 32), mxb = *(const f32x4*)(L + RC_MUX + (F.tid & 15) * 32 + 16);
        const float mux[8] = {mxa[0], mxa[1], mxa[2], mxa[3], mxb[0], mxb[1], mxb[2], mxb[3]};
#pragma unroll
        for (int i = 0; i < 2; ++i) { const int idx8 = F.tid + NTHREADS * i, tok = idx8 >> 4, cg = idx8 & 15;
            const u32x4 cu = *(const u32x4*)(L + RC_RAWX + (tok + 1) * 272 + cg * 16), pr = *(const u32x4*)(L + RC_RAWX + tok * 272 + cg * 16); u32x4 o;
#pragma unroll
            for (int e = 0; e < 4; ++e) { const float c0 = lo16(cu[e]), c1 = hi16(cu[e]), p0 = lo16(pr[e]), p1 = hi16(pr[e]);
                float m0 = c0 + (p0 - c0) * mux[2 * e], m1 = c1 + (p1 - c1) * mux[2 * e + 1];
                if (cg < 8) { m0 = fast_tanh(m0); m1 = fast_tanh(m1); }
                o[e] = pk2(m0, m1); }
            *(u32x4*)(L + ((cg < 8) ? (RC_XW + (tok * 72 + cg * 8) * 2) : (RC_XA + (tok * 72 + (cg - 8) * 8) * 2))) = o; }
        {
            const int tok = F.tid >> 3, c8 = F.tid & 7;
            const u32x4 kc = *(const u32x4*)(L + RC_RAWK + (tok + 1) * 144 + c8 * 16), kp = *(const u32x4*)(L + RC_RAWK + tok * 144 + c8 * 16);
            const f32x4 m0 = *(const f32x4*)(PRM + 64 + 8 * c8), m1 = *(const f32x4*)(PRM + 64 + 8 * c8 + 4), q0 = *(const f32x4*)(PRM + 5 * 64 + 8 * c8), q1 = *(const f32x4*)(PRM + 5 * 64 + 8 * c8 + 4);
            float ss = 0.f;
#pragma unroll
            for (int e = 0; e < 4; ++e) { const float c0 = lo16(kc[e]), c1 = hi16(kc[e]), p0 = lo16(kp[e]), p1 = hi16(kp[e]);
                const float mu0 = (e < 2) ? m0[2 * e] : m1[2 * e - 4], mu1 = (e < 2) ? m0[2 * e + 1] : m1[2 * e - 3], kq0 = (e < 2) ? q0[2 * e] : q1[2 * e - 4], kq1 = (e < 2) ? q0[2 * e + 1] : q1[2 * e - 3];
                const float k0 = (c0 + (p0 - c0) * mu0) * kq0, k1 = (c1 + (p1 - c1) * mu1) * kq1; ss += k0 * k0 + k1 * k1; }
            ss += dpp_mov<0xB1>(ss); ss += dpp_mov<0x4E>(ss); ss += dpp_mov<0x141>(ss);
            if (c8 == 0) SSK[tok] = ss; }
        lds_barrier();
        f32x4 axv[2], bxv[2];
        {
            f32x4 inc0 = {0.f, 0.f, 0.f, 0.f}, inc1 = inc0, wl0 = inc0, wl1 = inc0, carry = inc0;
            const float* prm = PRM + 16 * ct + 4 * g;
            const f32x4 w0v = *(const f32x4*)(prm + 3 * 64);
#pragma unroll
            for (int tt = 0; tt < 4; ++tt) {
                f32x4 aw = {0.f, 0.f, 0.f, 0.f};
#pragma unroll
                for (int ks = 0; ks < 2; ++ks) aw = mfma16(fw[ks], *(const bf16x8*)(L + RC_XW + ((16 * tt + c16) * 72 + 32 * ks + 8 * g) * 2), aw);
                f32x4 ic, wv;
#pragma unroll
                for (int e = 0; e < 4; ++e) { const float wpre = w0v[e] + aw[e]; const float wl = -0.6065306597126334f * __builtin_amdgcn_rcpf(1.f + __expf(-wpre));
                    float x = wl; x += row_shr<1>(x); x += row_shr<2>(x); x += row_shr<4>(x); x += row_shr<8>(x);
                    ic[e] = x + carry[e]; carry[e] += row_bcast15(x); wv[e] = wl; }
                if (tt == 2 * th) { inc0 = ic; wl0 = wv; }
                if (tt == 2 * th + 1) { inc1 = ic; wl1 = wv; }
            }
            const f32x4 mur = *(const f32x4*)(prm), muk = *(const f32x4*)(prm + 64), muv = *(const f32x4*)(prm + 128);
            const f32x4 a0v = *(const f32x4*)(prm + 4 * 64), kkw = *(const f32x4*)(prm + 5 * 64), kaw = *(const f32x4*)(prm + 6 * 64), rkw = *(const f32x4*)(prm + 7 * 64);
#pragma unroll
            for (int j = 0; j < 2; ++j) {
                const int tok = 32 * th + 16 * j + c16;
                f32x4 aa = {0.f, 0.f, 0.f, 0.f};
#pragma unroll
                for (int ks = 0; ks < 2; ++ks) aa = mfma16(fa[ks], *(const bf16x8*)(L + RC_XA + (tok * 72 + 32 * ks + 8 * g) * 2), aa);
                const f32x4 inc = (j == 0) ? inc0 : inc1, wl4 = (j == 0) ? wl0 : wl1;
                const int ro = ((tok + 1) * 72 + 16 * ct + 4 * g) * 2;
                const u32x2 kc_ = *(const u32x2*)(L + RC_RAWK + ro), kp_ = *(const u32x2*)(L + RC_RAWK + ro - 144), rc_ = *(const u32x2*)(L + RC_RAWR + ro), rp_ = *(const u32x2*)(L + RC_RAWR + ro - 144),
                            vc_ = *(const u32x2*)(L + RC_RAWV + ro), vp_ = *(const u32x2*)(L + RC_RAWV + ro - 144);
                const f32x4 kc4 = {lo16(kc_.x), hi16(kc_.x), lo16(kc_.y), hi16(kc_.y)}, kp4 = {lo16(kp_.x), hi16(kp_.x), lo16(kp_.y), hi16(kp_.y)};
                const f32x4 rc4 = {lo16(rc_.x), hi16(rc_.x), lo16(rc_.y), hi16(rc_.y)}, rp4 = {lo16(rp_.x), hi16(rp_.x), lo16(rp_.y), hi16(rp_.y)};
                const f32x4 vc4 = {lo16(vc_.x), hi16(vc_.x), lo16(vc_.y), hi16(vc_.y)}, vp4 = {lo16(vp_.x), hi16(vp_.x), lo16(vp_.y), hi16(vp_.y)};
                const f32x4 km = kc4 + (kp4 - kc4) * muk, rm = rc4 + (rp4 - rc4) * mur, vm = vc4 + (vp4 - vc4) * muv; f32x4 kt, rt;
                float bs = 0.f;
                const float inv = __builtin_amdgcn_rsqf(fmaxf(SSK[tok], 1e-24f));
#pragma unroll
                for (int e = 0; e < 4; ++e) {
                    const float ei = __expf(inc[e]), eiv = __builtin_amdgcn_rcpf(ei);
                    const float a = __builtin_amdgcn_rcpf(1.f + __expf(-(a0v[e] + aa[e])));
                    const float kk = km[e] * kkw[e] * inv;
                    axv[j][e] = -kk * (ei * __expf(-wl4[e])); bxv[j][e] = kk * a * eiv;
                    const float kpn = km[e] * (1.f + (a - 1.f) * kaw[e]);
                    bs += rm[e] * kpn * rkw[e];
                    kt[e] = kpn * eiv; rt[e] = rm[e] * ei;
                    if (th == 1 && j == 1 && c16 == 15) GLV[16 * ct + 4 * g + e] = ei;
                }
                bs = swap32_sum(swap16_sum(bs));
                if (g == 0) BSP[ct * 64 + tok] = bs;
                { const int o = (tok * 72 + 16 * ct + 4 * g) * 2;
                  *(s16x4v*)(L + RC_AT + o) = packbf4(axv[j]); *(s16x4v*)(L + RC_BT + o) = packbf4(bxv[j]);
                  *(s16x4v*)(L + RC_KT + o) = packbf4(kt); *(s16x4v*)(L + RC_RT + o) = packbf4(rt); *(s16x4v*)(L + RC_VV + o) = packbf4(vm); }
            }
        }
        lds_barrier();
        if (F.tid < 64) BS[F.tid] = (BSP[F.tid] + BSP[64 + F.tid]) + (BSP[128 + F.tid] + BSP[192 + F.tid]);
        if (F.tid >= 64 && F.tid < 88) { const int i = F.tid - 64, arr = i >> 3, pc = i & 7; *(u32x4*)(L + RC_CARRY + i * 16) = *(const u32x4*)(L + RC_RAWR + arr * 9360 + 64 * 144 + pc * 16); }
        if (F.tid >= 96 && F.tid < 112) { const int pc = F.tid - 96; *(u32x4*)(L + RC_CARRY + 384 + pc * 16) = *(const u32x4*)(L + RC_RAWX + 64 * 272 + pc * 16); }
        f32x4 glv;
#pragma unroll
        for (int cb = 0; cb < 4; ++cb) glv[cb] = GLV[16 * cb + c16];
        f32x4 Nq, NTq;
        {
            auto other_tile = [&](int idx) {
                int sb, tb; bool isbr;
                if (idx < 6) { isbr = false; sb = (int)((0x211000u >> (4 * idx)) & 0xfu); tb = (int)((0x332321u >> (4 * idx)) & 0xfu); }
                else { isbr = true; const int k = idx - 6; sb = (int)((0x3221110000ull >> (4 * k)) & 0xfull); tb = (int)((0x3323213210ull >> (4 * k)) & 0xfull); }
                f32x4 acc = tile_ch64(L + RC_BT, 16 * sb, L + (isbr ? RC_RT : RC_AT), 16 * tb, c16, g);
                if (isbr && sb == tb) {
#pragma unroll
                    for (int e = 0; e < 4; ++e) if (4 * g + e > c16) acc[e] = 0.f;
                }
                *(s16x4v*)(L + (isbr ? RC_MBR : RC_MAB) + (sb * 4 + tb) * 512 + lane * 8) = packbf4(acc);
            };
            if (w < 4) {
                Nq = tile_ch64(L + RC_BT, 16 * w, L + RC_AT, 16 * w, c16, g);
                NTq = tile_ch64(L + RC_AT, 16 * w, L + RC_BT, 16 * w, c16, g);
#pragma unroll
                for (int e = 0; e < 4; ++e) { if (4 * g + e >= c16) Nq[e] = 0.f; if (c16 >= 4 * g + e) NTq[e] = 0.f; }
#pragma unroll
                for (int k = 0; k < 4; ++k) other_tile(4 * w + k);
            }
        }
        f32x4 maktT[4], mkr[4];
        if (w < 4) {
            const f32x4 zero = {0.f, 0.f, 0.f, 0.f};
            f32x4 Id;
#pragma unroll
            for (int e = 0; e < 4; ++e) Id[e] = (4 * g + e == c16) ? 1.f : 0.f;
            const s16x4v nb = packbf4(Nq), ntb = packbf4(NTq);
            const f32x4 N2 = mfma16k(ntb, nb, zero), N2T = mfma16k(nb, ntb, zero);
            const s16x4v n2b = packbf4(N2), n2tb = packbf4(N2T);
            const f32x4 N4 = mfma16k(n2tb, n2b, zero), N4T = mfma16k(n2b, n2tb, zero);
            const s16x4v n4b = packbf4(N4), n4tb = packbf4(N4T);
            const s16x4v n8b = packbf4(mfma16k(n4tb, n4b, zero));
            const f32x4 T1 = Id + Nq, T1T = Id + NTq; const s16x4v t1tb = packbf4(T1T);
            const f32x4 T2 = mfma16k(t1tb, n2b, T1), T2T = mfma16k(n2b, t1tb, T1T); const s16x4v t2tb = packbf4(T2T);
            const f32x4 T3 = mfma16k(t2tb, n4b, T2), T3T = mfma16k(n4b, t2tb, T2T);
            const f32x4 T4 = mfma16k(packbf4(T3T), n8b, T3);
            *(s16x4v*)(L + RC_T + w * 512 + lane * 8) = packbf4(T4);
#pragma unroll
            for (int q = 0; q < 4; ++q) { maktT[q] = zero; mkr[q] = zero; }
        } else {
            const int st = w - 4;
#pragma unroll
            for (int tb = 0; tb < 4; ++tb) {
                f32x4 a1 = {0.f, 0.f, 0.f, 0.f}, a2 = a1;
                if (tb >= st) {
                    a1 = tile_ch64(L + RC_AT, 16 * tb, L + RC_KT, 16 * st, c16, g);
                    a2 = tile_ch64(L + RC_KT, 16 * st, L + RC_RT, 16 * tb, c16, g);
                    if (tb == st) {
#pragma unroll
                        for (int e = 0; e < 4; ++e) { if (c16 >= 4 * g + e) a1[e] = 0.f; if (4 * g + e > c16) a2[e] = 0.f; }
                    }
                }
                maktT[tb] = a1; mkr[tb] = a2;
            }
        }
        lds_barrier();
        s16x4v xb[4];
        {
            s16x4v mabi[6], ti[4], yi[4];
            mabi[0] = *(const s16x4v*)(L + RC_MAB + (0 * 4 + 1) * 512 + lane * 8); mabi[1] = *(const s16x4v*)(L + RC_MAB + (0 * 4 + 2) * 512 + lane * 8); mabi[2] = *(const s16x4v*)(L + RC_MAB + (1 * 4 + 2) * 512 + lane * 8);
            mabi[3] = *(const s16x4v*)(L + RC_MAB + (0 * 4 + 3) * 512 + lane * 8); mabi[4] = *(const s16x4v*)(L + RC_MAB + (1 * 4 + 3) * 512 + lane * 8); mabi[5] = *(const s16x4v*)(L + RC_MAB + (2 * 4 + 3) * 512 + lane * 8);
#pragma unroll
            for (int q = 0; q < 4; ++q) { ti[q] = *(const s16x4v*)(L + RC_T + q * 512 + lane * 8);
                if (w < 4) yi[q] = trread(L3 + RC_AT + (16 * q + 4 * g + ((lane >> 2) & 3)) * 144 + (16 * w) * 2 + 8 * (lane & 3)); }
            __builtin_amdgcn_sched_barrier(0);
#pragma unroll
            for (int q = 0; q < 4; ++q) {
                f32x4 y = (w < 4) ? unpackbf4(yi[q]) : maktT[q];
#pragma unroll
                for (int p = 0; p < 4; ++p) if (p < q) y = mfma16k(mabi[(q == 1) ? 0 : (q == 2) ? (1 + p) : (3 + p)], xb[p], y);
                const f32x4 xq = mfma16k(ti[q], packbf4(y), (f32x4){0.f, 0.f, 0.f, 0.f});
                xb[q] = packbf4(xq);
            }
        }
        {
            s16x4v mbri[10]; u32x2 rvi[4];
#pragma unroll
            for (int tb = 0; tb < 4; ++tb) {
#pragma unroll
                for (int sb = 0; sb < 4; ++sb) if (sb <= tb) mbri[tb * (tb + 1) / 2 + sb] = *(const s16x4v*)(L + RC_MBR + (sb * 4 + tb) * 512 + lane * 8);
                if (w < 4) rvi[tb] = *(const u32x2*)(L + RC_RT + (16 * tb + c16) * 144 + (16 * w + 4 * g) * 2); }
            __builtin_amdgcn_sched_barrier(0);
#pragma unroll
            for (int tb = 0; tb < 4; ++tb) {
                f32x4 acc;
                if (w < 4) acc = (f32x4){lo16(rvi[tb].x), hi16(rvi[tb].x), lo16(rvi[tb].y), hi16(rvi[tb].y)};
                else acc = mkr[tb];
#pragma unroll
                for (int sb = 0; sb < 4; ++sb) if (sb <= tb) acc = mfma16k(xb[sb], mbri[tb * (tb + 1) / 2 + sb], acc);
                *(s16x4v*)(L + ((w < 4) ? RC_GY : RC_HY) + (mytile * 4 + tb) * 512 + lane * 8) = packbf4(acc);
            }
        }
#pragma unroll
        for (int ch2 = 0; ch2 < 2; ++ch2) {
            s16x4v bti[8], kti[2];
#pragma unroll
            for (int c1 = 0; c1 < 2; ++c1) { const int cb = 2 * ch2 + c1;
#pragma unroll
                for (int tb = 0; tb < 4; ++tb) bti[c1 * 4 + tb] = trread(L3 + RC_BT + (16 * tb + 4 * g + ((lane >> 2) & 3)) * 144 + (16 * cb) * 2 + 8 * (lane & 3));
                if (w >= 4) kti[c1] = trread(L3 + RC_KT + (16 * (w - 4) + 4 * g + ((lane >> 2) & 3)) * 144 + (16 * cb) * 2 + 8 * (lane & 3)); }
            __builtin_amdgcn_sched_barrier(0);
#pragma unroll
            for (int c1 = 0; c1 < 2; ++c1) { const int cb = 2 * ch2 + c1;
                f32x4 acc = {0.f, 0.f, 0.f, 0.f};
#pragma unroll
                for (int tb = 0; tb < 4; ++tb) acc = mfma16k(xb[tb], bti[c1 * 4 + tb], acc);
                if (w < 4) {
#pragma unroll
                    for (int e = 0; e < 4; ++e) if (16 * w + 4 * g + e == 16 * cb + c16) acc[e] += 1.f;
                } else acc += unpackbf4(kti[c1]);
                acc = acc * glv[cb];
                *(s16x4v*)(L + ((w < 4) ? RC_GS : RC_HS) + (mytile * 4 + cb) * 512 + lane * 8) = packbf4(acc);
            }
            __builtin_amdgcn_sched_barrier(0);
        }
        lds_barrier();
        {
            const int ib = w & 3, hf = w >> 2;
            s16x4v simg[4], vtr[4];
#pragma unroll
            for (int k = 0; k < 4; ++k) { simg[k] = *(const s16x4v*)(L + RC_S + sb_cur + (k * 4 + ib) * 512 + lane * 8);
                vtr[k] = trread(L3 + RC_VV + (16 * k + 4 * g + ((lane >> 2) & 3)) * 144 + (16 * ib) * 2 + 8 * (lane & 3)); }
#pragma unroll
            for (int j = 0; j < 2; ++j) {
                const int tb = 2 * hf + j, cb = 2 * hf + j;
                f32x4 y = {0.f, 0.f, 0.f, 0.f}, sn = y;
                { s16x4v gyi[4], hyi[4];
#pragma unroll
                  for (int k = 0; k < 4; ++k) { gyi[k] = *(const s16x4v*)(L + RC_GY + (k * 4 + tb) * 512 + lane * 8); hyi[k] = *(const s16x4v*)(L + RC_HY + (k * 4 + tb) * 512 + lane * 8); }
                  __builtin_amdgcn_sched_barrier(0);
#pragma unroll
                  for (int k = 0; k < 4; ++k) y = mfma16k(simg[k], gyi[k], y);
#pragma unroll
                  for (int k = 0; k < 4; ++k) if (k <= tb) y = mfma16k(vtr[k], hyi[k], y); }
                { s16x4v gsi[4], hsi[4];
#pragma unroll
                  for (int k = 0; k < 4; ++k) { gsi[k] = *(const s16x4v*)(L + RC_GS + (k * 4 + cb) * 512 + lane * 8); hsi[k] = *(const s16x4v*)(L + RC_HS + (k * 4 + cb) * 512 + lane * 8); }
                  __builtin_amdgcn_sched_barrier(0);
#pragma unroll
                  for (int k = 0; k < 4; ++k) sn = mfma16k(gsi[k], simg[k], sn);
#pragma unroll
                  for (int k = 0; k < 4; ++k) sn = mfma16k(hsi[k], vtr[k], sn); }
                *(f32x4*)(L + RC_YO + ((16 * tb + c16) * 68 + 16 * ib + 4 * g) * 4) = y;
                *(s16x4v*)(L + RC_S + sb_nxt + (cb * 4 + ib) * 512 + lane * 8) = packbf4(sn);
            }
        }
        lds_barrier();
        if (c + 1 < T / 64) commit(tidl);
        {
            float yv[8], mean[8], var[8];
#pragma unroll
            for (int it = 0; it < 8; ++it) yv[it] = *(const float*)(L + RC_YO + ((w * 8 + it) * 68 + lane) * 4);
#pragma unroll
            for (int it = 0; it < 8; ++it) mean[it] = wave_sum_dpp(yv[it]) * (1.f / 64.f);
#pragma unroll
            for (int it = 0; it < 8; ++it) { yv[it] -= mean[it]; var[it] = wave_sum_dpp(yv[it] * yv[it]) * (1.f / 64.f); }
            const float lw = lnw, lb = lnb;
#pragma unroll
            for (int it = 0; it < 8; ++it) { const size_t row = (size_t)b * T + 64 * c + w * 8 + it;
                const float yn = yv[it] * rsqrtf(var[it] + GN_EPS) * lw + lb;
                const int tk = w * 8 + it; const float vv = bf2f(*(const bf16_t*)(L + RC_VV + (tk * 72 + lane) * 2));
                OA[row * 2048 + h * 64 + lane] = (bf16_t)f2bf((yn + BS[tk] * vv) * bf2f(pgr[it])); }
        }
        lds_barrier();
    }
}

DI int crow(int reg, int hh) { return (reg & 3) + 8 * (reg >> 2) + 4 * hh; }
constexpr int NSA_KB = 0, NSA_VB = 18432, NSA_PSUM = 36864, NSA_IMP = 70144, NSA_SEL = 78848, NSA_UNI = 79104, NSA_ITEM = 79108, NSA_BT = 79360, NSA_Q = 90112;
constexpr float NEGBIG = -1e30f;
struct TileRegs { u32x4 k, v; };
DI void tile_fetch(TileRegs& r, const bf16_t* Kp, size_t kstride, const bf16_t* Vp, size_t vstride, int tid) {
    const int row = tid >> 3, ch = tid & 7;
    r.k = *(const u32x4*)(Kp + (size_t)row * kstride + ch * 8);
    r.v = *(const u32x4*)(Vp + (size_t)row * vstride + ch * 8);
}
DI void tile_commit(const TileRegs& r, unsigned char* lds, int buf, int tid) {
    const int row = tid >> 3, ch = tid & 7;
    *(u32x4*)(lds + NSA_KB + buf * 9216 + row * 144 + ch * 16) = r.k;
    unsigned char* vp = lds + NSA_VB + buf * 8704 + row * 136 + ch * 16;
    *(u32x2*)vp = (u32x2){r.v.x, r.v.y}; *(u32x2*)(vp + 8) = (u32x2){r.v.z, r.v.w};
}
DI void tile_scores(f32x16& s0, f32x16& s1, const unsigned char* lds, int buf, const unsigned char* qb, int r, int hh) {
    const unsigned char* kb = lds + NSA_KB + buf * 9216 + r * 144 + hh * 16;
    s0 = (f32x16){0.f, 0.f, 0.f, 0.f, 0.f, 0.f, 0.f, 0.f, 0.f, 0.f, 0.f, 0.f, 0.f, 0.f, 0.f, 0.f}; s1 = s0;
#pragma unroll
    for (int d0 = 0; d0 < 4; ++d0) {
        const bf16x8 k0 = *(const bf16x8*)(kb + d0 * 32), k1 = *(const bf16x8*)(kb + 32 * 144 + d0 * 32);
        const bf16x8 qf = *(const bf16x8*)(qb + d0 * 8192);
        s0 = mfma32(k0, qf, s0); s1 = mfma32(k1, qf, s1);
    }
}
DI bf16x8 pack8(const f32x16& p, int s2) { u32x4 w; w.x = pk2(p[8 * s2], p[8 * s2 + 1]); w.y = pk2(p[8 * s2 + 2], p[8 * s2 + 3]); w.z = pk2(p[8 * s2 + 4], p[8 * s2 + 5]); w.w = pk2(p[8 * s2 + 6], p[8 * s2 + 7]); return __builtin_bit_cast(bf16x8, w); }
DI void tile_pv(f32x16 (&o)[2], const f32x16& p0, const f32x16& p1, const unsigned char* lds, int buf, int r, int hh) {
    const unsigned char* vb = lds + NSA_VB + buf * 8704;
#pragma unroll
    for (int half = 0; half < 2; ++half)
#pragma unroll
        for (int s2 = 0; s2 < 2; ++s2) {
            const bf16x8 pf = pack8(half ? p1 : p0, s2);
#pragma unroll
            for (int dh = 0; dh < 2; ++dh) { const unsigned char* vp = vb + (32 * dh + r) * 136 + (32 * half + 16 * s2 + 4 * hh) * 2;
                const u32x2 lo = *(const u32x2*)vp, hi = *(const u32x2*)(vp + 16); u32x4 vw = {lo.x, lo.y, hi.x, hi.y};
                o[dh] = mfma32(__builtin_bit_cast(bf16x8, vw), pf, o[dh]); }
        }
}
constexpr float MINIT = -1e20f;
DI void online_update(f32x16& s0, f32x16& s1, float& mrun, float& lrun, f32x16 (&o)[2]) {
    float mt = fmaxf(s0[0], s1[0]);
#pragma unroll
    for (int i = 1; i < 16; ++i) mt = fmaxf(mt, fmaxf(s0[i], s1[i]));
    mt = swap32_max(mt);
    if (__any(mt > mrun)) {
        const float mnew = fmaxf(mrun, mt); const float alpha = __builtin_amdgcn_exp2f(mrun - mnew);
        lrun *= alpha; mrun = mnew;
#pragma unroll
        for (int i = 0; i < 16; ++i) { o[0][i] *= alpha; o[1][i] *= alpha; }
    }
    float ps0 = 0.f, ps1 = 0.f;
#pragma unroll
    for (int i = 0; i < 16; ++i) { s0[i] = __builtin_amdgcn_exp2f(s0[i] - mrun); s1[i] = __builtin_amdgcn_exp2f(s1[i] - mrun); ps0 += s0[i]; ps1 += s1[i]; }
    lrun += swap32_sum(ps0 + ps1);
}

template <int VAR> DI void nsa_worker(Frame& F) {
    unsigned char* lds = F.lds;
    float* PSUM = (float*)(lds + NSA_PSUM); float* IMP = (float*)(lds + NSA_IMP); unsigned* SEL = (unsigned*)(lds + NSA_SEL); unsigned* UNI = (unsigned*)(lds + NSA_UNI);
    int* ITEM = (int*)(lds + NSA_ITEM); float* BT = (float*)(lds + NSA_BT);
    const bf16_t* PQ = (const bf16_t*)(F.ws + WS_PQ); const bf16_t* PKV = (const bf16_t*)(F.ws + WS_PKV);
    const bf16_t* KC = (const bf16_t*)(F.ws + WS_KC); const bf16_t* VCT = (const bf16_t*)(F.ws + WS_VCT);
    const bf16_t* VST = (const bf16_t*)(F.ws + WS_VST); const bf16_t* VWT = (const bf16_t*)(F.ws + WS_VWT);
    const float* GATES = (const float*)(F.ws + WS_GATES); bf16_t* OB = (bf16_t*)((char*)F.out + DO_OAB) + 1024;
    unsigned* ctr = (unsigned*)(F.ws + WS_CTL) + 64;
    { int t0_ = (int)threadIdx.x; asm volatile("" : "+v"(t0_));
      for (int i = t0_; i < 2048; i += NTHREADS) BT[i] = ((const float*)(F.ws + WS_BIAS))[i] * LOG2E; }
    const int hg = F.wave >> 1, th = F.wave & 1;
    const int myx = (int)((unsigned)__builtin_amdgcn_s_getreg((3 << 11) | 20) & 7u); int qsel = 0;
    for (;;) {
        lds_barrier();
        if (((int)threadIdx.x) == 0) { int it = -1;
            while (qsel < 8) { const int qx = (myx + qsel) & 7; const unsigned v = atomicAdd(ctr + 16 * qx, 1u); if (v < 128u) { it = (int)v * 8 + qx; break; } ++qsel; }
            *ITEM = it; }
        lds_barrier();
        const int item0 = *ITEM; if (item0 < 0) break;
        const int item = ((item0 >> 3) << 3) | (item0 & 7);
        int tidl = threadIdx.x; asm volatile("" : "+v"(tidl));
        const int r = tidl & 31, hh = (tidl >> 5) & 1, tl = 32 * th + r;
        const int qidx = item >> 3, qx_ = item & 7; const int qt = 31 - (qidx >> 2), bg = 8 * (qidx & 3) + qx_, b = bg >> 2, g = bg & 3, t0 = 64 * qt, cur = qt;
        const int hq = 4 * g + hg, t = t0 + tl; const size_t row = (size_t)b * T + t;
        const unsigned char* qr = lds + NSA_Q + tidl * 16;
#pragma unroll
        for (int d0 = 0; d0 < 4; ++d0) *(bf16x8*)(lds + NSA_Q + d0 * 8192 + tidl * 16) = *(const bf16x8*)(PQ + row * 1024 + hq * 64 + 16 * d0 + 8 * hh);
        const float gate_c = GATES[row * 48 + hq * 3], gate_s = GATES[row * 48 + hq * 3 + 1], gate_w = GATES[row * 48 + hq * 3 + 2];
        const float* bt = BT + hq * 128;
        f32x16 oacc[2];
#pragma unroll
        for (int i = 0; i < 16; ++i) { oacc[0][i] = 0.f; oacc[1][i] = 0.f; }
        TileRegs tr;
        {
            const bf16_t* Kp = KC + ((size_t)b * 128 * 4 + g) * 64; const bf16_t* Vp = VCT + (size_t)(b * 4 + g) * 64 * 128;
            tile_fetch(tr, Kp, 256, Vp, 128, tidl); tile_commit(tr, lds, 0, tidl);
            tile_fetch(tr, Kp + (size_t)64 * 256, 256, Vp + 64, 128, tidl); tile_commit(tr, lds, 1, tidl);
            lds_barrier();
            tile_fetch(tr, PKV + (size_t)b * T * 1536 + 2 * 256 + g * 64, 1536, VST + (size_t)(b * 4 + g) * 64 * 2048, 2048, tidl);
            f32x16 sc[2][2];
            tile_scores(sc[0][0], sc[0][1], lds, 0, qr, r, hh); __builtin_amdgcn_sched_barrier(0); tile_scores(sc[1][0], sc[1][1], lds, 1, qr, r, hh); __builtin_amdgcn_sched_barrier(0);
            const int nmax = (t >= 31) ? ((t - 31) >> 4) : -1;
            float mx = NEGBIG;
            const int tmin_w = t0 + 32 * th;
#define CMP_MASK(S_, NB_) do { \
                if (16 * (NB_) + 31 > tmin_w + 31) { _Pragma("unroll") for (int i = 0; i < 16; ++i) S_[i] = NEGBIG; }                                     \
                else if (16 * ((NB_) + 31) + 31 + 128 <= tmin_w) { _Pragma("unroll") for (int i = 0; i < 16; ++i) mx = fmaxf(mx, S_[i]); }               \
                else { _Pragma("unroll") for (int i = 0; i < 16; ++i) { const int n = (NB_) + crow(i, hh); const int rel = t - 16 * n - 31; float s = S_[i]; \
                    const float bv = bt[min(max(rel, 0), 127)]; if (n <= nmax) { s += bv; mx = fmaxf(mx, s); } else s = NEGBIG; S_[i] = s; } } \
                __builtin_amdgcn_sched_barrier(0); } while (0)
            CMP_MASK(sc[0][0], 0); CMP_MASK(sc[0][1], 32); CMP_MASK(sc[1][0], 64); CMP_MASK(sc[1][1], 96);
#undef CMP_MASK
            mx = swap32_max(mx);
            float ps = 0.f;
#pragma unroll
            for (int kt = 0; kt < 2; ++kt)
#pragma unroll
                for (int half = 0; half < 2; ++half)
#pragma unroll
                    for (int i = 0; i < 16; ++i) { const float s = sc[kt][half][i]; const float p = (s > -1e29f) ? __builtin_amdgcn_exp2f(s - mx) : 0.f; sc[kt][half][i] = p; ps += p; }
            ps = swap32_sum(ps);
            const float inv = (ps > 0.f) ? 1.f / ps : 0.f;
#pragma unroll
            for (int kt = 0; kt < 2; ++kt)
#pragma unroll
                for (int half = 0; half < 2; ++half)
#pragma unroll
                    for (int i = 0; i < 16; ++i) sc[kt][half][i] *= inv;
            if (cur >= 8) {
#pragma unroll 1
                for (int hgi = 0; hgi < 4; ++hgi) {
                    if (hg == hgi) {
#pragma unroll
                        for (int kt = 0; kt < 2; ++kt)
#pragma unroll
                            for (int half = 0; half < 2; ++half)
                                { float* pb = PSUM + tl * 129 + 64 * kt + 32 * half + 4 * hh; float old[16];
#pragma unroll
                                  for (int i = 0; i < 16; ++i) old[i] = (hgi == 0) ? 0.f : pb[(i & 3) + 8 * (i >> 2)];
#pragma unroll
                                  for (int i = 0; i < 16; ++i) pb[(i & 3) + 8 * (i >> 2)] = old[i] + sc[kt][half][i]; }
                    }
                    lds_barrier();
                }
            }
#pragma unroll
            for (int kt = 0; kt < 2; ++kt)
#pragma unroll
                for (int half = 0; half < 2; ++half)
#pragma unroll
                    for (int i = 0; i < 16; ++i) sc[kt][half][i] *= gate_c;
            tile_pv(oacc, sc[0][0], sc[0][1], lds, 0, r, hh); __builtin_amdgcn_sched_barrier(0); tile_pv(oacc, sc[1][0], sc[1][1], lds, 1, r, hh); __builtin_amdgcn_sched_barrier(0);
            if (cur >= 8) {
#pragma unroll
                for (int i = 0; i < 4; ++i) { const int tok = tidl >> 3, j = (tidl & 7) + 8 * i; const float* pp = PSUM + tok * 129 + 4 * j;
                    float v = pp[0] + pp[1] + pp[2] + 0.5f * pp[3]; if (j > 0) v += 0.5f * pp[-1];
                    IMP[tok * 33 + j] = v; }
                lds_barrier();
                if (F.wave == 0) {
                    const int tok = tidl & 63; float scv[32];
#pragma unroll
                    for (int j = 0; j < 32; ++j) { const bool forced = (j == 0) || (j == cur) || (j == cur - 1); scv[j] = forced ? 1e4f : ((j <= cur) ? IMP[tok * 33 + j] : -1.f); }
                    unsigned msk = 0u;
#pragma unroll 1
                    for (int k = 0; k < 8; ++k) { float best = -3e38f; int bi = 0;
#pragma unroll
                        for (int j = 0; j < 32; ++j) { const bool tk = ((msk >> j) & 1u) == 0u && scv[j] > best; best = tk ? scv[j] : best; bi = tk ? j : bi; }
                        msk |= 1u << bi; }
                    msk &= (cur >= 31) ? 0xffffffffu : ((1u << (cur + 1)) - 1u);
                    SEL[tok] = msk;
                    unsigned um = msk;
#pragma unroll
                    for (int o = 1; o < 64; o <<= 1) um |= (unsigned)__shfl_xor((int)um, o);
                    if ((tidl & 63) == 0) *UNI = um;
                }
            } else {
                if (tidl < 64) SEL[tidl] = (1u << (cur + 1)) - 1u;
                if (tidl == 0) *UNI = (1u << (cur + 1)) - 1u;
            }
            lds_barrier();
        }
        {
            const unsigned uni = *UNI, mysel = SEL[tl];
            const bf16_t* Kb = PKV + (size_t)b * T * 1536 + 2 * 256 + g * 64; const bf16_t* Vb = VST + (size_t)(b * 4 + g) * 64 * 2048;
            float mrun = MINIT, lrun = 0.f; f32x16 o[2];
#pragma unroll
            for (int i = 0; i < 16; ++i) { o[0][i] = 0.f; o[1][i] = 0.f; }
            unsigned rem = uni; int j = 0; rem &= rem - 1u; int buf = 0;
            const bf16_t* Kbw = PKV + (size_t)b * T * 1536 + 4 * 256 + g * 64; const bf16_t* Vbw = VWT + (size_t)(b * 4 + g) * 64 * 2048; const int jw0 = (cur >= 8) ? cur - 8 : 0;
            for (;;) {
                tile_commit(tr, lds, buf, tidl);
                lds_barrier();
                const int jn = rem ? __builtin_ctz(rem) : -1; rem &= rem - 1u;
                if (jn >= 0) tile_fetch(tr, Kb + (size_t)64 * jn * 1536, 1536, Vb + 64 * jn, 2048, tidl);
                else tile_fetch(tr, Kbw + (size_t)64 * jw0 * 1536, 1536, Vbw + 64 * jw0, 2048, tidl);
                f32x16 s0, s1;
                if (VAR <= 1) tile_scores(s0, s1, lds, buf, qr, r, hh); else { s0 = o[0]; s1 = o[1]; }
                const bool selb = (mysel >> j) & 1u;
                if (VAR == 0 && j >= cur - 2) {
#pragma unroll
                    for (int i = 0; i < 16; ++i) { const int rel0 = t - (64 * j + crow(i, hh)), rel1 = rel0 - 32;
                        const float b0 = bt[min(max(rel0, 0), 127)], b1 = bt[min(max(rel1, 0), 127)];
                        s0[i] = (selb && rel0 >= 0) ? (s0[i] + b0) : NEGBIG;
                        s1[i] = (selb && rel1 >= 0) ? (s1[i] + b1) : NEGBIG; }
                } else if (!selb) {
#pragma unroll
                    for (int i = 0; i < 16; ++i) { s0[i] = NEGBIG; s1[i] = NEGBIG; }
                }
                if (VAR == 0) online_update(s0, s1, mrun, lrun, o);
                if (VAR <= 1) tile_pv(o, s0, s1, lds, buf, r, hh);
                if (jn < 0) break;
                j = jn; buf ^= 1;
            }
            const float sc_ = gate_s / lrun;
#pragma unroll
            for (int i = 0; i < 16; ++i) { oacc[0][i] += sc_ * o[0][i]; oacc[1][i] += sc_ * o[1][i]; }
            lds_barrier();
        }
        {
            const bf16_t* Kb = PKV + (size_t)b * T * 1536 + 4 * 256 + g * 64; const bf16_t* Vb = VWT + (size_t)(b * 4 + g) * 64 * 2048;
            float mrun = MINIT, lrun = 0.f; f32x16 o[2];
#pragma unroll
            for (int i = 0; i < 16; ++i) { o[0][i] = 0.f; o[1][i] = 0.f; }
            int j = (cur >= 8) ? cur - 8 : 0, buf = 0;
            for (;;) {
                tile_commit(tr, lds, buf, tidl);
                lds_barrier();
                const int jn = (j < cur) ? j + 1 : -1;
                if (jn >= 0) tile_fetch(tr, Kb + (size_t)64 * jn * 1536, 1536, Vb + 64 * jn, 2048, tidl);
                f32x16 s0, s1;
                if (VAR <= 1) tile_scores(s0, s1, lds, buf, qr, r, hh); else { s0 = o[0]; s1 = o[1]; }
                if (VAR == 0 && (j >= cur - 2 || j == cur - 8)) {
#pragma unroll
                    for (int i = 0; i < 16; ++i) { const int rel0 = t - (64 * j + crow(i, hh)), rel1 = rel0 - 32;
                        const float b0 = bt[min(max(rel0, 0), 127)], b1 = bt[min(max(rel1, 0), 127)];
                        s0[i] = (rel0 >= 0 && rel0 < 512) ? (s0[i] + b0) : NEGBIG;
                        s1[i] = (rel1 >= 0 && rel1 < 512) ? (s1[i] + b1) : NEGBIG; }
                }
                if (VAR == 0) online_update(s0, s1, mrun, lrun, o);
                if (VAR <= 1) tile_pv(o, s0, s1, lds, buf, r, hh);
                if (jn < 0) break;
                j = jn; buf ^= 1;
            }
            const float sc_ = gate_w / lrun;
#pragma unroll
            for (int i = 0; i < 16; ++i) { oacc[0][i] += sc_ * o[0][i]; oacc[1][i] += sc_ * o[1][i]; }
        }
        bf16_t* op = OB + row * 2048 + hq * 64;
        if (VAR != 0) { if (oacc[0][0] + oacc[1][5] == 123.456f) op[0] = 0; continue; }
#pragma unroll
        for (int dh = 0; dh < 2; ++dh)
#pragma unroll
            for (int gq = 0; gq < 4; ++gq) { u32x2 w; w.x = pk2(oacc[dh][4 * gq], oacc[dh][4 * gq + 1]); w.y = pk2(oacc[dh][4 * gq + 2], oacc[dh][4 * gq + 3]);
                *(u32x2*)(op + 32 * dh + 8 * gq + 4 * hh) = w; }
    }
}


#define XB_TMO      128
#define XB_XCNT(j)  (256  + 64 * (j))
#define XB_XSUB(j)  (1280 + 64 * (j))
#define XB_XGEN(j)  (2304 + 64 * (j))
#define XB_TOP      3328
#define XB_TOPGEN   3392
#define XCD_BAR_WORDS 3456
#define XB_SPIN_CAP (1u << 22)
DI unsigned xb_ld(unsigned* p)              { return __hip_atomic_load(p, __ATOMIC_RELAXED, __HIP_MEMORY_SCOPE_AGENT); }
DI unsigned xb_add(unsigned* p, unsigned v) { return __hip_atomic_fetch_add(p, v, __ATOMIC_RELAXED, __HIP_MEMORY_SCOPE_AGENT); }
DI unsigned xb_xcc_id() { return (unsigned)__builtin_amdgcn_s_getreg((3 << 11) | 20) & 0xFu; }
#define XB_SPIN(cond, bar) do { unsigned _sp = 0; while (cond) { __builtin_amdgcn_s_sleep(1); \
    if ((++_sp & 255u) == 0u) { if (xb_ld(&(bar)[XB_TMO])) break; if (_sp > XB_SPIN_CAP) { atomicAdd(&(bar)[XB_TMO], 1u); break; } } } } while (0)
struct XcdBarrier { unsigned* bar; unsigned x; volatile LAS unsigned* st; };
DI XcdBarrier xcd_barrier_post(unsigned* bar, volatile LAS unsigned* st) {
    XcdBarrier b; b.bar = bar; b.x = xb_xcc_id(); b.st = st;
    if (threadIdx.x == 0) (void)xb_add(&bar[XB_XCNT(b.x)], 1u);
    return b;
}
DI void xcd_barrier_complete(unsigned* bar, unsigned x, unsigned& nloc, unsigned& nx) {
    const unsigned G = gridDim.x * gridDim.y * gridDim.z;
    unsigned sum, cnt, mine, sp = 0u;
    for (;;) {
        sum = 0u; cnt = 0u; mine = 0u;
#pragma unroll
        for (unsigned j = 0; j < 16; ++j) { const unsigned c = xb_ld(&bar[XB_XCNT(j)]); sum += c; cnt += (c > 0u) ? 1u : 0u; mine = (j == x) ? c : mine; }
        if (sum == G) break;
        __builtin_amdgcn_s_sleep(1);
        if ((++sp & 255u) == 0u) { if (xb_ld(&bar[XB_TMO])) break; if (sp > XB_SPIN_CAP) { atomicAdd(&bar[XB_TMO], 1u); break; } }
    }
    nloc = mine > 0u ? mine : 1u; nx = cnt > 0u ? cnt : 1u;
}
DI void xcd_barrier(const XcdBarrier& b) {
    asm volatile("s_waitcnt vmcnt(0)" ::: "memory");
    __syncthreads();
    if (threadIdx.x == 0) {
        unsigned* bar = b.bar;
        __builtin_amdgcn_s_waitcnt(0);
        unsigned nloc = b.st[0], nx = b.st[1];
        if (nloc == 0u) { xcd_barrier_complete(bar, b.x, nloc, nx); b.st[0] = nloc; b.st[1] = nx; }
        const unsigned old = xb_add(&bar[XB_XSUB(b.x)], 1u);
        const unsigned gen = old / nloc;
        if (old + 1u == (gen + 1u) * nloc) {
            __builtin_amdgcn_fence(__ATOMIC_RELEASE, "agent");
            asm volatile("s_waitcnt vmcnt(0)" ::: "memory");
            const unsigned og = xb_add(&bar[XB_TOP], 1u);
            const unsigned tg = og / nx;
            if (og + 1u == (tg + 1u) * nx) xb_add(&bar[XB_TOPGEN], 1u);
            else XB_SPIN(xb_ld(&bar[XB_TOPGEN]) == tg, bar);
            __builtin_amdgcn_fence(__ATOMIC_ACQUIRE, "agent");
            xb_add(&bar[XB_XGEN(b.x)], 1u);
            asm volatile("s_waitcnt vmcnt(0)" ::: "memory");
        } else {
            XB_SPIN(xb_ld(&bar[XB_XGEN(b.x)]) == gen, bar);
            __builtin_amdgcn_fence(__ATOMIC_ACQUIRE, "agent");
            asm volatile("s_waitcnt vmcnt(0)" ::: "memory");
        }
    }
    __syncthreads();
}

constexpr int N_LAUNCHES = MK_N_LAUNCHES, N_PHASES = 9;
__global__ void __launch_bounds__(NTHREADS, 2) hybrid_fwd(Args args) {
    extern __shared__ __attribute__((aligned(16))) unsigned char lds[];
    Frame F;
    F.lds = lds; F.lds3 = (LAS unsigned char*)lds;
    F.tid = threadIdx.x; F.lane = F.tid & 63; F.wave = __builtin_amdgcn_readfirstlane(F.tid >> 6);
    F.G = gridDim.x; F.blk = blockIdx.x; F.gw = F.blk * 8 + F.wave; F.NGW = F.G * 8;
    F.in = args.in; F.out = args.out; F.ws = args.ws;
    volatile LAS unsigned* bst = (volatile LAS unsigned*)(F.lds3 + LDS_BYTES - 16);
    if (F.tid < 2) bst[F.tid] = 0u;
    __syncthreads();
    XcdBarrier bar = xcd_barrier_post((unsigned*)(args.ws + WS_CTL) + 1024, bst);
    const int lo = args.ph_lo, hi = args.ph_hi;
#ifndef PH_MASK
#define PH_MASK 0x1ff
#endif
#ifndef REP_MASK
#define REP_MASK 0
#endif
#define REP(k) ((REP_MASK >> (k)) & 1)
#define IN(k) (((PH_MASK >> (k)) & 1) && lo <= (k) && (k) < hi)
#define SEAM(k) do { if (IN(k) && IN((k) + 1)) { xcd_barrier(bar); } } while (0)
    unsigned char* ws = args.ws;
    if (IN(0)) { phase_a(F, true); if (REP(0)) { __syncthreads(); phase_a(F, false); } } SEAM(0);
    if (IN(1)) { phase_b(F); if (REP(1)) { __syncthreads(); phase_b(F); } } SEAM(1);
    if (IN(2)) {
        pg8::Gemm g; g.A0 = g.A1 = (const bf16_t*)(ws + WS_H); g.B0 = g.B1 = (const bf16_t*)(ws + WS_WIN); g.K = D;
        pg8::StaticOrder S; S.init(M, NCOLS, F.G, F.blk, 1);
        EpiInProj E{ws};
        pg8::gemm_phase<EpiInProj, true, true>(F.lds3, g, S, E);
        if (REP(2)) { EpiInProjT<(REP_MASK >> 16) & 3> E2{ws}; pg8::gemm_phase<EpiInProjT<(REP_MASK >> 16) & 3>, true, true>(F.lds3, g, S, E2); }
    } SEAM(2);
    if (IN(3)) { phase_d<0>(F); if (REP(3)) { __syncthreads(); phase_d<((REP_MASK >> 16) & 3) ? ((REP_MASK >> 16) & 3) : 1, (REP_MASK >> 18) & 3>(F); } } SEAM(3);
    if (IN(4)) {
        const int nscan = (F.G >= 256) ? 128 : F.G / 2;
#ifndef NO_SCAN
        if (F.blk < nscan) { for (int hd = F.blk; hd < BATCH * RH; hd += nscan) rwkv_head(F, hd); }
#endif
#ifndef NO_NSA
        nsa_worker<0>(F);
#endif
        if (REP(4)) {
            xcd_barrier(bar); if (F.blk == 0 && F.tid < 8) __hip_atomic_store((unsigned*)(ws + WS_CTL) + 64 + 16 * F.tid, 0u, __ATOMIC_RELAXED, __HIP_MEMORY_SCOPE_AGENT); xcd_barrier(bar);
            if (REP_MASK & 0x1000) { if (F.blk < nscan) { for (int hd = F.blk; hd < BATCH * RH; hd += nscan) rwkv_head(F, hd); } }
            if (REP_MASK & 0x2000) { nsa_worker<(REP_MASK >> 16) & 3>(F); }
        }
    } SEAM(4);
    if (IN(5)) {
        pg8::Gemm g; g.A0 = g.A1 = (const bf16_t*)((const char*)args.out + DO_OAB); g.B0 = g.B1 = (const bf16_t*)(ws + WS_WOA); g.K = D;
        pg8::StaticOrder S; S.init(M, D, F.G, F.blk, 1);
        EpiMerge E{(const bf16_t*)(ws + WS_PMG), (bf16_t*)(ws + WS_MIXED)};
        pg8::gemm_phase<EpiMerge, true, true>(F.lds3, g, S, E);
        if (REP(5)) { if ((REP_MASK >> 16) & 3) { EpiInProjT<2> E2{ws}; pg8::gemm_phase<EpiInProjT<2>, true, true>(F.lds3, g, S, E2); } else pg8::gemm_phase<EpiMerge, true, true>(F.lds3, g, S, E); }
    } SEAM(5);
    if (IN(6)) {
        pg8::Gemm g; g.A0 = g.A1 = (const bf16_t*)(ws + WS_MIXED); g.B0 = g.B1 = (const bf16_t*)(ws + WS_WOUT); g.K = D;
        pg8::StaticOrder S; S.init(M, D, F.G, F.blk, 1);
        EpiWout E{args.in[0], (const float*)(ws + WS_MOD), (const float*)(ws + WS_M2V), args.out, (bf16_t*)(ws + WS_X1M), (float*)(ws + WS_SUMSQ)};
        pg8::gemm_phase<EpiWout, true, true>(F.lds3, g, S, E);
    } SEAM(6);
    if (IN(7)) {
        pg8::Gemm g; g.A0 = g.A1 = (const bf16_t*)(ws + WS_X1M); g.B0 = g.B1 = (const bf16_t*)(ws + WS_WUP); g.K = D;
        pg8::StaticOrder S; S.init(M, DFF, F.G, F.blk, 1);
        EpiUp E{(const float*)(ws + WS_SUMSQ), (const float*)(ws + WS_C2), (bf16_t*)(ws + WS_U)};
        pg8::gemm_phase<EpiUp, true, true>(F.lds3, g, S, E);
        if (REP(7)) pg8::gemm_phase<EpiUp, true, true>(F.lds3, g, S, E);
    } SEAM(7);
    if (IN(8)) {
        pg8::Gemm g; g.A0 = g.A1 = (const bf16_t*)(ws + WS_U); g.B0 = g.B1 = (const bf16_t*)(ws + WS_WDOWN); g.K = DFF;
        pg8::StaticOrder S; S.init(M, D, F.G, F.blk, 1);
        EpiDown E{(const float*)(ws + WS_MOD), args.out};
        pg8::gemm_phase<EpiDown, true, true>(F.lds3, g, S, E);
    }
#undef IN
#undef SEAM
}

extern "C" void kernel_launch(void* const* d_in, const int* in_sizes, int n_in, void* d_out, int out_size, void* d_ws, size_t ws_size, hipStream_t stream) {
    static int grid = 0;
    if (grid == 0) {
        if (n_in != 32 || in_sizes[0] != M * D || out_size != M * D || ws_size < WS_END) {
            fprintf(stderr, "kernel_launch: unexpected shapes (n_in %d, in0 %d, out %d, ws %zu); nothing launched\n", n_in, n_in > 0 ? in_sizes[0] : -1, out_size, ws_size); grid = -1; return; }
        int dev = 0, cus = 0, per_cu = 0;
        if (hipGetDevice(&dev) != hipSuccess || hipDeviceGetAttribute(&cus, hipDeviceAttributeMultiprocessorCount, dev) != hipSuccess) { grid = -1; return; }
        if (hipFuncSetAttribute((const void*)hybrid_fwd, hipFuncAttributeMaxDynamicSharedMemorySize, LDS_BYTES) != hipSuccess) { fprintf(stderr, "kernel_launch: hipFuncSetAttribute failed\n"); grid = -1; return; }
        if (hipOccupancyMaxActiveBlocksPerMultiprocessor(&per_cu, (const void*)hybrid_fwd, NTHREADS, LDS_BYTES) != hipSuccess || per_cu < 1) { fprintf(stderr, "kernel_launch: occupancy query gives %d blocks per CU; nothing launched\n", per_cu); per_cu = 0; }
        (void)hipGetLastError();
        if (per_cu < 1) { grid = -1; return; }
        grid = cus;
        if (grid > 256) grid = 256;
    }
    if (grid < 0) return;
    if (hipMemsetAsync((char*)d_ws + WS_CTL, 0, CTL_ZERO_BYTES, stream) != hipSuccess) { fprintf(stderr, "kernel_launch: memset failed\n"); return; }
    Args a{};
    for (int i = 0; i < 32; ++i) a.in[i] = (const float*)d_in[i];
    a.out = (float*)d_out; a.ws = (unsigned char*)d_ws;
    if (N_LAUNCHES == 1) {
        a.ph_lo = 0; a.ph_hi = N_PHASES;
        hipLaunchKernelGGL(hybrid_fwd, dim3(grid), dim3(NTHREADS), LDS_BYTES, stream, a);
        const hipError_t e = hipPeekAtLastError();
        if (e != hipSuccess) fprintf(stderr, "kernel_launch: launch failed: %s (grid %d)\n", hipGetErrorString(e), grid);
    } else {
        for (int p = 0; p < N_PHASES; ++p) { a.ph_lo = p; a.ph_hi = p + 1; hipLaunchKernelGGL(hybrid_fwd, dim3(grid), dim3(NTHREADS), LDS_BYTES, stream, a); }
    }
}
```

```cpp
#include <hip/hip_runtime.h>
#include <cstdio>
#include <cstdint>

#ifndef MK_N_LAUNCHES
#define MK_N_LAUNCHES 1
#endif

#define DI __device__ __forceinline__
#define LAS __attribute__((address_space(3)))
typedef unsigned short bf16_t;
typedef short bf16x8 __attribute__((ext_vector_type(8)));
typedef short s16x4 __attribute__((ext_vector_type(4)));
typedef float f32x2 __attribute__((ext_vector_type(2)));
typedef float f32x4 __attribute__((ext_vector_type(4)));
typedef float f32x16 __attribute__((ext_vector_type(16)));
typedef unsigned u32x2 __attribute__((ext_vector_type(2)));
typedef unsigned u32x4 __attribute__((ext_vector_type(4)));
typedef __bf16 bf16x2_t __attribute__((ext_vector_type(2)));

constexpr int D = 2048, BATCH = 8, T = 2048, M = BATCH * T, DFF = 8192;
constexpr int RW = 1024, RH = 16, HD = 64;
constexpr int NCOLS = 10240;
constexpr int IN_COLS = 10064;
constexpr int NC = 127;
constexpr float NORM_EPS = 1e-6f, GN_EPS = 64e-5f;
constexpr float LOG2E = 1.4426950408889634f;

constexpr size_t MiB = 1u << 20;
constexpr size_t WS_CTL = 0, CTL_ZERO_BYTES = 1 * MiB;
constexpr size_t WS_MOD = 64 * 1024;
constexpr size_t WS_SUMSQ = 512 * 1024;
constexpr size_t WS_C2 = 1 * MiB;
constexpr size_t WS_M2V = WS_C2 + 256 * 1024;
constexpr size_t WS_BIAS = WS_M2V + 64 * 1024;
constexpr size_t WS_CPE = WS_BIAS + 8 * 1024;
constexpr size_t WS_W2T = WS_CPE + 1024;
constexpr size_t WS_A2T = WS_W2T + 128 * 1024;
constexpr size_t WS_G2T = WS_A2T + 128 * 1024;
constexpr size_t WS_CW1K = WS_G2T + 320 * 1024;
constexpr size_t WS_CW1V = WS_CW1K + 256 * 1024;
constexpr size_t WS_CW2K = WS_CW1V + 256 * 1024;
constexpr size_t WS_CW2V = WS_CW2K + 8 * 1024;
constexpr size_t WS_KC = WS_CW2V + 8 * 1024;
constexpr size_t WS_VCT = WS_KC + 512 * 1024;
constexpr size_t WS_BSUM = WS_VCT + 512 * 1024;
constexpr size_t WS_GATES = WS_BSUM + 1 * MiB;
static_assert(WS_GATES + 3 * MiB <= 8 * MiB, "small region");
constexpr size_t WS_WOA = 8 * MiB, WS_WOB = 12 * MiB, WS_WOUT = 16 * MiB, WS_WUP = 24 * MiB, WS_WDOWN = 56 * MiB, WS_WIN = 88 * MiB;
constexpr size_t WS_H = 128 * MiB;
constexpr size_t WS_PR = 192 * MiB, WS_PK = 224 * MiB, WS_PV = 256 * MiB, WS_PQ = 288 * MiB, WS_PKV = 320 * MiB, WS_PMG = 368 * MiB, WS_PMISC = 496 * MiB;
constexpr size_t WS_END = 512 * MiB;
constexpr size_t WS_GRW = 88 * MiB, WS_VST = 120 * MiB, WS_VWT = 128 * MiB;
constexpr size_t DO_OAB = 0;
constexpr size_t WS_STASH = 192 * MiB;
constexpr size_t WS_MIXED = 88 * MiB;
constexpr size_t WS_X1M = 368 * MiB;
constexpr size_t WS_U = 88 * MiB;
static_assert(WS_U + (size_t)M * DFF * 2 <= WS_X1M, "u vs x1m");
constexpr size_t DO_AT = 0, DO_BT = 32 * MiB, DO_KT = 64 * MiB, DO_RT = 96 * MiB;
constexpr size_t WS_VM = 136 * MiB, WS_GL = 168 * MiB;

constexpr int LDS_BYTES = 147456;
constexpr int NTHREADS = 512;

DI float bf2f(unsigned v) { return __uint_as_float(v << 16); }
DI unsigned pk2(float lo, float hi) { f32x2 v = {lo, hi}; bf16x2_t b = __builtin_convertvector(v, bf16x2_t); return __builtin_bit_cast(unsigned, b); }
DI unsigned f2bf(float f) { return pk2(f, 0.f) & 0xffffu; }
DI float lo16(unsigned u) { return __uint_as_float(u << 16); }
DI float hi16(unsigned u) { return __uint_as_float(u & 0xffff0000u); }
DI float wave_sum(float v) {
#pragma unroll
    for (int o = 1; o < 64; o <<= 1) v += __shfl_xor(v, o);
    return v;
}
DI void lds_barrier() { asm volatile("s_waitcnt lgkmcnt(0)\n\ts_barrier" ::: "memory"); }
DI float sigmoidf_(float x) { return __builtin_amdgcn_rcpf(1.f + __expf(-x)); }
template <int CTRL> DI float dpp_mov(float v) { return __builtin_bit_cast(float, __builtin_amdgcn_update_dpp(0, __builtin_bit_cast(int, v), CTRL, 0xf, 0xf, true)); }
DI float swap32_sum(float x) { auto r = __builtin_amdgcn_permlane32_swap(__float_as_uint(x), __float_as_uint(x), false, false); return __uint_as_float(r[0]) + __uint_as_float(r[1]); }
DI float swap32_max(float x) { auto r = __builtin_amdgcn_permlane32_swap(__float_as_uint(x), __float_as_uint(x), false, false); return fmaxf(__uint_as_float(r[0]), __uint_as_float(r[1])); }
DI float wave_sum_dpp(float x);
DI float swap16_sum(float x) { auto r = __builtin_amdgcn_permlane16_swap(__float_as_uint(x), __float_as_uint(x), false, false); return __uint_as_float(r[0]) + __uint_as_float(r[1]); }

DI float wave_sum_dpp(float x) {
    x += dpp_mov<0xB1>(x);
    x += dpp_mov<0x4E>(x);
    x += dpp_mov<0x141>(x);
    x += dpp_mov<0x140>(x);
    return swap32_sum(swap16_sum(x));
}

namespace pg8 {
constexpr int BM = 256, BK = 64, HALF = 128, HTB = HALF * BK * 2, STAGE_BYTES = 8 * HTB, NXCD = 8, WGM = 4;
__host__ __device__ __forceinline__ int lds_byte(int r, int c) { const int st = (r >> 4) * 2 + (c >> 5), rr = r & 15, cc = c & 31, ob = rr * 64 + cc * 2; return st * 1024 + (ob ^ (((ob >> 9) & 1) << 5)); }
__host__ __device__ __forceinline__ void stage_rc(int b, int& R, int& C) { const int st = b / 1024, sb = b % 1024, swz = sb ^ (((sb >> 9) & 1) << 5); R = (st >> 1) * 16 + swz / 64; C = (st & 1) * 32 + (swz % 64) / 2; }
__host__ __device__ __forceinline__ int perm32(int rho) { const int n = rho >> 4, i = rho & 15; return 8 * (i >> 2) + 4 * n + (i & 3); }

struct Unit { int pm, pn, z; };
struct Gemm { const bf16_t* A0; const bf16_t* A1; const bf16_t* B0; const bf16_t* B1; int K; };
struct StaticOrder {
    int nM, nN, nwg, G, c, nz;
    __device__ void init(int M_, int N_, int G_, int c_, int nz_) { nM = M_ / BM; nN = N_ / BM; nwg = nM * nN; G = G_; c = c_; nz = nz_; }
    __device__ bool next(int i, Unit& u) const {
        const int ti = i / nz; u.z = i - ti * nz;
        const long L = (long)ti * G + c; if (L >= nwg) return false;
        int wgid = (int)L; { const int q = nwg / NXCD, r = nwg % NXCD, xcd = wgid % NXCD, off = wgid / NXCD; wgid = (xcd < r ? xcd * (q + 1) : r * (q + 1) + (xcd - r) * q) + off; }
        const int nig = WGM * nN, gid = wgid / nig, fm = gid * WGM, gsz = (nM - fm) < WGM ? (nM - fm) : WGM;
        u.pm = fm + ((wgid % nig) % gsz); u.pn = (wgid % nig) / gsz; return true;
    }
};

template <class Epi, bool ALIGN_EPI, bool SP2>
__device__ __forceinline__ void gemm_phase(LAS unsigned char* lds, const Gemm g, const StaticOrder& S, const Epi& E) {
    const int tid = threadIdx.x, wid = __builtin_amdgcn_readfirstlane(tid >> 6), lane = tid & 63, wr = wid >> 2, wc = wid & 3, fr = lane & 15, fq = lane >> 4;
    const int K = g.K, nt = K / BK;
    unsigned voffA[2], voffB[2];
#pragma unroll
    for (int i = 0; i < 2; ++i) { int R, C; stage_rc(tid * 16 + i * 8192, R, C); const int Rb = Epi::PERM ? ((R & ~31) + perm32(R & 31)) : R;
        voffA[i] = (unsigned)(R * K + C) * 2u; voffB[i] = (unsigned)(Rb * K + C) * 2u; }
    const size_t kstep = (size_t)(BK * 2);
    const size_t hstep = (size_t)HALF * K * 2;
    const size_t tstep = 2 * hstep;
    const unsigned ldsw = (unsigned)wid * 1024u;
    const int aoff = lds_byte(wr * 64 + fr, fq * 8), boff = lds_byte(wc * 32 + fr, fq * 8);
#define PG8_SA(b, h) (((b) * 2 + (h)) * HTB)
#define PG8_SB(b, h) ((4 + (b) * 2 + (h)) * HTB)
#define PG8_STAGE(bufoff, gbase, voff) do { _Pragma("unroll") for (int _i = 0; _i < 2; ++_i) \
        __builtin_amdgcn_global_load_lds((const unsigned*)((const char*)(gbase) + (voff)[_i]), (LAS unsigned*)(lds + (bufoff) + ldsw + _i * 8192), 16, 0, 0); } while (0)
#define PG8_LDA(dst, b, h) do { _Pragma("unroll") for (int m = 0; m < 4; ++m) _Pragma("unroll") for (int k = 0; k < 2; ++k) dst[m][k] = *(const LAS bf16x8*)(lds + PG8_SA(b, h) + aoff + m * 2048 + k * 1024); } while (0)
#define PG8_LDB(dst, b, h) do { _Pragma("unroll") for (int n = 0; n < 2; ++n) _Pragma("unroll") for (int k = 0; k < 2; ++k) dst[n][k] = *(const LAS bf16x8*)(lds + PG8_SB(b, h) + boff + n * 2048 + k * 1024); } while (0)
#define PG8_MMA(ai, bj, At, Bt) do { __builtin_amdgcn_s_setprio(1); _Pragma("unroll") for (int m = 0; m < 4; ++m) _Pragma("unroll") for (int n = 0; n < 2; ++n) _Pragma("unroll") for (int k = 0; k < 2; ++k) \
        acc[ai][bj][m][n] = __builtin_amdgcn_mfma_f32_16x16x32_bf16(Bt[n][k], At[m][k], acc[ai][bj][m][n], 0, 0, 0); __builtin_amdgcn_s_setprio(0); } while (0)
#define PG8_WAIT_V(n) asm volatile("s_waitcnt vmcnt(" #n ")" ::: "memory")
#define PG8_WAIT_L(n) asm volatile("s_waitcnt lgkmcnt(" #n ")" ::: "memory")
#define PG8_BAR __builtin_amdgcn_s_barrier()
#define PG8_SCHED __builtin_amdgcn_sched_barrier(0)
    Unit cur, nxt; int ui = 0;
    if (!S.next(0, cur)) return;
    f32x4 acc[2][2][4][2];
#pragma unroll
    for (int a = 0; a < 2; ++a)
#pragma unroll
        for (int b = 0; b < 2; ++b)
#pragma unroll
            for (int m = 0; m < 4; ++m)
#pragma unroll
                for (int n = 0; n < 2; ++n) acc[a][b][m][n] = (f32x4){0.f, 0.f, 0.f, 0.f};
    bf16x8 At[4][2], B0[2][2], B1[2][2];
    const char* cA = (const char*)(cur.z ? g.A1 : g.A0) + (size_t)cur.pm * tstep; const char* cB = (const char*)(cur.z ? g.B1 : g.B0) + (size_t)cur.pn * tstep;
    if constexpr (SP2) {
        PG8_STAGE(PG8_SB(0, 0), cB, voffB); PG8_STAGE(PG8_SB(0, 1), cB + hstep, voffB); PG8_STAGE(PG8_SA(0, 0), cA, voffA); PG8_STAGE(PG8_SA(0, 1), cA + hstep, voffA);
        if (wr == 1) PG8_BAR;
        PG8_WAIT_V(2); PG8_BAR;
        PG8_STAGE(PG8_SB(1, 0), cB + kstep, voffB); PG8_STAGE(PG8_SA(1, 0), cA + kstep, voffA); PG8_STAGE(PG8_SB(1, 1), cB + hstep + kstep, voffB);
        PG8_WAIT_V(6); PG8_BAR;
    } else {
        PG8_STAGE(PG8_SB(0, 0), cB, voffB); PG8_STAGE(PG8_SA(0, 0), cA, voffA); PG8_STAGE(PG8_SB(0, 1), cB + hstep, voffB); PG8_STAGE(PG8_SA(0, 1), cA + hstep, voffA);
        if (wr == 1) PG8_BAR;
        PG8_WAIT_V(4); PG8_BAR;
        PG8_STAGE(PG8_SB(1, 0), cB + kstep, voffB); PG8_STAGE(PG8_SA(1, 0), cA + kstep, voffA); PG8_STAGE(PG8_SB(1, 1), cB + hstep + kstep, voffB);
        PG8_WAIT_V(6); PG8_BAR;
    }
    for (;;) {
        const bool has_next = S.next(ui + 1, nxt);
        const char* nA = has_next ? (const char*)(nxt.z ? g.A1 : g.A0) + (size_t)nxt.pm * tstep : cA; const char* nB = has_next ? (const char*)(nxt.z ? g.B1 : g.B0) + (size_t)nxt.pn * tstep : cB;
        for (int t = 0; t < nt; t += 2) {
            if constexpr (Epi::MID_T > 0) { if (t == Epi::MID_T) { E.mid(acc, cur, wr, wc, fr, fq); asm volatile("s_waitcnt vmcnt(0)" ::: "memory"); } }
            const bool last = (t == nt - 2);
            const char* a1 = cA + (size_t)(t + 1) * kstep;
            const char* a2 = last ? nA : cA + (size_t)(t + 2) * kstep; const char* b2 = last ? nB : cB + (size_t)(t + 2) * kstep;
            const char* a3 = a2 + kstep; const char* b3 = b2 + kstep;
            if constexpr (SP2) {
            PG8_LDB(B0, 0, 0); PG8_LDB(B1, 0, 1); PG8_SCHED; PG8_LDA(At, 0, 0); PG8_STAGE(PG8_SA(1, 1), a1 + hstep, voffA);
            PG8_WAIT_V(8); PG8_WAIT_L(0); PG8_BAR; PG8_MMA(0, 0, At, B0); PG8_MMA(0, 1, At, B1); PG8_BAR; PG8_SCHED;
            PG8_LDA(At, 0, 1); PG8_STAGE(PG8_SB(0, 0), b2, voffB); PG8_STAGE(PG8_SB(0, 1), b2 + hstep, voffB); PG8_STAGE(PG8_SA(0, 0), a2, voffA);
            PG8_WAIT_V(8); PG8_WAIT_L(0); PG8_BAR; PG8_MMA(1, 0, At, B0); PG8_MMA(1, 1, At, B1); PG8_BAR; PG8_SCHED;
            PG8_LDB(B0, 1, 0); PG8_LDB(B1, 1, 1); PG8_SCHED; PG8_LDA(At, 1, 0); PG8_STAGE(PG8_SA(0, 1), a2 + hstep, voffA);
            PG8_WAIT_V(8); PG8_WAIT_L(0); PG8_BAR; PG8_MMA(0, 0, At, B0); PG8_MMA(0, 1, At, B1); PG8_BAR; PG8_SCHED;
            PG8_LDA(At, 1, 1); PG8_STAGE(PG8_SB(1, 0), b3, voffB); PG8_STAGE(PG8_SB(1, 1), b3 + hstep, voffB); PG8_STAGE(PG8_SA(1, 0), a3, voffA);
            PG8_WAIT_V(8); PG8_WAIT_L(0); PG8_BAR; PG8_MMA(1, 0, At, B0); PG8_MMA(1, 1, At, B1); PG8_BAR; PG8_SCHED;
            } else {
            PG8_LDB(B0, 0, 0); PG8_SCHED; PG8_LDA(At, 0, 0); PG8_STAGE(PG8_SA(1, 1), a1 + hstep, voffA);
            PG8_WAIT_L(8); PG8_BAR; PG8_WAIT_L(0); PG8_MMA(0, 0, At, B0); PG8_BAR; PG8_SCHED;
            PG8_LDB(B1, 0, 1); PG8_STAGE(PG8_SB(0, 0), b2, voffB);
            PG8_BAR; PG8_WAIT_L(0); PG8_MMA(0, 1, At, B1); PG8_BAR;
            PG8_LDA(At, 0, 1); PG8_STAGE(PG8_SA(0, 0), a2, voffA);
            PG8_BAR; PG8_WAIT_L(0); PG8_MMA(1, 0, At, B0); PG8_BAR; PG8_SCHED;
            PG8_STAGE(PG8_SB(0, 1), b2 + hstep, voffB);
            PG8_WAIT_V(6); PG8_BAR; PG8_MMA(1, 1, At, B1); PG8_BAR;
            PG8_LDB(B0, 1, 0); PG8_SCHED; PG8_LDA(At, 1, 0); PG8_STAGE(PG8_SA(0, 1), a2 + hstep, voffA);
            PG8_WAIT_L(8); PG8_BAR; PG8_WAIT_L(0); PG8_MMA(0, 0, At, B0); PG8_BAR; PG8_SCHED;
            PG8_LDB(B1, 1, 1); PG8_STAGE(PG8_SB(1, 0), b3, voffB);
            PG8_BAR; PG8_WAIT_L(0); PG8_MMA(0, 1, At, B1); PG8_BAR;
            PG8_LDA(At, 1, 1); PG8_STAGE(PG8_SA(1, 0), a3, voffA);
            PG8_BAR; PG8_WAIT_L(0); PG8_MMA(1, 0, At, B0); PG8_BAR; PG8_SCHED;
            PG8_STAGE(PG8_SB(1, 1), b3 + hstep, voffB);
            PG8_WAIT_V(6); PG8_BAR; PG8_MMA(1, 1, At, B1); PG8_BAR;
            }
        }
        if constexpr (ALIGN_EPI) { if (wr == 0) PG8_BAR; }
        E(acc, cur, wr, wc, fr, fq);
        if (!has_next) break;
#pragma unroll
        for (int a = 0; a < 2; ++a)
#pragma unroll
            for (int b = 0; b < 2; ++b)
#pragma unroll
                for (int m = 0; m < 4; ++m)
#pragma unroll
                    for (int n = 0; n < 2; ++n) acc[a][b][m][n] = (f32x4){0.f, 0.f, 0.f, 0.f};
        cur = nxt; cA = nA; cB = nB; ++ui;
        if constexpr (ALIGN_EPI) { if (wr == 1) PG8_BAR; }
    }
    PG8_WAIT_V(0);
    if constexpr (!ALIGN_EPI) { if (wr == 0) PG8_BAR; }
    PG8_BAR;
#undef PG8_SA
#undef PG8_SB
#undef PG8_STAGE
#undef PG8_LDA
#undef PG8_LDB
#undef PG8_MMA
#undef PG8_WAIT_V
#undef PG8_WAIT_L
#undef PG8_BAR
#undef PG8_SCHED
}
}
using pg8::Unit; using pg8::HALF; using pg8::BM;
typedef const f32x4 (&AccRef)[2][2][4][2];

template <int MODE> struct EpiInProjT {
    static constexpr bool PERM = true; static constexpr int MID_T = 0;
    unsigned char* ws;
    DI void operator()(AccRef acc, const Unit& u, int wr, int wc, int fr, int fq) const {
        if (MODE == 2) { f32x4 t = {0.f, 0.f, 0.f, 0.f};
#pragma unroll
            for (int ai = 0; ai < 2; ++ai)
#pragma unroll
                for (int bj = 0; bj < 2; ++bj)
#pragma unroll
                    for (int m = 0; m < 4; ++m) { t += acc[ai][bj][m][0]; t += acc[ai][bj][m][1]; }
            if (t[0] + t[1] + t[2] + t[3] == 123.456f) *(float*)ws = 1.f; return; }
        const int pn = u.pn; bf16_t* base; int ld, ct; bool sig = false;
        if (pn < 4) { base = (bf16_t*)(ws + WS_PR); ld = 1024; ct = pn; }
        else if (pn < 8) { base = (bf16_t*)(ws + WS_PK); ld = 1024; ct = pn - 4; }
        else if (pn < 12) { base = (bf16_t*)(ws + WS_PV); ld = 1024; ct = pn - 8; }
        else if (pn < 16) { base = (bf16_t*)(ws + WS_PQ); ld = 1024; ct = pn - 12; }
        else if (pn < 22) { base = (bf16_t*)(ws + WS_PKV); ld = 1536; ct = pn - 16; }
        else if (pn < 38) { base = (bf16_t*)(ws + WS_PMG); ld = 4096; ct = pn - 22; sig = true; }
        else { base = (bf16_t*)(ws + WS_PMISC); ld = 512; ct = pn - 38; }
        const int row0 = u.pm * BM + wr * 64 + fr, col0 = ct * BM + wc * 32 + 8 * fq;
#pragma unroll
        for (int ai = 0; ai < 2; ++ai)
#pragma unroll
            for (int m = 0; m < 4; ++m) { bf16_t* rowp = base + (size_t)(row0 + ai * HALF + m * 16) * ld + col0;
#pragma unroll
                for (int bj = 0; bj < 2; ++bj) { f32x4 v0 = acc[ai][bj][m][0], v1 = acc[ai][bj][m][1];
                    if (sig) {
#pragma unroll
                        for (int e = 0; e < 4; ++e) { v0[e] = sigmoidf_(v0[e]); v1[e] = sigmoidf_(v1[e]); } }
                    u32x4 w; w.x = pk2(v0[0], v0[1]); w.y = pk2(v0[2], v0[3]); w.z = pk2(v1[0], v1[1]); w.w = pk2(v1[2], v1[3]);
                    if (MODE == 0) *(u32x4*)(rowp + bj * HALF) = w; else if (w.x == 0x12345678u && w.w == 0x9abcdef0u) *(u32x4*)(rowp + bj * HALF) = w; } }
    }
};
typedef EpiInProjT<0> EpiInProj;
struct EpiMerge {
    static constexpr bool PERM = true;
    static constexpr int MID_T = 16;
    const bf16_t* mg; bf16_t* mixed;
    DI void mid(f32x4 (&acc)[2][2][4][2], const Unit& u, int wr, int wc, int fr, int fq) const {
        int row0 = u.pm * BM + wr * 64 + fr, col0 = u.pn * BM + wc * 32 + 8 * fq;
        asm volatile("" : "+v"(row0), "+v"(col0));
#pragma unroll
        for (int ai = 0; ai < 2; ++ai)
#pragma unroll
            for (int m = 0; m < 4; ++m) { const size_t row = (size_t)(row0 + ai * HALF + m * 16);
#pragma unroll
                for (int bj = 0; bj < 2; ++bj) { const int col = col0 + bj * HALF;
                    const u32x4 ga = *(const u32x4*)(mg + row * 4096 + col), gb = *(const u32x4*)(mg + row * 4096 + 2048 + col);
#pragma unroll
                    for (int e = 0; e < 4; ++e) { const float s0 = lo16(ga[e]) * __builtin_amdgcn_rcpf(fmaxf(lo16(gb[e]), 1e-20f)), s1 = hi16(ga[e]) * __builtin_amdgcn_rcpf(fmaxf(hi16(gb[e]), 1e-20f));
                        acc[ai][bj][m][e >> 1][2 * (e & 1)] *= s0; acc[ai][bj][m][e >> 1][2 * (e & 1) + 1] *= s1; } }
                __builtin_amdgcn_sched_barrier(0); }
    }
    DI void operator()(AccRef acc, const Unit& u, int wr, int wc, int fr, int fq) const {
        const int row0 = u.pm * BM + wr * 64 + fr, col0 = u.pn * BM + wc * 32 + 8 * fq;
#pragma unroll
        for (int ai = 0; ai < 2; ++ai)
#pragma unroll
            for (int m = 0; m < 4; ++m) { const size_t row = (size_t)(row0 + ai * HALF + m * 16);
#pragma unroll
                for (int bj = 0; bj < 2; ++bj) { const int col = col0 + bj * HALF;
                    const u32x4 gb = *(const u32x4*)(mg + row * 4096 + 2048 + col); u32x4 w;
#pragma unroll
                    for (int e = 0; e < 4; ++e) w[e] = pk2(acc[ai][bj][m][e >> 1][2 * (e & 1)] * fmaxf(lo16(gb[e]), 1e-20f), acc[ai][bj][m][e >> 1][2 * (e & 1) + 1] * fmaxf(hi16(gb[e]), 1e-20f));
                    *(u32x4*)(mixed + row * 2048 + col) = w; } }
    }
};
struct EpiWout {
    static constexpr bool PERM = false; static constexpr int MID_T = 0;
    const float* x; const float* mod; const float* m2v; float* x1; bf16_t* x1m; float* sumsq;
    DI void operator()(AccRef acc, const Unit& u, int wr, int wc, int fr, int fq) const {
        const int row0 = u.pm * BM + wr * 64 + fr, col0 = u.pn * BM + wc * 32 + 4 * fq; const int b = (u.pm * BM) / T;
        const float* gt1 = mod + (size_t)b * 12288 + 4096; const float* mv = m2v + (size_t)b * 2048;
        f32x4 gv[2][2], m2[2][2];
#pragma unroll
        for (int bj = 0; bj < 2; ++bj)
#pragma unroll
            for (int n = 0; n < 2; ++n) { gv[bj][n] = *(const f32x4*)(gt1 + col0 + bj * HALF + n * 16); m2[bj][n] = *(const f32x4*)(mv + col0 + bj * HALF + n * 16); }
        f32x4 xn[2][2];
#pragma unroll
        for (int bj = 0; bj < 2; ++bj)
#pragma unroll
            for (int n = 0; n < 2; ++n) xn[bj][n] = *(const f32x4*)(x + (size_t)row0 * D + col0 + bj * HALF + n * 16);
#pragma unroll
        for (int gi = 0; gi < 8; ++gi) { const int ai = gi >> 2, m = gi & 3; const size_t row = (size_t)(row0 + ai * HALF + m * 16); float ss = 0.f;
            f32x4 xc[2][2];
#pragma unroll
            for (int bj = 0; bj < 2; ++bj)
#pragma unroll
                for (int n = 0; n < 2; ++n) xc[bj][n] = xn[bj][n];
            if (gi < 7) { const size_t rown = (size_t)(row0 + ((gi + 1) >> 2) * HALF + ((gi + 1) & 3) * 16);
#pragma unroll
                for (int bj = 0; bj < 2; ++bj)
#pragma unroll
                    for (int n = 0; n < 2; ++n) xn[bj][n] = *(const f32x4*)(x + rown * D + col0 + bj * HALF + n * 16); }
#pragma unroll
            for (int bj = 0; bj < 2; ++bj)
#pragma unroll
                for (int n = 0; n < 2; ++n) { const int col = col0 + bj * HALF + n * 16;
                    const f32x4 v = xc[bj][n] + gv[bj][n] * acc[ai][bj][m][n];
                    *(f32x4*)(x1 + row * D + col) = v; ss += (v[0] * v[0] + v[1] * v[1]) + (v[2] * v[2] + v[3] * v[3]);
                    const f32x4 vm = v * m2[bj][n]; u32x2 w; w.x = pk2(vm[0], vm[1]); w.y = pk2(vm[2], vm[3]); *(u32x2*)(x1m + row * D + col) = w; }
            ss += __shfl_xor(ss, 16); ss += __shfl_xor(ss, 32);
            if (fq == 0) atomicAdd(sumsq + row, ss);
            __builtin_amdgcn_sched_barrier(0); }
    }
};
struct EpiUp {
    static constexpr bool PERM = true; static constexpr int MID_T = 0;
    const float* sumsq; const float* c2; bf16_t* uo;
    DI void operator()(AccRef acc, const Unit& u, int wr, int wc, int fr, int fq) const {
        const int row0 = u.pm * BM + wr * 64 + fr, col0 = u.pn * BM + wc * 32 + 8 * fq; const int b = (u.pm * BM) / T;
        const float* cb = c2 + (size_t)b * DFF + col0;
        f32x4 cv[2][2];
#pragma unroll
        for (int bj = 0; bj < 2; ++bj)
#pragma unroll
            for (int n = 0; n < 2; ++n) cv[bj][n] = *(const f32x4*)(cb + bj * HALF + 4 * n);
#pragma unroll
        for (int ai = 0; ai < 2; ++ai)
#pragma unroll
            for (int m = 0; m < 4; ++m) { const size_t row = (size_t)(row0 + ai * HALF + m * 16);
                const float rstd = rsqrtf(sumsq[row] * (1.f / D) + NORM_EPS);
#pragma unroll
                for (int bj = 0; bj < 2; ++bj) { f32x4 v0 = acc[ai][bj][m][0] * rstd + cv[bj][0], v1 = acc[ai][bj][m][1] * rstd + cv[bj][1];
#pragma unroll
                    for (int e = 0; e < 4; ++e) { const float a0 = fmaxf(v0[e], 0.f), a1 = fmaxf(v1[e], 0.f); v0[e] = a0 * a0; v1[e] = a1 * a1; }
                    u32x4 w; w.x = pk2(v0[0], v0[1]); w.y = pk2(v0[2], v0[3]); w.z = pk2(v1[0], v1[1]); w.w = pk2(v1[2], v1[3]);
                    *(u32x4*)(uo + row * DFF + col0 + bj * HALF) = w; } }
    }
};
struct EpiDown {
    static constexpr bool PERM = false; static constexpr int MID_T = 0;
    const float* mod; float* out;
    DI void operator()(AccRef acc, const Unit& u, int wr, int wc, int fr, int fq) const {
        const int row0 = u.pm * BM + wr * 64 + fr, col0 = u.pn * BM + wc * 32 + 4 * fq; const int b = (u.pm * BM) / T;
        const float* gt2 = mod + (size_t)b * 12288 + 10240;
        f32x4 gv[2][2];
#pragma unroll
        for (int bj = 0; bj < 2; ++bj)
#pragma unroll
            for (int n = 0; n < 2; ++n) gv[bj][n] = *(const f32x4*)(gt2 + col0 + bj * HALF + n * 16);
        f32x4 xn[2][2];
#pragma unroll
        for (int bj = 0; bj < 2; ++bj)
#pragma unroll
            for (int n = 0; n < 2; ++n) xn[bj][n] = *(const f32x4*)(out + (size_t)row0 * D + col0 + bj * HALF + n * 16);
#pragma unroll
        for (int gi = 0; gi < 8; ++gi) { const int ai = gi >> 2, m = gi & 3; const size_t row = (size_t)(row0 + ai * HALF + m * 16);
            f32x4 xc[2][2];
#pragma unroll
            for (int bj = 0; bj < 2; ++bj)
#pragma unroll
                for (int n = 0; n < 2; ++n) xc[bj][n] = xn[bj][n];
            if (gi < 7) { const size_t rown = (size_t)(row0 + ((gi + 1) >> 2) * HALF + ((gi + 1) & 3) * 16);
#pragma unroll
                for (int bj = 0; bj < 2; ++bj)
#pragma unroll
                    for (int n = 0; n < 2; ++n) xn[bj][n] = *(const f32x4*)(out + rown * D + col0 + bj * HALF + n * 16); }
#pragma unroll
            for (int bj = 0; bj < 2; ++bj)
#pragma unroll
                for (int n = 0; n < 2; ++n) *(f32x4*)(out + row * D + col0 + bj * HALF + n * 16) = xc[bj][n] + gv[bj][n] * acc[ai][bj][m][n];
            __builtin_amdgcn_sched_barrier(0); }
    }
};

struct Args { const float* in[32]; float* out; unsigned char* ws; int ph_lo, ph_hi; };
struct Frame {
    unsigned char* lds; LAS unsigned char* lds3;
    int tid, lane, wave, gw, NGW, G, blk;
    const float* const* in; float* out; unsigned char* ws;
};
#define LDS_WAIT() asm volatile("s_waitcnt lgkmcnt(0)" ::: "memory")

DI int win_map(int n) {
    if (n < 3072) return n;
    if (n < 4096) return 3360 + (n - 3072);
    if (n < 5632) return 4384 + (n - 4096);
    if (n < 9728) return 5968 + (n - 5632);
    if (n < 10016) return 3072 + (n - 9728);
    if (n < 10064) return 5920 + (n - 10016);
    return -1;
}
DI void transpose_item(const float* __restrict__ W, int ldW, int K, bf16_t* __restrict__ WT, int ldT, int k0, int n0, bool wmap, unsigned* scr, int lane) {
    const int n4 = lane & 15, kq = lane >> 4; const int nn = n0 + 4 * n4; const int src = wmap ? win_map(nn) : nn;
    f32x4 v[16];
#pragma unroll
    for (int i = 0; i < 16; ++i) { const int k = k0 + 8 * (i >> 1) + 2 * kq + (i & 1);
        v[i] = (f32x4){0.f, 0.f, 0.f, 0.f}; if (src >= 0 && k < K) v[i] = *(const f32x4*)(W + (size_t)k * ldW + src); }
#pragma unroll
    for (int p = 0; p < 8; ++p)
#pragma unroll
        for (int e = 0; e < 4; ++e) scr[(4 * n4 + e) * 33 + 4 * p + kq] = pk2(v[2 * p][e], v[2 * p + 1][e]);
    LDS_WAIT(); asm volatile("" ::: "memory");
    const int c = lane & 7;
    if (k0 + 8 * c < K) {
#pragma unroll
        for (int j = 0; j < 8; ++j) { const int n = (lane >> 3) + 8 * j; const unsigned* sp = scr + n * 33 + 4 * c;
            *(u32x4*)(WT + (size_t)(n0 + n) * ldT + k0 + 8 * c) = (u32x4){sp[0], sp[1], sp[2], sp[3]}; }
    }
    LDS_WAIT(); asm volatile("" ::: "memory");
}
DI int rel_bucket_dev(int rel) {
    if (rel < 16) return rel;
    const int thr[15] = {19, 21, 24, 27, 31, 35, 40, 46, 52, 59, 67, 77, 87, 99, 113};
    int bkt = 16;
#pragma unroll
    for (int i = 0; i < 15; ++i) bkt += (rel >= thr[i]) ? 1 : 0;
    return bkt;
}
DI void phase_a(Frame& F, bool first) {
    unsigned* scr = (unsigned*)(F.lds + F.wave * 8448);
    float* sc = (float*)(F.lds + 73728);
    const float* c = F.in[1];
    for (int i = F.tid; i < BATCH * D; i += NTHREADS) { const int b = i >> 11, d = i & 2047; const float cv = c[i]; sc[d * 8 + b] = cv / (1.f + __expf(-cv)); }
    __syncthreads();
    if (first) {
        const float* w_ada = F.in[2]; const float* b_ada = F.in[3]; float* mod = (float*)(F.ws + WS_MOD);
        for (int item = F.gw; item < 1536; item += F.NGW) {
            const int cgi = item % 48, ds = item / 48, c0 = 256 * cgi + 4 * F.lane, d0 = 64 * ds;
            f32x4 acc[8];
#pragma unroll
            for (int b = 0; b < 8; ++b) acc[b] = (f32x4){0.f, 0.f, 0.f, 0.f};
#pragma unroll 8
            for (int d = d0; d < d0 + 64; ++d) {
                const f32x4 wv = *(const f32x4*)(w_ada + (size_t)d * 12288 + c0);
                const f32x4 s0 = *(const f32x4*)(sc + d * 8), s1 = *(const f32x4*)(sc + d * 8 + 4);
                acc[0] += s0[0] * wv; acc[1] += s0[1] * wv; acc[2] += s0[2] * wv; acc[3] += s0[3] * wv;
                acc[4] += s1[0] * wv; acc[5] += s1[1] * wv; acc[6] += s1[2] * wv; acc[7] += s1[3] * wv;
            }
            f32x4 bv = (f32x4){0.f, 0.f, 0.f, 0.f}; if (ds == 0) bv = *(const f32x4*)(b_ada + c0);
#pragma unroll
            for (int b = 0; b < 8; ++b)
#pragma unroll
                for (int e = 0; e < 4; ++e) atomicAdd(mod + (size_t)b * 12288 + c0 + e, acc[b][e] + bv[e]);
        }
    }
    {
        struct MatD { const float* W; int ldW, K; size_t off; int ldT, nblk, kblk; bool wmap; };
        const MatD mats[13] = {
            {F.in[6], IN_COLS, 2048, WS_WIN, 2048, NCOLS / 64, 32, true},
            {F.in[27], 2048, 1024, WS_WOA, 2048, 32, 16, false},
            {F.in[28], 2048, 1024, WS_WOA + 2048, 2048, 32, 16, false},
            {F.in[29], 2048, 2048, WS_WOUT, 2048, 32, 32, false},
            {F.in[30], 8192, 2048, WS_WUP, 2048, 128, 32, false},
            {F.in[31], 2048, 8192, WS_WDOWN, 8192, 32, 128, false},
            {F.in[9], 1024, 64, WS_W2T, 64, 16, 1, false},
            {F.in[11], 1024, 64, WS_A2T, 64, 16, 1, false},
            {F.in[12], 1024, 160, WS_G2T, 160, 16, 3, false},
            {F.in[19], 64, 2048, WS_CW1K, 2048, 1, 32, false},
            {F.in[22], 64, 2048, WS_CW1V, 2048, 1, 32, false},
            {F.in[20], 64, 64, WS_CW2K, 64, 1, 1, false},
            {F.in[23], 64, 64, WS_CW2V, 64, 1, 1, false}};
        int total = 0;
#pragma unroll
        for (int i = 0; i < 13; ++i) total += mats[i].nblk * mats[i].kblk;
        for (int it = F.gw; it < total; it += F.NGW) {
            int r = it, mi = 0;
#pragma unroll
            for (int i = 0; i < 12; ++i) { const int cnt = mats[i].nblk * mats[i].kblk; if (mi == i && r >= cnt) { r -= cnt; mi = i + 1; } }
            const float* W = mats[0].W; int ldW = mats[0].ldW, K = mats[0].K, ldT = mats[0].ldT, nblk = mats[0].nblk; size_t off = mats[0].off; bool wm = mats[0].wmap;
#pragma unroll
            for (int i = 1; i < 13; ++i) if (mi == i) { W = mats[i].W; ldW = mats[i].ldW; K = mats[i].K; ldT = mats[i].ldT; nblk = mats[i].nblk; off = mats[i].off; wm = mats[i].wmap; }
            const int kb = r / nblk, nb = r % nblk;
            transpose_item(W, ldW, K, (bf16_t*)(F.ws + off), ldT, 64 * kb, 64 * nb, wm, scr, F.lane);
        }
    }
    const int gt = F.blk * NTHREADS + F.tid;
    if (gt < 2048) { const int hq = gt >> 7, rel = gt & 127; const float* rb = F.in[26];
        ((float*)(F.ws + WS_BIAS))[gt] = rb[rel_bucket_dev(rel) * 16 + hq] - rb[31 * 16 + hq]; }
    if (gt >= 4096 && gt < 4096 + 2048) { const int i = gt - 4096, b = i >> 8, e = i & 255; ((bf16_t*)(F.ws + WS_KC))[((size_t)(b * 128 + 127)) * 256 + e] = 0; }
    if (gt >= 8192 && gt < 8192 + 2048) { const int i = gt - 8192; ((bf16_t*)(F.ws + WS_VCT))[(size_t)i * 128 + 127] = 0; }
    if (F.gw == F.NGW - 1 || F.gw == F.NGW - 2) {
        const int kv = (F.gw == F.NGW - 1) ? 0 : 1; const float* pe = F.in[kv ? 21 : 18]; const float* w1 = F.in[kv ? 22 : 19];
        float a = 0.f;
        for (int k = 0; k < 2048; ++k) a += pe[k] * w1[(size_t)k * 64 + F.lane];
        ((float*)(F.ws + WS_CPE))[kv * 64 + F.lane] = a;
    }
}

DI void phase_b(Frame& F) {
    const float* mod = (const float*)(F.ws + WS_MOD);
    const float* x = F.in[0]; const float* g1 = F.in[4]; const float* g2 = F.in[5];
    bf16_t* H = (bf16_t*)(F.ws + WS_H);
    float* sh2 = (float*)F.lds;
    for (int i = F.tid; i < BATCH * D; i += NTHREADS) { const int b = i >> 11, d = i & 2047; sh2[i] = mod[(size_t)b * 12288 + 6144 + d]; }
    __syncthreads();
    for (int m0 = F.gw * 8; m0 < M; m0 += F.NGW * 8) {
        const int b = m0 / T; const float* mb = mod + (size_t)b * 12288;
        f32x4 cf[8], sh[8], v[8], vn[8];
#pragma unroll
        for (int j = 0; j < 8; ++j) { const int col = 4 * F.lane + 256 * j; vn[j] = *(const f32x4*)(x + (size_t)m0 * D + col);
            cf[j] = *(const f32x4*)(g1 + col) * (1.f + *(const f32x4*)(mb + 2048 + col)); sh[j] = *(const f32x4*)(mb + col); }
#pragma unroll 1
        for (int k = 0; k < 8; ++k) { const int m = m0 + k;
#pragma unroll
            for (int j = 0; j < 8; ++j) v[j] = vn[j];
            const int mn = (k < 7) ? m + 1 : m;
#pragma unroll
            for (int j = 0; j < 8; ++j) vn[j] = *(const f32x4*)(x + (size_t)mn * D + 4 * F.lane + 256 * j);
            float ss = 0.f;
#pragma unroll
            for (int j = 0; j < 8; ++j) ss += (v[j][0] * v[j][0] + v[j][1] * v[j][1]) + (v[j][2] * v[j][2] + v[j][3] * v[j][3]);
            const float rstd = rsqrtf(wave_sum_dpp(ss) * (1.f / D) + NORM_EPS);
#pragma unroll
            for (int j = 0; j < 8; ++j) { const int col = 4 * F.lane + 256 * j;
                const f32x4 o = (v[j] * rstd) * cf[j] + sh[j];
                u32x2 w; w.x = pk2(o[0], o[1]); w.y = pk2(o[2], o[3]); *(u32x2*)(H + (size_t)m * D + col) = w; }
        }
    }
    for (int i = F.blk * NTHREADS + F.tid; i < BATCH * D; i += F.G * NTHREADS) { const int b = i >> 11, d = i & 2047;
        ((float*)(F.ws + WS_M2V))[i] = g2[d] * (1.f + mod[(size_t)b * 12288 + 8192 + d]); }
    const bf16_t* wup = (const bf16_t*)(F.ws + WS_WUP); float* c2 = (float*)(F.ws + WS_C2);
    for (int n = F.gw; n < DFF; n += F.NGW) {
        u32x4 wv[4];
#pragma unroll
        for (int j = 0; j < 4; ++j) wv[j] = *(const u32x4*)(wup + (size_t)n * D + 8 * F.lane + 512 * j);
#pragma unroll 1
        for (int b = 0; b < 8; ++b) { float p = 0.f;
#pragma unroll
            for (int j = 0; j < 4; ++j) { const float* s = sh2 + b * 2048 + 8 * F.lane + 512 * j; const f32x4 s0 = *(const f32x4*)s, s1 = *(const f32x4*)(s + 4);
                p += lo16(wv[j].x) * s0[0] + hi16(wv[j].x) * s0[1] + lo16(wv[j].y) * s0[2] + hi16(wv[j].y) * s0[3]
                   + lo16(wv[j].z) * s1[0] + hi16(wv[j].z) * s1[1] + lo16(wv[j].w) * s1[2] + hi16(wv[j].w) * s1[3]; }
            p = wave_sum_dpp(p); if (F.lane == 0) c2[(size_t)b * DFF + n] = p; }
    }
}

DI f32x4 mfma16(bf16x8 a, bf16x8 b, f32x4 c) { return __builtin_amdgcn_mfma_f32_16x16x32_bf16(a, b, c, 0, 0, 0); }
DI f32x16 mfma32(bf16x8 a, bf16x8 b, f32x16 c) { return __builtin_amdgcn_mfma_f32_32x32x16_bf16(a, b, c, 0, 0, 0); }
DI float fast_tanh(float x) { const float xc = fminf(fmaxf(x, -15.f), 15.f); const float t = __expf(2.f * xc); return (t - 1.f) * __builtin_amdgcn_rcpf(t + 1.f); }
DI float gelu_tanh(float x) { const float u = 0.7978845608028654f * (x + 0.044715f * x * x * x); return 0.5f * x * (1.f + fast_tanh(u)); }
DI float softplusf_(float x) { return fmaxf(x, 0.f) + __logf(1.f + __expf(-fabsf(x))); }
DI unsigned short f2h(float f) { return __builtin_bit_cast(unsigned short, (_Float16)f); }
DI float h2f(unsigned short u) { return (float)__builtin_bit_cast(_Float16, u); }

DI void compress_pair(Frame& F, int pair) {
    const int grp = F.wave >> 2, wq = F.wave & 3, it = 2 * pair + grp;
    const int kv = it >> 8, r_ = it & 255, b = r_ >> 5, g = (r_ >> 3) & 3, nb = r_ & 7;
    const int m = F.lane & 15, q = F.lane >> 4, n = 16 * nb + m; const bool nvalid = n < NC;
    const bf16_t* PKV = (const bf16_t*)(F.ws + WS_PKV);
    const bf16_t* xbase = PKV + (size_t)(b * T + 16 * n) * 1536 + kv * 256 + g * 64;
    const bf16_t* w1t = (const bf16_t*)(F.ws + (kv ? WS_CW1V : WS_CW1K));
    const bf16_t* w2t = (const bf16_t*)(F.ws + (kv ? WS_CW2V : WS_CW2K));
    const float* cpe = (const float*)(F.ws + WS_CPE) + kv * 64;
    f32x4* part = (f32x4*)F.lds;
    f32x4 acc[4];
#pragma unroll
    for (int i = 0; i < 4; ++i) acc[i] = (f32x4){0.f, 0.f, 0.f, 0.f};
#pragma unroll 4
    for (int ks = 16 * wq; ks < 16 * wq + 16; ++ks) {
        const int k = 32 * ks + 8 * q, tok = k >> 6, d = k & 63;
        bf16x8 bfr = (bf16x8){0, 0, 0, 0, 0, 0, 0, 0};
        if (nvalid) bfr = *(const bf16x8*)(xbase + (size_t)tok * 1536 + d);
#pragma unroll
        for (int ht = 0; ht < 4; ++ht) { const bf16x8 afr = *(const bf16x8*)(w1t + (size_t)(16 * ht + m) * 2048 + k); acc[ht] = mfma16(afr, bfr, acc[ht]); }
    }
#pragma unroll
    for (int ht = 0; ht < 4; ++ht) part[((grp * 4 + wq) * 4 + ht) * 64 + F.lane] = acc[ht];
    __syncthreads();
    if (wq == 0) {
#pragma unroll
        for (int ht = 0; ht < 4; ++ht) { acc[ht] = (part[((grp * 4 + 0) * 4 + ht) * 64 + F.lane] + part[((grp * 4 + 1) * 4 + ht) * 64 + F.lane]) + (part[((grp * 4 + 2) * 4 + ht) * 64 + F.lane] + part[((grp * 4 + 3) * 4 + ht) * 64 + F.lane]);
            const f32x4 cp = *(const f32x4*)(cpe + 16 * ht + 4 * q);
#pragma unroll
            for (int e = 0; e < 4; ++e) acc[ht][e] = gelu_tanh(acc[ht][e] + cp[e]); }
        f32x4 out[4];
#pragma unroll
        for (int i = 0; i < 4; ++i) out[i] = (f32x4){0.f, 0.f, 0.f, 0.f};
#pragma unroll
        for (int kk2 = 0; kk2 < 2; ++kk2) {
            u32x4 bw; bw.x = pk2(acc[2 * kk2][0], acc[2 * kk2][1]); bw.y = pk2(acc[2 * kk2][2], acc[2 * kk2][3]); bw.z = pk2(acc[2 * kk2 + 1][0], acc[2 * kk2 + 1][1]); bw.w = pk2(acc[2 * kk2 + 1][2], acc[2 * kk2 + 1][3]);
            const bf16x8 bfr = __builtin_bit_cast(bf16x8, bw);
#pragma unroll
            for (int dt = 0; dt < 4; ++dt) { const bf16_t* wp = w2t + (size_t)(16 * dt + m) * 64 + 32 * kk2 + 4 * q;
                const u32x2 lo = *(const u32x2*)wp, hi = *(const u32x2*)(wp + 16); u32x4 aw = {lo.x, lo.y, hi.x, hi.y};
                out[dt] = mfma16(__builtin_bit_cast(bf16x8, aw), bfr, out[dt]); }
        }
        if (kv == 0) {
            float ss = 0.f;
#pragma unroll
            for (int dt = 0; dt < 4; ++dt)
#pragma unroll
                for (int e = 0; e < 4; ++e) ss += out[dt][e] * out[dt][e];
            ss += __shfl_xor(ss, 16); ss += __shfl_xor(ss, 32);
            const float rstd = rsqrtf(ss * (1.f / 64.f) + NORM_EPS); const float* kg = F.in[25];
            if (nvalid) {
                bf16_t* kc = (bf16_t*)(F.ws + WS_KC) + ((size_t)(b * 128 + n) * 4 + g) * 64;
#pragma unroll
                for (int dt = 0; dt < 4; ++dt) { const int d = 16 * dt + 4 * q; const f32x4 gv = *(const f32x4*)(kg + d); const f32x4 o = out[dt] * rstd * gv;
                    u32x2 w; w.x = pk2(o[0], o[1]); w.y = pk2(o[2], o[3]); *(u32x2*)(kc + d) = w; }
            }
        } else if (nvalid) {
            bf16_t* vct = (bf16_t*)(F.ws + WS_VCT) + (size_t)(b * 4 + g) * 64 * 128 + n;
#pragma unroll
            for (int dt = 0; dt < 4; ++dt)
#pragma unroll
                for (int e = 0; e < 4; ++e) vct[(size_t)(16 * dt + 4 * q + e) * 128] = (bf16_t)f2bf(out[dt][e]);
        }
    }
    __syncthreads();
}

template <int N> DI float row_shr(float v) { return __builtin_bit_cast(float, __builtin_amdgcn_update_dpp(0, __builtin_bit_cast(int, v), 0x110 + N, 0xf, 0xf, true)); }
DI float row_bcast15(float v) { return __builtin_bit_cast(float, __builtin_amdgcn_update_dpp(0, __builtin_bit_cast(int, v), 0x150 + 15, 0xf, 0xf, true)); }
template <int DMODE, int SV = 0> DI void phase_d(Frame& F) {
    constexpr bool first = (DMODE == 0);
    if (DMODE != 3) for (int pr = F.blk; pr < 256; pr += F.G) compress_pair(F, pr);
    const bf16_t* PR = (const bf16_t*)(F.ws + WS_PR); const bf16_t* PK = (const bf16_t*)(F.ws + WS_PK); const bf16_t* PV = (const bf16_t*)(F.ws + WS_PV);
    const bf16_t* PMISC = (const bf16_t*)(F.ws + WS_PMISC);
    bf16_t* PQ = (bf16_t*)(F.ws + WS_PQ); bf16_t* PKV = (bf16_t*)(F.ws + WS_PKV);
    bf16_t* AT = (bf16_t*)((char*)F.out + DO_AT); bf16_t* BT = (bf16_t*)((char*)F.out + DO_BT); bf16_t* KT = (bf16_t*)((char*)F.out + DO_KT); bf16_t* RT = (bf16_t*)((char*)F.out + DO_RT);
    bf16_t* VM = (bf16_t*)(F.ws + WS_VM); float* GL = (float*)(F.ws + WS_GL);
    bf16_t* GRW = (bf16_t*)(F.ws + WS_GRW); float* BSUM = (float*)(F.ws + WS_BSUM); float* GATES = (float*)(F.ws + WS_GATES);
    const bf16_t* W2T = (const bf16_t*)(F.ws + WS_W2T); const bf16_t* A2T = (const bf16_t*)(F.ws + WS_A2T); const bf16_t* G2T = (const bf16_t*)(F.ws + WS_G2T);
    const float* mu = F.in[7]; const float* w0 = F.in[8]; const float* a0 = F.in[10]; const float* k_k = F.in[13]; const float* k_a = F.in[14]; const float* r_k = F.in[15];
    const float* q_g = F.in[24]; const float* k_g = F.in[25];
    bf16_t* XW = (bf16_t*)F.lds; bf16_t* XA = (bf16_t*)(F.lds + 9216); bf16_t* XG = (bf16_t*)(F.lds + 18432); bf16_t* VT = (bf16_t*)(F.lds + 40960);
    const int q = F.lane >> 4, l16 = F.lane & 15;
    for (int tl = F.blk; tl < M / 64; tl += F.G) {
        const int rowbase = tl * 64, b = rowbase / T, t0 = rowbase % T;
        int tidl = threadIdx.x; asm volatile("" : "+v"(tidl));
#pragma unroll 10
        for (int idx = tidl; idx < 64 * 160; idx += NTHREADS) { const int tok = idx / 160, c = 128 + (idx - tok * 160); const size_t row = rowbase + tok;
            const float cur = bf2f(PMISC[row * 512 + c]); const float prev = (t0 + tok > 0) ? bf2f(PMISC[(row - 1) * 512 + c]) : 0.f;
            const float mv = cur + (prev - cur) * mu[3072 + c];
            XG[tok * 168 + c - 128] = (bf16_t)f2bf(sigmoidf_(mv)); }
#pragma unroll 3
        for (int idx = tidl; idx < 64 * 48; idx += NTHREADS) { const int tok = idx / 48, j = idx - tok * 48; const size_t row = rowbase + tok;
            GATES[row * 48 + j] = sigmoidf_(bf2f(PMISC[row * 512 + 288 + j])); }
#pragma unroll
        for (int i = 0; i < 8; ++i) { const int idx = tidl + NTHREADS * i, s = idx >> 11, rem = idx & 2047, tok = rem >> 5, ch8 = rem & 31;
            const u32x4 v = *(const u32x4*)(PKV + (size_t)(rowbase + tok) * 1536 + (3 + 2 * s) * 256 + ch8 * 8);
            *(u32x4*)(VT + (size_t)(s * 64 + tok) * 264 + ch8 * 8) = v; }
        __syncthreads();
        if (DMODE != 3) { const int s = tidl >> 8, gd = tidl & 255;
          bf16_t* dst = (bf16_t*)(F.ws + (s ? WS_VWT : WS_VST)) + ((size_t)(b * 4 + (gd >> 6)) * 64 + (gd & 63)) * 2048 + t0;
#pragma unroll
          for (int i = 0; i < 8; ++i) { unsigned pk[4];
#pragma unroll
              for (int e = 0; e < 4; ++e) pk[e] = (unsigned)VT[(size_t)(s * 64 + 8 * i + 2 * e) * 264 + gd] | ((unsigned)VT[(size_t)(s * 64 + 8 * i + 2 * e + 1) * 264 + gd] << 16);
              *(u32x4*)(dst + 8 * i) = (u32x4){pk[0], pk[1], pk[2], pk[3]}; } }
#pragma unroll 1
        for (int hh = 0; hh < ((DMODE == 2) ? 0 : 2); ++hh) {
            const int head = 2 * F.wave + hh;
            const unsigned rowoff0 = (unsigned)(rowbase + l16) * 1024u + (unsigned)(head * 64 + 4 * q);
            bf16x8 fgn[5];
#pragma unroll
            for (int ks = 0; ks < 5; ++ks) fgn[ks] = *(const bf16x8*)(G2T + (size_t)(head * 64 + l16) * 160 + 32 * ks + 8 * q);
#pragma unroll 1
            for (int ct = 0; ct < 4; ++ct) {
                bf16x8 fg[5];
#pragma unroll
                for (int ks = 0; ks < 5; ++ks) fg[ks] = fgn[ks];
                { const int ctn = (ct < 3) ? ct + 1 : ct;
#pragma unroll
                  for (int ks = 0; ks < 5; ++ks) fgn[ks] = *(const bf16x8*)(G2T + (size_t)(head * 64 + 16 * ctn + l16) * 160 + 32 * ks + 8 * q); }
#pragma unroll
                for (int tt = 0; tt < 4; ++tt) { const int tokl = 16 * tt + l16; f32x4 ag = {0.f, 0.f, 0.f, 0.f};
#pragma unroll
                    for (int ks = 0; ks < 5; ++ks) ag = mfma16(fg[ks], *(const bf16x8*)(XG + tokl * 168 + 32 * ks + 8 * q), ag);
                    u32x2 w; w.x = pk2(ag[0], ag[1]); w.y = pk2(ag[2], ag[3]); *(u32x2*)(GRW + (rowoff0 + (unsigned)(tt * 16384) + (unsigned)(ct * 16))) = w; }
            }
        }
#pragma unroll 8
        for (int it = 0; it < (first ? 32 : 0); ++it) { const int pair = (F.wave * 32 + it) * 4 + q, tok = pair >> 4, head = pair & 15;
            bf16_t* p = PQ + (size_t)(rowbase + tok) * 1024 + head * 64 + 4 * l16; const u32x2 v = *(const u32x2*)p;
            f32x4 f = {lo16(v.x), hi16(v.x), lo16(v.y), hi16(v.y)}; float ss = (f[0] * f[0] + f[1] * f[1]) + (f[2] * f[2] + f[3] * f[3]);
            ss += __shfl_xor(ss, 1); ss += __shfl_xor(ss, 2); ss += __shfl_xor(ss, 4); ss += __shfl_xor(ss, 8);
            const float rstd = rsqrtf(ss * (1.f / 64.f) + NORM_EPS) * (0.125f * LOG2E); f = f * rstd * *(const f32x4*)(q_g + 4 * l16);
            u32x2 w; w.x = pk2(f[0], f[1]); w.y = pk2(f[2], f[3]); *(u32x2*)p = w; }
#pragma unroll 8
        for (int it = 0; it < (first ? 16 : 0); ++it) { const int pair = (F.wave * 16 + it) * 4 + q, tok = pair >> 3, sg = pair & 7, slot = (sg >> 2) ? 4 : 2, g = sg & 3;
            bf16_t* p = PKV + (size_t)(rowbase + tok) * 1536 + slot * 256 + g * 64 + 4 * l16; const u32x2 v = *(const u32x2*)p;
            f32x4 f = {lo16(v.x), hi16(v.x), lo16(v.y), hi16(v.y)}; float ss = (f[0] * f[0] + f[1] * f[1]) + (f[2] * f[2] + f[3] * f[3]);
            ss += __shfl_xor(ss, 1); ss += __shfl_xor(ss, 2); ss += __shfl_xor(ss, 4); ss += __shfl_xor(ss, 8);
            const float rstd = rsqrtf(ss * (1.f / 64.f) + NORM_EPS); f = f * rstd * *(const f32x4*)(k_g + ((slot == 2) ? 64 : 128) + 4 * l16);
            u32x2 w; w.x = pk2(f[0], f[1]); w.y = pk2(f[2], f[3]); *(u32x2*)p = w; }
        __syncthreads();
    }
}

typedef short s16x4v __attribute__((ext_vector_type(4)));
DI f32x4 mfma16k(s16x4v a, s16x4v b, f32x4 c) { return __builtin_amdgcn_mfma_f32_16x16x16bf16_1k(a, b, c, 0, 0, 0); }
DI s16x4v packbf4(f32x4 v) { u32x2 w = {pk2(v[0], v[1]), pk2(v[2], v[3])}; return __builtin_bit_cast(s16x4v, w); }
DI f32x4 unpackbf4(s16x4v v) { const u32x2 w = __builtin_bit_cast(u32x2, v); return (f32x4){lo16(w.x), hi16(w.x), lo16(w.y), hi16(w.y)}; }
DI s16x4v trread(LAS unsigned char* p) { return __builtin_bit_cast(s16x4v, __builtin_amdgcn_ds_read_tr16_b64_v4i16((LAS s16x4v*)p)); }
constexpr int RC_AT = 0, RC_BT = 9216, RC_KT = 18432, RC_RT = 27648, RC_VV = 36864;
constexpr int RC_MAB = 46080, RC_T = 54272, RC_YO = 46080;
constexpr int RC_MBR = 63488, RC_GY = 71680, RC_GS = 79872, RC_HY = 88064, RC_HS = 96256, RC_S = 104448;
DI f32x4 tile_ch64(const unsigned char* Am, int a0, const unsigned char* Bm, int b0, int c16, int g) {
    f32x4 acc = {0.f, 0.f, 0.f, 0.f};
#pragma unroll
    for (int ks = 0; ks < 2; ++ks) acc = mfma16(*(const bf16x8*)(Am + (a0 + c16) * 144 + (32 * ks + 8 * g) * 2), *(const bf16x8*)(Bm + (b0 + c16) * 144 + (32 * ks + 8 * g) * 2), acc);
    return acc;
}
constexpr int RC_XW = 46080, RC_XA = 55296;
constexpr int RC_RAWR = 64512, RC_RAWK = 73872, RC_RAWV = 83232;
constexpr int RC_RAWX = 120832;
constexpr int RC_SSK = 138512, RC_BSP = 139536, RC_GLV = 140560, RC_BS = 140816, RC_PRM = 141072, RC_CARRY = 143120, RC_MUX = 143760;
DI void rwkv_head(Frame& F, int hd) {
    const int b = hd >> 4, h = hd & 15;
    unsigned char* L = F.lds; LAS unsigned char* L3 = F.lds3;
    const int lane0 = F.lane, w = F.wave;
    const bf16_t* PR = (const bf16_t*)(F.ws + WS_PR); const bf16_t* PK = (const bf16_t*)(F.ws + WS_PK); const bf16_t* PV = (const bf16_t*)(F.ws + WS_PV); const bf16_t* PMISC = (const bf16_t*)(F.ws + WS_PMISC);
    const bf16_t* GRW = (const bf16_t*)(F.ws + WS_GRW);
    bf16_t* OA = (bf16_t*)((char*)F.out + DO_OAB);
    const float* ln_w = F.in[16]; const float* ln_b = F.in[17]; const float* mu = F.in[7];
    float* SSK = (float*)(L + RC_SSK); float* BSP = (float*)(L + RC_BSP); float* GLV = (float*)(L + RC_GLV); float* BS = (float*)(L + RC_BS); float* PRM = (float*)(L + RC_PRM);
    u32x4 pre[5];
    auto fetch = [&](int c, int tid_) { const int srow = tid_ >> 3, sch = tid_ & 7, xrow = tid_ >> 4, xch = tid_ & 15; const size_t row = (size_t)b * T + 64 * c;
        const size_t off = (row + srow) * 1024 + h * 64 + 8 * sch;
        pre[0] = *(const u32x4*)(PR + off); pre[1] = *(const u32x4*)(PK + off); pre[2] = *(const u32x4*)(PV + off);
        pre[3] = *(const u32x4*)(PMISC + (row + xrow) * 512 + 8 * xch); pre[4] = *(const u32x4*)(PMISC + (row + xrow + 32) * 512 + 8 * xch); };
    auto commit = [&](int tid_) { const int srow = tid_ >> 3, sch = tid_ & 7, xrow = tid_ >> 4, xch = tid_ & 15;
        *(u32x4*)(L + RC_RAWR + (srow + 1) * 144 + sch * 16) = pre[0]; *(u32x4*)(L + RC_RAWK + (srow + 1) * 144 + sch * 16) = pre[1]; *(u32x4*)(L + RC_RAWV + (srow + 1) * 144 + sch * 16) = pre[2];
        *(u32x4*)(L + RC_RAWX + (xrow + 1) * 272 + xch * 16) = pre[3]; *(u32x4*)(L + RC_RAWX + (xrow + 33) * 272 + xch * 16) = pre[4];
        if (tid_ < 24) *(u32x4*)(L + RC_RAWR + (tid_ >> 3) * 9360 + (tid_ & 7) * 16) = *(const u32x4*)(L + RC_CARRY + tid_ * 16);
        if (tid_ >= 32 && tid_ < 48) *(u32x4*)(L + RC_RAWX + (tid_ & 15) * 16) = *(const u32x4*)(L + RC_CARRY + 384 + (tid_ & 15) * 16); };
    for (int i = F.tid; i < 8192 / 4; i += NTHREADS) ((unsigned*)(L + RC_S))[i] = 0u;
    if (F.tid < 40) *(u32x4*)(L + RC_CARRY + F.tid * 16) = (u32x4){0u, 0u, 0u, 0u};
    __syncthreads();
    { const float* w0 = F.in[8]; const float* a0 = F.in[10]; const float* k_k = F.in[13]; const float* k_a = F.in[14]; const float* r_k = F.in[15];
      const int arr = F.tid >> 6, ch = h * 64 + (F.tid & 63);
      PRM[F.tid] = (arr < 3) ? mu[arr * 1024 + ch] : (arr == 3) ? w0[ch] : (arr == 4) ? a0[ch] : (arr == 5) ? k_k[ch] : (arr == 6) ? k_a[ch] : r_k[ch]; }
    fetch(0, F.tid); commit(F.tid);
    const int ct = w & 3, th = w >> 2;
    bf16x8 fw[2], fa[2];
    { const bf16_t* W2T = (const bf16_t*)(F.ws + WS_W2T); const bf16_t* A2T = (const bf16_t*)(F.ws + WS_A2T); const int c16 = lane0 & 15, g = lane0 >> 4; const int chr = h * 64 + 16 * ct + c16;
#pragma unroll
      for (int ks = 0; ks < 2; ++ks) { fw[ks] = *(const bf16x8*)(W2T + (size_t)chr * 64 + 32 * ks + 8 * g); fa[ks] = *(const bf16x8*)(A2T + (size_t)chr * 64 + 32 * ks + 8 * g); } }
    __syncthreads();
    const int mytile = (w < 4) ? w : (w - 4);
    if (F.tid < 128) ((float*)(L + RC_MUX))[F.tid] = mu[3072 + F.tid];
    const float lnw = ln_w[h * 64 + lane0], lnb = ln_b[h * 64 + lane0];
    asm volatile("" :: "v"(lnw), "v"(lnb), "v"(fw[0]), "v"(fw[1]), "v"(fa[0]), "v"(fa[1]));
    __syncthreads();
#pragma unroll 1
    for (int c = 0; c < T / 64; ++c) {
        const int sb_cur = (c & 1) * 8192, sb_nxt = 8192 - sb_cur;
        int lane = lane0; asm volatile("" : "+v"(lane));
        const int c16 = lane & 15, g = lane >> 4;
        int tidl = F.tid; asm volatile("" : "+v"(tidl));
        if (c + 1 < T / 64) fetch(c + 1, tidl);
        unsigned short pgr[8];
#pragma unroll
        for (int it = 0; it < 8; ++it) { const size_t row = (size_t)b * T + 64 * c + w * 8 + it; pgr[it] = GRW[row * 1024 + h * 64 + lane]; }
        const f32x4 mxa = *(const f32x4*)(L + RC_MUX + (F.tid & 15) * 32), mxb = *(const f32x4*)(L + RC_MUX + (F.tid & 15) * 32 + 16);
        const float mux[8] = {mxa[0], mxa[1], mxa[2], mxa[3], mxb[0], mxb[1], mxb[2], mxb[3]};
#pragma unroll
        for (int i = 0; i < 2; ++i) { const int idx8 = F.tid + NTHREADS * i, tok = idx8 >> 4, cg = idx8 & 15;
            const u32x4 cu = *(const u32x4*)(L + RC_RAWX + (tok + 1) * 272 + cg * 16), pr = *(const u32x4*)(L + RC_RAWX + tok * 272 + cg * 16); u32x4 o;
#pragma unroll
            for (int e = 0; e < 4; ++e) { const float c0 = lo16(cu[e]), c1 = hi16(cu[e]), p0 = lo16(pr[e]), p1 = hi16(pr[e]);
                float m0 = c0 + (p0 - c0) * mux[2 * e], m1 = c1 + (p1 - c1) * mux[2 * e + 1];
                if (cg < 8) { m0 = fast_tanh(m0); m1 = fast_tanh(m1); }
                o[e] = pk2(m0, m1); }
            *(u32x4*)(L + ((cg < 8) ? (RC_XW + (tok * 72 + cg * 8) * 2) : (RC_XA + (tok * 72 + (cg - 8) * 8) * 2))) = o; }
        {
            const int tok = F.tid >> 3, c8 = F.tid & 7;
            const u32x4 kc = *(const u32x4*)(L + RC_RAWK + (tok + 1) * 144 + c8 * 16), kp = *(const u32x4*)(L + RC_RAWK + tok * 144 + c8 * 16);
            const f32x4 m0 = *(const f32x4*)(PRM + 64 + 8 * c8), m1 = *(const f32x4*)(PRM + 64 + 8 * c8 + 4), q0 = *(const f32x4*)(PRM + 5 * 64 + 8 * c8), q1 = *(const f32x4*)(PRM + 5 * 64 + 8 * c8 + 4);
            float ss = 0.f;
#pragma unroll
            for (int e = 0; e < 4; ++e) { const float c0 = lo16(kc[e]), c1 = hi16(kc[e]), p0 = lo16(kp[e]), p1 = hi16(kp[e]);
                const float mu0 = (e < 2) ? m0[2 * e] : m1[2 * e - 4], mu1 = (e < 2) ? m0[2 * e + 1] : m1[2 * e - 3], kq0 = (e < 2) ? q0[2 * e] : q1[2 * e - 4], kq1 = (e < 2) ? q0[2 * e + 1] : q1[2 * e - 3];
                const float k0 = (c0 + (p0 - c0) * mu0) * kq0, k1 = (c1 + (p1 - c1) * mu1) * kq1; ss += k0 * k0 + k1 * k1; }
            ss += dpp_mov<0xB1>(ss); ss += dpp_mov<0x4E>(ss); ss += dpp_mov<0x141>(ss);
            if (c8 == 0) SSK[tok] = ss; }
        lds_barrier();
        f32x4 axv[2], bxv[2];
        {
            f32x4 inc0 = {0.f, 0.f, 0.f, 0.f}, inc1 = inc0, wl0 = inc0, wl1 = inc0, carry = inc0;
            const float* prm = PRM + 16 * ct + 4 * g;
            const f32x4 w0v = *(const f32x4*)(prm + 3 * 64);
#pragma unroll
            for (int tt = 0; tt < 4; ++tt) {
                f32x4 aw = {0.f, 0.f, 0.f, 0.f};
#pragma unroll
                for (int ks = 0; ks < 2; ++ks) aw = mfma16(fw[ks], *(const bf16x8*)(L + RC_XW + ((16 * tt + c16) * 72 + 32 * ks + 8 * g) * 2), aw);
                f32x4 ic, wv;
#pragma unroll
                for (int e = 0; e < 4; ++e) { const float wpre = w0v[e] + aw[e]; const float wl = -0.6065306597126334f * __builtin_amdgcn_rcpf(1.f + __expf(-wpre));
                    float x = wl; x += row_shr<1>(x); x += row_shr<2>(x); x += row_shr<4>(x); x += row_shr<8>(x);
                    ic[e] = x + carry[e]; carry[e] += row_bcast15(x); wv[e] = wl; }
                if (tt == 2 * th) { inc0 = ic; wl0 = wv; }
                if (tt == 2 * th + 1) { inc1 = ic; wl1 = wv; }
            }
            const f32x4 mur = *(const f32x4*)(prm), muk = *(const f32x4*)(prm + 64), muv = *(const f32x4*)(prm + 128);
            const f32x4 a0v = *(const f32x4*)(prm + 4 * 64), kkw = *(const f32x4*)(prm + 5 * 64), kaw = *(const f32x4*)(prm + 6 * 64), rkw = *(const f32x4*)(prm + 7 * 64);
#pragma unroll
            for (int j = 0; j < 2; ++j) {
                const int tok = 32 * th + 16 * j + c16;
                f32x4 aa = {0.f, 0.f, 0.f, 0.f};
#pragma unroll
                for (int ks = 0; ks < 2; ++ks) aa = mfma16(fa[ks], *(const bf16x8*)(L + RC_XA + (tok * 72 + 32 * ks + 8 * g) * 2), aa);
                const f32x4 inc = (j == 0) ? inc0 : inc1, wl4 = (j == 0) ? wl0 : wl1;
                const int ro = ((tok + 1) * 72 + 16 * ct + 4 * g) * 2;
                const u32x2 kc_ = *(const u32x2*)(L + RC_RAWK + ro), kp_ = *(const u32x2*)(L + RC_RAWK + ro - 144), rc_ = *(const u32x2*)(L + RC_RAWR + ro), rp_ = *(const u32x2*)(L + RC_RAWR + ro - 144),
                            vc_ = *(const u32x2*)(L + RC_RAWV + ro), vp_ = *(const u32x2*)(L + RC_RAWV + ro - 144);
                const f32x4 kc4 = {lo16(kc_.x), hi16(kc_.x), lo16(kc_.y), hi16(kc_.y)}, kp4 = {lo16(kp_.x), hi16(kp_.x), lo16(kp_.y), hi16(kp_.y)};
                const f32x4 rc4 = {lo16(rc_.x), hi16(rc_.x), lo16(rc_.y), hi16(rc_.y)}, rp4 = {lo16(rp_.x), hi16(rp_.x), lo16(rp_.y), hi16(rp_.y)};
                const f32x4 vc4 = {lo16(vc_.x), hi16(vc_.x), lo16(vc_.y), hi16(vc_.y)}, vp4 = {lo16(vp_.x), hi16(vp_.x), lo16(vp_.y), hi16(vp_.y)};
                const f32x4 km = kc4 + (kp4 - kc4) * muk, rm = rc4 + (rp4 - rc4) * mur, vm = vc4 + (vp4 - vc4) * muv; f32x4 kt, rt;
                float bs = 0.f;
                const float inv = __builtin_amdgcn_rsqf(fmaxf(SSK[tok], 1e-24f));
#pragma unroll
                for (int e = 0; e < 4; ++e) {
                    const float ei = __expf(inc[e]), eiv = __builtin_amdgcn_rcpf(ei);
                    const float a = __builtin_amdgcn_rcpf(1.f + __expf(-(a0v[e] + aa[e])));
                    const float kk = km[e] * kkw[e] * inv;
                    axv[j][e] = -kk * (ei * __expf(-wl4[e])); bxv[j][e] = kk * a * eiv;
                    const float kpn = km[e] * (1.f + (a - 1.f) * kaw[e]);
                    bs += rm[e] * kpn * rkw[e];
                    kt[e] = kpn * eiv; rt[e] = rm[e] * ei;
                    if (th == 1 && j == 1 && c16 == 15) GLV[16 * ct + 4 * g + e] = ei;
                }
                bs = swap32_sum(swap16_sum(bs));
                if (g == 0) BSP[ct * 64 + tok] = bs;
                { const int o = (tok * 72 + 16 * ct + 4 * g) * 2;
                  *(s16x4v*)(L + RC_AT + o) = packbf4(axv[j]); *(s16x4v*)(L + RC_BT + o) = packbf4(bxv[j]);
                  *(s16x4v*)(L + RC_KT + o) = packbf4(kt); *(s16x4v*)(L + RC_RT + o) = packbf4(rt); *(s16x4v*)(L + RC_VV + o) = packbf4(vm); }
            }
        }
        lds_barrier();
        if (F.tid < 64) BS[F.tid] = (BSP[F.tid] + BSP[64 + F.tid]) + (BSP[128 + F.tid] + BSP[192 + F.tid]);
        if (F.tid >= 64 && F.tid < 88) { const int i = F.tid - 64, arr = i >> 3, pc = i & 7; *(u32x4*)(L + RC_CARRY + i * 16) = *(const u32x4*)(L + RC_RAWR + arr * 9360 + 64 * 144 + pc * 16); }
        if (F.tid >= 96 && F.tid < 112) { const int pc = F.tid - 96; *(u32x4*)(L + RC_CARRY + 384 + pc * 16) = *(const u32x4*)(L + RC_RAWX + 64 * 272 + pc * 16); }
        f32x4 glv;
#pragma unroll
        for (int cb = 0; cb < 4; ++cb) glv[cb] = GLV[16 * cb + c16];
        f32x4 Nq, NTq;
        {
            auto other_tile = [&](int idx) {
                int sb, tb; bool isbr;
                if (idx < 6) { isbr = false; sb = (int)((0x211000u >> (4 * idx)) & 0xfu); tb = (int)((0x332321u >> (4 * idx)) & 0xfu); }
                else { isbr = true; const int k = idx - 6; sb = (int)((0x3221110000ull >> (4 * k)) & 0xfull); tb = (int)((0x3323213210ull >> (4 * k)) & 0xfull); }
                f32x4 acc = tile_ch64(L + RC_BT, 16 * sb, L + (isbr ? RC_RT : RC_AT), 16 * tb, c16, g);
                if (isbr && sb == tb) {
#pragma unroll
                    for (int e = 0; e < 4; ++e) if (4 * g + e > c16) acc[e] = 0.f;
                }
                *(s16x4v*)(L + (isbr ? RC_MBR : RC_MAB) + (sb * 4 + tb) * 512 + lane * 8) = packbf4(acc);
            };
            if (w < 4) {
                Nq = tile_ch64(L + RC_BT, 16 * w, L + RC_AT, 16 * w, c16, g);
                NTq = tile_ch64(L + RC_AT, 16 * w, L + RC_BT, 16 * w, c16, g);
#pragma unroll
                for (int e = 0; e < 4; ++e) { if (4 * g + e >= c16) Nq[e] = 0.f; if (c16 >= 4 * g + e) NTq[e] = 0.f; }
#pragma unroll
                for (int k = 0; k < 4; ++k) other_tile(4 * w + k);
            }
        }
        f32x4 maktT[4], mkr[4];
        if (w < 4) {
            const f32x4 zero = {0.f, 0.f, 0.f, 0.f};
            f32x4 Id;
#pragma unroll
            for (int e = 0; e < 4; ++e) Id[e] = (4 * g + e == c16) ? 1.f : 0.f;
            const s16x4v nb = packbf4(Nq), ntb = packbf4(NTq);
            const f32x4 N2 = mfma16k(ntb, nb, zero), N2T = mfma16k(nb, ntb, zero);
            const s16x4v n2b = packbf4(N2), n2tb = packbf4(N2T);
            const f32x4 N4 = mfma16k(n2tb, n2b, zero), N4T = mfma16k(n2b, n2tb, zero);
            const s16x4v n4b = packbf4(N4), n4tb = packbf4(N4T);
            const s16x4v n8b = packbf4(mfma16k(n4tb, n4b, zero));
            const f32x4 T1 = Id + Nq, T1T = Id + NTq; const s16x4v t1tb = packbf4(T1T);
            const f32x4 T2 = mfma16k(t1tb, n2b, T1), T2T = mfma16k(n2b, t1tb, T1T); const s16x4v t2tb = packbf4(T2T);
            const f32x4 T3 = mfma16k(t2tb, n4b, T2), T3T = mfma16k(n4b, t2tb, T2T);
            const f32x4 T4 = mfma16k(packbf4(T3T), n8b, T3);
            *(s16x4v*)(L + RC_T + w * 512 + lane * 8) = packbf4(T4);
#pragma unroll
            for (int q = 0; q < 4; ++q) { maktT[q] = zero; mkr[q] = zero; }
        } else {
            const int st = w - 4;
#pragma unroll
            for (int tb = 0; tb < 4; ++tb) {
                f32x4 a1 = {0.f, 0.f, 0.f, 0.f}, a2 = a1;
                if (tb >= st) {
                    a1 = tile_ch64(L + RC_AT, 16 * tb, L + RC_KT, 16 * st, c16, g);
                    a2 = tile_ch64(L + RC_KT, 16 * st, L + RC_RT, 16 * tb, c16, g);
                    if (tb == st) {
#pragma unroll
                        for (int e = 0; e < 4; ++e) { if (c16 >= 4 * g + e) a1[e] = 0.f; if (4 * g + e > c16) a2[e] = 0.f; }
                    }
                }
                maktT[tb] = a1; mkr[tb] = a2;
            }
        }
        lds_barrier();
        s16x4v xb[4];
        {
            s16x4v mabi[6], ti[4], yi[4];
            mabi[0] = *(const s16x4v*)(L + RC_MAB + (0 * 4 + 1) * 512 + lane * 8); mabi[1] = *(const s16x4v*)(L + RC_MAB + (0 * 4 + 2) * 512 + lane * 8); mabi[2] = *(const s16x4v*)(L + RC_MAB + (1 * 4 + 2) * 512 + lane * 8);
            mabi[3] = *(const s16x4v*)(L + RC_MAB + (0 * 4 + 3) * 512 + lane * 8); mabi[4] = *(const s16x4v*)(L + RC_MAB + (1 * 4 + 3) * 512 + lane * 8); mabi[5] = *(const s16x4v*)(L + RC_MAB + (2 * 4 + 3) * 512 + lane * 8);
#pragma unroll
            for (int q = 0; q < 4; ++q) { ti[q] = *(const s16x4v*)(L + RC_T + q * 512 + lane * 8);
                if (w < 4) yi[q] = trread(L3 + RC_AT + (16 * q + 4 * g + ((lane >> 2) & 3)) * 144 + (16 * w) * 2 + 8 * (lane & 3)); }
            __builtin_amdgcn_sched_barrier(0);
#pragma unroll
            for (int q = 0; q < 4; ++q) {
                f32x4 y = (w < 4) ? unpackbf4(yi[q]) : maktT[q];
#pragma unroll
                for (int p = 0; p < 4; ++p) if (p < q) y = mfma16k(mabi[(q == 1) ? 0 : (q == 2) ? (1 + p) : (3 + p)], xb[p], y);
                const f32x4 xq = mfma16k(ti[q], packbf4(y), (f32x4){0.f, 0.f, 0.f, 0.f});
                xb[q] = packbf4(xq);
            }
        }
        {
            s16x4v mbri[10]; u32x2 rvi[4];
#pragma unroll
            for (int tb = 0; tb < 4; ++tb) {
#pragma unroll
                for (int sb = 0; sb < 4; ++sb) if (sb <= tb) mbri[tb * (tb + 1) / 2 + sb] = *(const s16x4v*)(L + RC_MBR + (sb * 4 + tb) * 512 + lane * 8);
                if (w < 4) rvi[tb] = *(const u32x2*)(L + RC_RT + (16 * tb + c16) * 144 + (16 * w + 4 * g) * 2); }
            __builtin_amdgcn_sched_barrier(0);
#pragma unroll
            for (int tb = 0; tb < 4; ++tb) {
                f32x4 acc;
                if (w < 4) acc = (f32x4){lo16(rvi[tb].x), hi16(rvi[tb].x), lo16(rvi[tb].y), hi16(rvi[tb].y)};
                else acc = mkr[tb];
#pragma unroll
                for (int sb = 0; sb < 4; ++sb) if (sb <= tb) acc = mfma16k(xb[sb], mbri[tb * (tb + 1) / 2 + sb], acc);
                *(s16x4v*)(L + ((w < 4) ? RC_GY : RC_HY) + (mytile * 4 + tb) * 512 + lane * 8) = packbf4(acc);
            }
        }
#pragma unroll
        for (int ch2 = 0; ch2 < 2; ++ch2) {
            s16x4v bti[8], kti[2];
#pragma unroll
            for (int c1 = 0; c1 < 2; ++c1) { const int cb = 2 * ch2 + c1;
#pragma unroll
                for (int tb = 0; tb < 4; ++tb) bti[c1 * 4 + tb] = trread(L3 + RC_BT + (16 * tb + 4 * g + ((lane >> 2) & 3)) * 144 + (16 * cb) * 2 + 8 * (lane & 3));
                if (w >= 4) kti[c1] = trread(L3 + RC_KT + (16 * (w - 4) + 4 * g + ((lane >> 2) & 3)) * 144 + (16 * cb) * 2 + 8 * (lane & 3)); }
            __builtin_amdgcn_sched_barrier(0);
#pragma unroll
            for (int c1 = 0; c1 < 2; ++c1) { const int cb = 2 * ch2 + c1;
                f32x4 acc = {0.f, 0.f, 0.f, 0.f};
#pragma unroll
                for (int tb = 0; tb < 4; ++tb) acc = mfma16k(xb[tb], bti[c1 * 4 + tb], acc);
                if (w < 4) {
#pragma unroll
                    for (int e = 0; e < 4; ++e) if (16 * w + 4 * g + e == 16 * cb + c16) acc[e] += 1.f;
                } else acc += unpackbf4(kti[c1]);
                acc = acc * glv[cb];
                *(s16x4v*)(L + ((w < 4) ? RC_GS : RC_HS) + (mytile * 4 + cb) * 512 + lane * 8) = packbf4(acc);
            }
            __builtin_amdgcn_sched_barrier(0);
        }
        lds_barrier();
        {
            const int ib = w & 3, hf = w >> 2;
            s16x4v simg[4], vtr[4];
#pragma unroll
            for (int k = 0; k < 4; ++k) { simg[k] = *(const s16x4v*)(L + RC_S + sb_cur + (k * 4 + ib) * 512 + lane * 8);
                vtr[k] = trread(L3 + RC_VV + (16 * k + 4 * g + ((lane >> 2) & 3)) * 144 + (16 * ib) * 2 + 8 * (lane & 3)); }
#pragma unroll
            for (int j = 0; j < 2; ++j) {
                const int tb = 2 * hf + j, cb = 2 * hf + j;
                f32x4 y = {0.f, 0.f, 0.f, 0.f}, sn = y;
                { s16x4v gyi[4], hyi[4];
#pragma unroll
                  for (int k = 0; k < 4; ++k) { gyi[k] = *(const s16x4v*)(L + RC_GY + (k * 4 + tb) * 512 + lane * 8); hyi[k] = *(const s16x4v*)(L + RC_HY + (k * 4 + tb) * 512 + lane * 8); }
                  __builtin_amdgcn_sched_barrier(0);
#pragma unroll
                  for (int k = 0; k < 4; ++k) y = mfma16k(simg[k], gyi[k], y);
#pragma unroll
                  for (int k = 0; k < 4; ++k) if (k <= tb) y = mfma16k(vtr[k], hyi[k], y); }
                { s16x4v gsi[4], hsi[4];
#pragma unroll
                  for (int k = 0; k < 4; ++k) { gsi[k] = *(const s16x4v*)(L + RC_GS + (k * 4 + cb) * 512 + lane * 8); hsi[k] = *(const s16x4v*)(L + RC_HS + (k * 4 + cb) * 512 + lane * 8); }
                  __builtin_amdgcn_sched_barrier(0);
#pragma unroll
                  for (int k = 0; k < 4; ++k) sn = mfma16k(gsi[k], simg[k], sn);
#pragma unroll
                  for (int k = 0; k < 4; ++k) sn = mfma16k(hsi[k], vtr[k], sn); }
                *(f32x4*)(L + RC_YO + ((16 * tb + c16) * 68 + 16 * ib + 4 * g) * 4) = y;
                *(s16x4v*)(L + RC_S + sb_nxt + (cb * 4 + ib) * 512 + lane * 8) = packbf4(sn);
            }
        }
        lds_barrier();
        if (c + 1 < T / 64) commit(tidl);
        {
            float yv[8], mean[8], var[8];
#pragma unroll
            for (int it = 0; it < 8; ++it) yv[it] = *(const float*)(L + RC_YO + ((w * 8 + it) * 68 + lane) * 4);
#pragma unroll
            for (int it = 0; it < 8; ++it) mean[it] = wave_sum_dpp(yv[it]) * (1.f / 64.f);
#pragma unroll
            for (int it = 0; it < 8; ++it) { yv[it] -= mean[it]; var[it] = wave_sum_dpp(yv[it] * yv[it]) * (1.f / 64.f); }
            const float lw = lnw, lb = lnb;
#pragma unroll
            for (int it = 0; it < 8; ++it) { const size_t row = (size_t)b * T + 64 * c + w * 8 + it;
                const float yn = yv[it] * rsqrtf(var[it] + GN_EPS) * lw + lb;
                const int tk = w * 8 + it; const float vv = bf2f(*(const bf16_t*)(L + RC_VV + (tk * 72 + lane) * 2));
                OA[row * 2048 + h * 64 + lane] = (bf16_t)f2bf((yn + BS[tk] * vv) * bf2f(pgr[it])); }
        }
        lds_barrier();
    }
}

DI int crow(int reg, int hh) { return (reg & 3) + 8 * (reg >> 2) + 4 * hh; }
constexpr int NSA_KB = 0, NSA_VB = 18432, NSA_PSUM = 36864, NSA_IMP = 70144, NSA_SEL = 78848, NSA_UNI = 79104, NSA_ITEM = 79108, NSA_BT = 79360, NSA_Q = 90112;
constexpr float NEGBIG = -1e30f;
struct TileRegs { u32x4 k, v; };
DI void tile_fetch(TileRegs& r, const bf16_t* Kp, size_t kstride, const bf16_t* Vp, size_t vstride, int tid) {
    const int row = tid >> 3, ch = tid & 7;
    r.k = *(const u32x4*)(Kp + (size_t)row * kstride + ch * 8);
    r.v = *(const u32x4*)(Vp + (size_t)row * vstride + ch * 8);
}
DI void tile_commit(const TileRegs& r, unsigned char* lds, int buf, int tid) {
    const int row = tid >> 3, ch = tid & 7;
    *(u32x4*)(lds + NSA_KB + buf * 9216 + row * 144 + ch * 16) = r.k;
    unsigned char* vp = lds + NSA_VB + buf * 8704 + row * 136 + ch * 16;
    *(u32x2*)vp = (u32x2){r.v.x, r.v.y}; *(u32x2*)(vp + 8) = (u32x2){r.v.z, r.v.w};
}
DI void tile_scores(f32x16& s0, f32x16& s1, const unsigned char* lds, int buf, const unsigned char* qb, int r, int hh) {
    const unsigned char* kb = lds + NSA_KB + buf * 9216 + r * 144 + hh * 16;
    s0 = (f32x16){0.f, 0.f, 0.f, 0.f, 0.f, 0.f, 0.f, 0.f, 0.f, 0.f, 0.f, 0.f, 0.f, 0.f, 0.f, 0.f}; s1 = s0;
#pragma unroll
    for (int d0 = 0; d0 < 4; ++d0) {
        const bf16x8 k0 = *(const bf16x8*)(kb + d0 * 32), k1 = *(const bf16x8*)(kb + 32 * 144 + d0 * 32);
        const bf16x8 qf = *(const bf16x8*)(qb + d0 * 8192);
        s0 = mfma32(k0, qf, s0); s1 = mfma32(k1, qf, s1);
    }
}
DI bf16x8 pack8(const f32x16& p, int s2) { u32x4 w; w.x = pk2(p[8 * s2], p[8 * s2 + 1]); w.y = pk2(p[8 * s2 + 2], p[8 * s2 + 3]); w.z = pk2(p[8 * s2 + 4], p[8 * s2 + 5]); w.w = pk2(p[8 * s2 + 6], p[8 * s2 + 7]); return __builtin_bit_cast(bf16x8, w); }
DI void tile_pv(f32x16 (&o)[2], const f32x16& p0, const f32x16& p1, const unsigned char* lds, int buf, int r, int hh) {
    const unsigned char* vb = lds + NSA_VB + buf * 8704;
#pragma unroll
    for (int half = 0; half < 2; ++half)
#pragma unroll
        for (int s2 = 0; s2 < 2; ++s2) {
            const bf16x8 pf = pack8(half ? p1 : p0, s2);
#pragma unroll
            for (int dh = 0; dh < 2; ++dh) { const unsigned char* vp = vb + (32 * dh + r) * 136 + (32 * half + 16 * s2 + 4 * hh) * 2;
                const u32x2 lo = *(const u32x2*)vp, hi = *(const u32x2*)(vp + 16); u32x4 vw = {lo.x, lo.y, hi.x, hi.y};
                o[dh] = mfma32(__builtin_bit_cast(bf16x8, vw), pf, o[dh]); }
        }
}
constexpr float MINIT = -1e20f;
DI void online_update(f32x16& s0, f32x16& s1, float& mrun, float& lrun, f32x16 (&o)[2]) {
    float mt = fmaxf(s0[0], s1[0]);
#pragma unroll
    for (int i = 1; i < 16; ++i) mt = fmaxf(mt, fmaxf(s0[i], s1[i]));
    mt = swap32_max(mt);
    if (__any(mt > mrun)) {
        const float mnew = fmaxf(mrun, mt); const float alpha = __builtin_amdgcn_exp2f(mrun - mnew);
        lrun *= alpha; mrun = mnew;
#pragma unroll
        for (int i = 0; i < 16; ++i) { o[0][i] *= alpha; o[1][i] *= alpha; }
    }
    float ps0 = 0.f, ps1 = 0.f;
#pragma unroll
    for (int i = 0; i < 16; ++i) { s0[i] = __builtin_amdgcn_exp2f(s0[i] - mrun); s1[i] = __builtin_amdgcn_exp2f(s1[i] - mrun); ps0 += s0[i]; ps1 += s1[i]; }
    lrun += swap32_sum(ps0 + ps1);
}

template <int VAR> DI void nsa_worker(Frame& F) {
    unsigned char* lds = F.lds;
    float* PSUM = (float*)(lds + NSA_PSUM); float* IMP = (float*)(lds + NSA_IMP); unsigned* SEL = (unsigned*)(lds + NSA_SEL); unsigned* UNI = (unsigned*)(lds + NSA_UNI);
    int* ITEM = (int*)(lds + NSA_ITEM); float* BT = (float*)(lds + NSA_BT);
    const bf16_t* PQ = (const bf16_t*)(F.ws + WS_PQ); const bf16_t* PKV = (const bf16_t*)(F.ws + WS_PKV);
    const bf16_t* KC = (const bf16_t*)(F.ws + WS_KC); const bf16_t* VCT = (const bf16_t*)(F.ws + WS_VCT);
    const bf16_t* VST = (const bf16_t*)(F.ws + WS_VST); const bf16_t* VWT = (const bf16_t*)(F.ws + WS_VWT);
    const float* GATES = (const float*)(F.ws + WS_GATES); bf16_t* OB = (bf16_t*)((char*)F.out + DO_OAB) + 1024;
    unsigned* ctr = (unsigned*)(F.ws + WS_CTL) + 64;
    { int t0_ = (int)threadIdx.x; asm volatile("" : "+v"(t0_));
      for (int i = t0_; i < 2048; i += NTHREADS) BT[i] = ((const float*)(F.ws + WS_BIAS))[i] * LOG2E; }
    const int hg = F.wave >> 1, th = F.wave & 1;
    const int myx = (int)((unsigned)__builtin_amdgcn_s_getreg((3 << 11) | 20) & 7u); int qsel = 0;
    for (;;) {
        lds_barrier();
        if (((int)threadIdx.x) == 0) { int it = -1;
            while (qsel < 8) { const int qx = (myx + qsel) & 7; const unsigned v = atomicAdd(ctr + 16 * qx, 1u); if (v < 128u) { it = (int)v * 8 + qx; break; } ++qsel; }
            *ITEM = it; }
        lds_barrier();
        const int item0 = *ITEM; if (item0 < 0) break;
        const int item = ((item0 >> 3) << 3) | (item0 & 7);
        int tidl = threadIdx.x; asm volatile("" : "+v"(tidl));
        const int r = tidl & 31, hh = (tidl >> 5) & 1, tl = 32 * th + r;
        const int qidx = item >> 3, qx_ = item & 7; const int qt = 31 - (qidx >> 2), bg = 8 * (qidx & 3) + qx_, b = bg >> 2, g = bg & 3, t0 = 64 * qt, cur = qt;
        const int hq = 4 * g + hg, t = t0 + tl; const size_t row = (size_t)b * T + t;
        const unsigned char* qr = lds + NSA_Q + tidl * 16;
#pragma unroll
        for (int d0 = 0; d0 < 4; ++d0) *(bf16x8*)(lds + NSA_Q + d0 * 8192 + tidl * 16) = *(const bf16x8*)(PQ + row * 1024 + hq * 64 + 16 * d0 + 8 * hh);
        const float gate_c = GATES[row * 48 + hq * 3], gate_s = GATES[row * 48 + hq * 3 + 1], gate_w = GATES[row * 48 + hq * 3 + 2];
        const float* bt = BT + hq * 128;
        f32x16 oacc[2];
#pragma unroll
        for (int i = 0; i < 16; ++i) { oacc[0][i] = 0.f; oacc[1][i] = 0.f; }
        TileRegs tr;
        {
            const bf16_t* Kp = KC + ((size_t)b * 128 * 4 + g) * 64; const bf16_t* Vp = VCT + (size_t)(b * 4 + g) * 64 * 128;
            tile_fetch(tr, Kp, 256, Vp, 128, tidl); tile_commit(tr, lds, 0, tidl);
            tile_fetch(tr, Kp + (size_t)64 * 256, 256, Vp + 64, 128, tidl); tile_commit(tr, lds, 1, tidl);
            lds_barrier();
            tile_fetch(tr, PKV + (size_t)b * T * 1536 + 2 * 256 + g * 64, 1536, VST + (size_t)(b * 4 + g) * 64 * 2048, 2048, tidl);
            f32x16 sc[2][2];
            tile_scores(sc[0][0], sc[0][1], lds, 0, qr, r, hh); __builtin_amdgcn_sched_barrier(0); tile_scores(sc[1][0], sc[1][1], lds, 1, qr, r, hh); __builtin_amdgcn_sched_barrier(0);
            const int nmax = (t >= 31) ? ((t - 31) >> 4) : -1;
            float mx = NEGBIG;
            const int tmin_w = t0 + 32 * th;
#define CMP_MASK(S_, NB_) do { \
                if (16 * (NB_) + 31 > tmin_w + 31) { _Pragma("unroll") for (int i = 0; i < 16; ++i) S_[i] = NEGBIG; }                                     \
                else if (16 * ((NB_) + 31) + 31 + 128 <= tmin_w) { _Pragma("unroll") for (int i = 0; i < 16; ++i) mx = fmaxf(mx, S_[i]); }               \
                else { _Pragma("unroll") for (int i = 0; i < 16; ++i) { const int n = (NB_) + crow(i, hh); const int rel = t - 16 * n - 31; float s = S_[i]; \
                    const float bv = bt[min(max(rel, 0), 127)]; if (n <= nmax) { s += bv; mx = fmaxf(mx, s); } else s = NEGBIG; S_[i] = s; } } \
                __builtin_amdgcn_sched_barrier(0); } while (0)
            CMP_MASK(sc[0][0], 0); CMP_MASK(sc[0][1], 32); CMP_MASK(sc[1][0], 64); CMP_MASK(sc[1][1], 96);
#undef CMP_MASK
            mx = swap32_max(mx);
            float ps = 0.f;
#pragma unroll
            for (int kt = 0; kt < 2; ++kt)
#pragma unroll
                for (int half = 0; half < 2; ++half)
#pragma unroll
                    for (int i = 0; i < 16; ++i) { const float s = sc[kt][half][i]; const float p = (s > -1e29f) ? __builtin_amdgcn_exp2f(s - mx) : 0.f; sc[kt][half][i] = p; ps += p; }
            ps = swap32_sum(ps);
            const float inv = (ps > 0.f) ? 1.f / ps : 0.f;
#pragma unroll
            for (int kt = 0; kt < 2; ++kt)
#pragma unroll
                for (int half = 0; half < 2; ++half)
#pragma unroll
                    for (int i = 0; i < 16; ++i) sc[kt][half][i] *= inv;
            if (cur >= 8) {
#pragma unroll 1
                for (int hgi = 0; hgi < 4; ++hgi) {
                    if (hg == hgi) {
#pragma unroll
                        for (int kt = 0; kt < 2; ++kt)
#pragma unroll
                            for (int half = 0; half < 2; ++half)
                                { float* pb = PSUM + tl * 129 + 64 * kt + 32 * half + 4 * hh; float old[16];
#pragma unroll
                                  for (int i = 0; i < 16; ++i) old[i] = (hgi == 0) ? 0.f : pb[(i & 3) + 8 * (i >> 2)];
#pragma unroll
                                  for (int i = 0; i < 16; ++i) pb[(i & 3) + 8 * (i >> 2)] = old[i] + sc[kt][half][i]; }
                    }
                    lds_barrier();
                }
            }
#pragma unroll
            for (int kt = 0; kt < 2; ++kt)
#pragma unroll
                for (int half = 0; half < 2; ++half)
#pragma unroll
                    for (int i = 0; i < 16; ++i) sc[kt][half][i] *= gate_c;
            tile_pv(oacc, sc[0][0], sc[0][1], lds, 0, r, hh); __builtin_amdgcn_sched_barrier(0); tile_pv(oacc, sc[1][0], sc[1][1], lds, 1, r, hh); __builtin_amdgcn_sched_barrier(0);
            if (cur >= 8) {
#pragma unroll
                for (int i = 0; i < 4; ++i) { const int tok = tidl >> 3, j = (tidl & 7) + 8 * i; const float* pp = PSUM + tok * 129 + 4 * j;
                    float v = pp[0] + pp[1] + pp[2] + 0.5f * pp[3]; if (j > 0) v += 0.5f * pp[-1];
                    IMP[tok * 33 + j] = v; }
                lds_barrier();
                if (F.wave == 0) {
                    const int tok = tidl & 63; float scv[32];
#pragma unroll
                    for (int j = 0; j < 32; ++j) { const bool forced = (j == 0) || (j == cur) || (j == cur - 1); scv[j] = forced ? 1e4f : ((j <= cur) ? IMP[tok * 33 + j] : -1.f); }
                    unsigned msk = 1u | (1u << cur) | (1u << (cur - 1));
#pragma unroll 1
                    for (int k = 0; k < 5; ++k) { float best = -3e38f; int bi = 0;
#pragma unroll
                        for (int j = 0; j < 32; ++j) { const bool tk = ((msk >> j) & 1u) == 0u && scv[j] > best; best = tk ? scv[j] : best; bi = tk ? j : bi; }
                        msk |= 1u << bi; }
                    msk &= (cur >= 31) ? 0xffffffffu : ((1u << (cur + 1)) - 1u);
                    SEL[tok] = msk;
                    unsigned um = msk;
#pragma unroll
                    for (int o = 1; o < 64; o <<= 1) um |= (unsigned)__shfl_xor((int)um, o);
                    if ((tidl & 63) == 0) *UNI = um;
                }
            } else {
                if (tidl < 64) SEL[tidl] = (1u << (cur + 1)) - 1u;
                if (tidl == 0) *UNI = (1u << (cur + 1)) - 1u;
            }
            lds_barrier();
        }
        {
            const unsigned uni = *UNI, mysel = SEL[tl];
            const bf16_t* Kb = PKV + (size_t)b * T * 1536 + 2 * 256 + g * 64; const bf16_t* Vb = VST + (size_t)(b * 4 + g) * 64 * 2048;
            float mrun = MINIT, lrun = 0.f; f32x16 o[2];
#pragma unroll
            for (int i = 0; i < 16; ++i) { o[0][i] = 0.f; o[1][i] = 0.f; }
            unsigned rem = uni; int j = 0; rem &= rem - 1u; int buf = 0;
            const bf16_t* Kbw = PKV + (size_t)b * T * 1536 + 4 * 256 + g * 64; const bf16_t* Vbw = VWT + (size_t)(b * 4 + g) * 64 * 2048; const int jw0 = (cur >= 8) ? cur - 8 : 0;
            for (;;) {
                tile_commit(tr, lds, buf, tidl);
                lds_barrier();
                const int jn = rem ? __builtin_ctz(rem) : -1; rem &= rem - 1u;
                if (jn >= 0) tile_fetch(tr, Kb + (size_t)64 * jn * 1536, 1536, Vb + 64 * jn, 2048, tidl);
                else tile_fetch(tr, Kbw + (size_t)64 * jw0 * 1536, 1536, Vbw + 64 * jw0, 2048, tidl);
                f32x16 s0, s1;
                if (VAR <= 1) tile_scores(s0, s1, lds, buf, qr, r, hh); else { s0 = o[0]; s1 = o[1]; }
                const bool selb = (mysel >> j) & 1u;
                if (VAR == 0 && j >= cur - 2) {
#pragma unroll
                    for (int i = 0; i < 16; ++i) { const int rel0 = t - (64 * j + crow(i, hh)), rel1 = rel0 - 32;
                        const float b0 = bt[min(max(rel0, 0), 127)], b1 = bt[min(max(rel1, 0), 127)];
                        s0[i] = (selb && rel0 >= 0) ? (s0[i] + b0) : NEGBIG;
                        s1[i] = (selb && rel1 >= 0) ? (s1[i] + b1) : NEGBIG; }
                } else if (!selb) {
#pragma unroll
                    for (int i = 0; i < 16; ++i) { s0[i] = NEGBIG; s1[i] = NEGBIG; }
                }
                if (VAR == 0) online_update(s0, s1, mrun, lrun, o);
                if (VAR <= 1) tile_pv(o, s0, s1, lds, buf, r, hh);
                if (jn < 0) break;
                j = jn; buf ^= 1;
            }
            const float sc_ = gate_s / lrun;
#pragma unroll
            for (int i = 0; i < 16; ++i) { oacc[0][i] += sc_ * o[0][i]; oacc[1][i] += sc_ * o[1][i]; }
            lds_barrier();
        }
        {
            const bf16_t* Kb = PKV + (size_t)b * T * 1536 + 4 * 256 + g * 64; const bf16_t* Vb = VWT + (size_t)(b * 4 + g) * 64 * 2048;
            float mrun = MINIT, lrun = 0.f; f32x16 o[2];
#pragma unroll
            for (int i = 0; i < 16; ++i) { o[0][i] = 0.f; o[1][i] = 0.f; }
            int j = (cur >= 8) ? cur - 8 : 0, buf = 0;
            for (;;) {
                tile_commit(tr, lds, buf, tidl);
                lds_barrier();
                const int jn = (j < cur) ? j + 1 : -1;
                if (jn >= 0) tile_fetch(tr, Kb + (size_t)64 * jn * 1536, 1536, Vb + 64 * jn, 2048, tidl);
                f32x16 s0, s1;
                if (VAR <= 1) tile_scores(s0, s1, lds, buf, qr, r, hh); else { s0 = o[0]; s1 = o[1]; }
                if (VAR == 0 && (j >= cur - 2 || j == cur - 8)) {
#pragma unroll
                    for (int i = 0; i < 16; ++i) { const int rel0 = t - (64 * j + crow(i, hh)), rel1 = rel0 - 32;
                        const float b0 = bt[min(max(rel0, 0), 127)], b1 = bt[min(max(rel1, 0), 127)];
                        s0[i] = (rel0 >= 0 && rel0 < 512) ? (s0[i] + b0) : NEGBIG;
                        s1[i] = (rel1 >= 0 && rel1 < 512) ? (s1[i] + b1) : NEGBIG; }
                }
                if (VAR == 0) online_update(s0, s1, mrun, lrun, o);
                if (VAR <= 1) tile_pv(o, s0, s1, lds, buf, r, hh);
                if (jn < 0) break;
                j = jn; buf ^= 1;
            }
            const float sc_ = gate_w / lrun;
#pragma unroll
            for (int i = 0; i < 16; ++i) { oacc[0][i] += sc_ * o[0][i]; oacc[1][i] += sc_ * o[1][i]; }
        }
        bf16_t* op = OB + row * 2048 + hq * 64;
        if (VAR != 0) { if (oacc[0][0] + oacc[1][5] == 123.456f) op[0] = 0; continue; }
#pragma unroll
        for (int dh = 0; dh < 2; ++dh)
#pragma unroll
            for (int gq = 0; gq < 4; ++gq) { u32x2 w; w.x = pk2(oacc[dh][4 * gq], oacc[dh][4 * gq + 1]); w.y = pk2(oacc[dh][4 * gq + 2], oacc[dh][4 * gq + 3]);
                *(u32x2*)(op + 32 * dh + 8 * gq + 4 * hh) = w; }
    }
}


#define XB_TMO      128
#define XB_XCNT(j)  (256  + 64 * (j))
#define XB_XSUB(j)  (1280 + 64 * (j))
#define XB_XGEN(j)  (2304 + 64 * (j))
#define XB_TOP      3328
#define XB_TOPGEN   3392
#define XCD_BAR_WORDS 3456
#define XB_SPIN_CAP (1u << 22)
DI unsigned xb_ld(unsigned* p)              { return __hip_atomic_load(p, __ATOMIC_RELAXED, __HIP_MEMORY_SCOPE_AGENT); }
DI unsigned xb_add(unsigned* p, unsigned v) { return __hip_atomic_fetch_add(p, v, __ATOMIC_RELAXED, __HIP_MEMORY_SCOPE_AGENT); }
DI unsigned xb_xcc_id() { return (unsigned)__builtin_amdgcn_s_getreg((3 << 11) | 20) & 0xFu; }
#define XB_SPIN(cond, bar) do { unsigned _sp = 0; while (cond) { __builtin_amdgcn_s_sleep(1); \
    if ((++_sp & 255u) == 0u) { if (xb_ld(&(bar)[XB_TMO])) break; if (_sp > XB_SPIN_CAP) { atomicAdd(&(bar)[XB_TMO], 1u); break; } } } } while (0)
struct XcdBarrier { unsigned* bar; unsigned x; volatile LAS unsigned* st; };
DI XcdBarrier xcd_barrier_post(unsigned* bar, volatile LAS unsigned* st) {
    XcdBarrier b; b.bar = bar; b.x = xb_xcc_id(); b.st = st;
    if (threadIdx.x == 0) (void)xb_add(&bar[XB_XCNT(b.x)], 1u);
    return b;
}
DI void xcd_barrier_complete(unsigned* bar, unsigned x, unsigned& nloc, unsigned& nx) {
    const unsigned G = gridDim.x * gridDim.y * gridDim.z;
    unsigned sum, cnt, mine, sp = 0u;
    for (;;) {
        sum = 0u; cnt = 0u; mine = 0u;
#pragma unroll
        for (unsigned j = 0; j < 16; ++j) { const unsigned c = xb_ld(&bar[XB_XCNT(j)]); sum += c; cnt += (c > 0u) ? 1u : 0u; mine = (j == x) ? c : mine; }
        if (sum == G) break;
        __builtin_amdgcn_s_sleep(1);
        if ((++sp & 255u) == 0u) { if (xb_ld(&bar[XB_TMO])) break; if (sp > XB_SPIN_CAP) { atomicAdd(&bar[XB_TMO], 1u); break; } }
    }
    nloc = mine > 0u ? mine : 1u; nx = cnt > 0u ? cnt : 1u;
}
DI void xcd_barrier(const XcdBarrier& b) {
    asm volatile("s_waitcnt vmcnt(0)" ::: "memory");
    __syncthreads();
    if (threadIdx.x == 0) {
        unsigned* bar = b.bar;
        __builtin_amdgcn_s_waitcnt(0);
        unsigned nloc = b.st[0], nx = b.st[1];
        if (nloc == 0u) { xcd_barrier_complete(bar, b.x, nloc, nx); b.st[0] = nloc; b.st[1] = nx; }
        const unsigned old = xb_add(&bar[XB_XSUB(b.x)], 1u);
        const unsigned gen = old / nloc;
        if (old + 1u == (gen + 1u) * nloc) {
            __builtin_amdgcn_fence(__ATOMIC_RELEASE, "agent");
            asm volatile("s_waitcnt vmcnt(0)" ::: "memory");
            const unsigned og = xb_add(&bar[XB_TOP], 1u);
            const unsigned tg = og / nx;
            if (og + 1u == (tg + 1u) * nx) xb_add(&bar[XB_TOPGEN], 1u);
            else XB_SPIN(xb_ld(&bar[XB_TOPGEN]) == tg, bar);
            __builtin_amdgcn_fence(__ATOMIC_ACQUIRE, "agent");
            xb_add(&bar[XB_XGEN(b.x)], 1u);
            asm volatile("s_waitcnt vmcnt(0)" ::: "memory");
        } else {
            XB_SPIN(xb_ld(&bar[XB_XGEN(b.x)]) == gen, bar);
            __builtin_amdgcn_fence(__ATOMIC_ACQUIRE, "agent");
            asm volatile("s_waitcnt vmcnt(0)" ::: "memory");
        }
    }
    __syncthreads();
}

constexpr int N_LAUNCHES = MK_N_LAUNCHES, N_PHASES = 9;
__global__ void __launch_bounds__(NTHREADS, 2) hybrid_fwd(Args args) {
    extern __shared__ __attribute__((aligned(16))) unsigned char lds[];
    Frame F;
    F.lds = lds; F.lds3 = (LAS unsigned char*)lds;
    F.tid = threadIdx.x; F.lane = F.tid & 63; F.wave = __builtin_amdgcn_readfirstlane(F.tid >> 6);
    F.G = gridDim.x; F.blk = blockIdx.x; F.gw = F.blk * 8 + F.wave; F.NGW = F.G * 8;
    F.in = args.in; F.out = args.out; F.ws = args.ws;
    volatile LAS unsigned* bst = (volatile LAS unsigned*)(F.lds3 + LDS_BYTES - 16);
    if (F.tid < 2) bst[F.tid] = 0u;
    __syncthreads();
    XcdBarrier bar = xcd_barrier_post((unsigned*)(args.ws + WS_CTL) + 1024, bst);
    const int lo = args.ph_lo, hi = args.ph_hi;
#ifndef PH_MASK
#define PH_MASK 0x1ff
#endif
#ifndef REP_MASK
#define REP_MASK 0
#endif
#define REP(k) ((REP_MASK >> (k)) & 1)
#define IN(k) (((PH_MASK >> (k)) & 1) && lo <= (k) && (k) < hi)
#define SEAM(k) do { if (IN(k) && IN((k) + 1)) { xcd_barrier(bar); } } while (0)
    unsigned char* ws = args.ws;
    if (IN(0)) { phase_a(F, true); if (REP(0)) { __syncthreads(); phase_a(F, false); } } SEAM(0);
    if (IN(1)) { phase_b(F); if (REP(1)) { __syncthreads(); phase_b(F); } } SEAM(1);
    if (IN(2)) {
        pg8::Gemm g; g.A0 = g.A1 = (const bf16_t*)(ws + WS_H); g.B0 = g.B1 = (const bf16_t*)(ws + WS_WIN); g.K = D;
        pg8::StaticOrder S; S.init(M, NCOLS, F.G, F.blk, 1);
        EpiInProj E{ws};
        pg8::gemm_phase<EpiInProj, true, true>(F.lds3, g, S, E);
        if (REP(2)) { EpiInProjT<(REP_MASK >> 16) & 3> E2{ws}; pg8::gemm_phase<EpiInProjT<(REP_MASK >> 16) & 3>, true, true>(F.lds3, g, S, E2); }
    } SEAM(2);
    if (IN(3)) { phase_d<0>(F); if (REP(3)) { __syncthreads(); phase_d<((REP_MASK >> 16) & 3) ? ((REP_MASK >> 16) & 3) : 1, (REP_MASK >> 18) & 3>(F); } } SEAM(3);
    if (IN(4)) {
        const int nscan = (F.G >= 256) ? 128 : F.G / 2;
#ifndef NO_SCAN
        if (F.blk < nscan) { for (int hd = F.blk; hd < BATCH * RH; hd += nscan) rwkv_head(F, hd); }
#endif
#ifndef NO_NSA
        nsa_worker<0>(F);
#endif
        if (REP(4)) {
            xcd_barrier(bar); if (F.blk == 0 && F.tid < 8) __hip_atomic_store((unsigned*)(ws + WS_CTL) + 64 + 16 * F.tid, 0u, __ATOMIC_RELAXED, __HIP_MEMORY_SCOPE_AGENT); xcd_barrier(bar);
            if (REP_MASK & 0x1000) { if (F.blk < nscan) { for (int hd = F.blk; hd < BATCH * RH; hd += nscan) rwkv_head(F, hd); } }
            if (REP_MASK & 0x2000) { nsa_worker<(REP_MASK >> 16) & 3>(F); }
        }
    } SEAM(4);
    if (IN(5)) {
        pg8::Gemm g; g.A0 = g.A1 = (const bf16_t*)((const char*)args.out + DO_OAB); g.B0 = g.B1 = (const bf16_t*)(ws + WS_WOA); g.K = D;
        pg8::StaticOrder S; S.init(M, D, F.G, F.blk, 1);
        EpiMerge E{(const bf16_t*)(ws + WS_PMG), (bf16_t*)(ws + WS_MIXED)};
        pg8::gemm_phase<EpiMerge, true, true>(F.lds3, g, S, E);
        if (REP(5)) { if ((REP_MASK >> 16) & 3) { EpiInProjT<2> E2{ws}; pg8::gemm_phase<EpiInProjT<2>, true, true>(F.lds3, g, S, E2); } else pg8::gemm_phase<EpiMerge, true, true>(F.lds3, g, S, E); }
    } SEAM(5);
    if (IN(6)) {
        pg8::Gemm g; g.A0 = g.A1 = (const bf16_t*)(ws + WS_MIXED); g.B0 = g.B1 = (const bf16_t*)(ws + WS_WOUT); g.K = D;
        pg8::StaticOrder S; S.init(M, D, F.G, F.blk, 1);
        EpiWout E{args.in[0], (const float*)(ws + WS_MOD), (const float*)(ws + WS_M2V), args.out, (bf16_t*)(ws + WS_X1M), (float*)(ws + WS_SUMSQ)};
        pg8::gemm_phase<EpiWout, true, true>(F.lds3, g, S, E);
    } SEAM(6);
    if (IN(7)) {
        pg8::Gemm g; g.A0 = g.A1 = (const bf16_t*)(ws + WS_X1M); g.B0 = g.B1 = (const bf16_t*)(ws + WS_WUP); g.K = D;
        pg8::StaticOrder S; S.init(M, DFF, F.G, F.blk, 1);
        EpiUp E{(const float*)(ws + WS_SUMSQ), (const float*)(ws + WS_C2), (bf16_t*)(ws + WS_U)};
        pg8::gemm_phase<EpiUp, true, true>(F.lds3, g, S, E);
        if (REP(7)) pg8::gemm_phase<EpiUp, true, true>(F.lds3, g, S, E);
    } SEAM(7);
    if (IN(8)) {
        pg8::Gemm g; g.A0 = g.A1 = (const bf16_t*)(ws + WS_U); g.B0 = g.B1 = (const bf16_t*)(ws + WS_WDOWN); g.K = DFF;
        pg8::StaticOrder S; S.init(M, D, F.G, F.blk, 1);
        EpiDown E{(const float*)(ws + WS_MOD), args.out};
        pg8::gemm_phase<EpiDown, true, true>(F.lds3, g, S, E);
    }
#undef IN
#undef SEAM
}

extern "C" void kernel_launch(void* const* d_in, const int* in_sizes, int n_in, void* d_out, int out_size, void* d_ws, size_t ws_size, hipStream_t stream) {
    static int grid = 0;
    if (grid == 0) {
        if (n_in != 32 || in_sizes[0] != M * D || out_size != M * D || ws_size < WS_END) {
            fprintf(stderr, "kernel_launch: unexpected shapes (n_in %d, in0 %d, out %d, ws %zu); nothing launched\n", n_in, n_in > 0 ? in_sizes[0] : -1, out_size, ws_size); grid = -1; return; }
        int dev = 0, cus = 0, per_cu = 0;
        if (hipGetDevice(&dev) != hipSuccess || hipDeviceGetAttribute(&cus, hipDeviceAttributeMultiprocessorCount, dev) != hipSuccess) { grid = -1; return; }
        if (hipFuncSetAttribute((const void*)hybrid_fwd, hipFuncAttributeMaxDynamicSharedMemorySize, LDS_BYTES) != hipSuccess) { fprintf(stderr, "kernel_launch: hipFuncSetAttribute failed\n"); grid = -1; return; }
        if (hipOccupancyMaxActiveBlocksPerMultiprocessor(&per_cu, (const void*)hybrid_fwd, NTHREADS, LDS_BYTES) != hipSuccess || per_cu < 1) { fprintf(stderr, "kernel_launch: occupancy query gives %d blocks per CU; nothing launched\n", per_cu); per_cu = 0; }
        (void)hipGetLastError();
        if (per_cu < 1) { grid = -1; return; }
        grid = cus;
        if (grid > 256) grid = 256;
    }
    if (grid < 0) return;
    if (hipMemsetAsync((char*)d_ws + WS_CTL, 0, CTL_ZERO_BYTES, stream) != hipSuccess) { fprintf(stderr, "kernel_launch: memset failed\n"); return; }
    Args a{};
    for (int i = 0; i < 32; ++i) a.in[i] = (const float*)d_in[i];
    a.out = (float*)d_out; a.ws = (unsigned char*)d_ws;
    if (N_LAUNCHES == 1) {
        a.ph_lo = 0; a.ph_hi = N_PHASES;
        hipLaunchKernelGGL(hybrid_fwd, dim3(grid), dim3(NTHREADS), LDS_BYTES, stream, a);
        const hipError_t e = hipPeekAtLastError();
        if (e != hipSuccess) fprintf(stderr, "kernel_launch: launch failed: %s (grid %d)\n", hipGetErrorString(e), grid);
    } else {
        for (int p = 0; p < N_PHASES; ++p) { a.ph_lo = p; a.ph_hi = p + 1; hipLaunchKernelGGL(hybrid_fwd, dim3(grid), dim3(NTHREADS), LDS_BYTES, stream, a); }
    }
}
```

```cpp
#include <hip/hip_runtime.h>
#include <cstdio>
#include <cstdint>

#ifndef MK_N_LAUNCHES
#define MK_N_LAUNCHES 1
#endif

#define DI __device__ __forceinline__
#define LAS __attribute__((address_space(3)))
typedef unsigned short bf16_t;
typedef short bf16x8 __attribute__((ext_vector_type(8)));
typedef short s16x4 __attribute__((ext_vector_type(4)));
typedef float f32x2 __attribute__((ext_vector_type(2)));
typedef float f32x4 __attribute__((ext_vector_type(4)));
typedef float f32x16 __attribute__((ext_vector_type(16)));
typedef unsigned u32x2 __attribute__((ext_vector_type(2)));
typedef unsigned u32x4 __attribute__((ext_vector_type(4)));
typedef __bf16 bf16x2_t __attribute__((ext_vector_type(2)));

constexpr int D = 2048, BATCH = 8, T = 2048, M = BATCH * T, DFF = 8192;
constexpr int RW = 1024, RH = 16, HD = 64;
constexpr int NCOLS = 10240;
constexpr int IN_COLS = 10064;
constexpr int NC = 127;
constexpr float NORM_EPS = 1e-6f, GN_EPS = 64e-5f;
constexpr float LOG2E = 1.4426950408889634f;

constexpr size_t MiB = 1u << 20;
constexpr size_t WS_CTL = 0, CTL_ZERO_BYTES = 1 * MiB;
constexpr size_t WS_MOD = 64 * 1024;
constexpr size_t WS_SUMSQ = 512 * 1024;
constexpr size_t WS_C2 = 1 * MiB;
constexpr size_t WS_M2V = WS_C2 + 256 * 1024;
constexpr size_t WS_BIAS = WS_M2V + 64 * 1024;
constexpr size_t WS_CPE = WS_BIAS + 8 * 1024;
constexpr size_t WS_W2T = WS_CPE + 1024;
constexpr size_t WS_A2T = WS_W2T + 128 * 1024;
constexpr size_t WS_G2T = WS_A2T + 128 * 1024;
constexpr size_t WS_CW1K = WS_G2T + 320 * 1024;
constexpr size_t WS_CW1V = WS_CW1K + 256 * 1024;
constexpr size_t WS_CW2K = WS_CW1V + 256 * 1024;
constexpr size_t WS_CW2V = WS_CW2K + 8 * 1024;
constexpr size_t WS_KC = WS_CW2V + 8 * 1024;
constexpr size_t WS_VCT = WS_KC + 512 * 1024;
constexpr size_t WS_BSUM = WS_VCT + 512 * 1024;
constexpr size_t WS_GATES = WS_BSUM + 1 * MiB;
static_assert(WS_GATES + 3 * MiB <= 8 * MiB, "small region");
constexpr size_t WS_WOA = 8 * MiB, WS_WOB = 12 * MiB, WS_WOUT = 16 * MiB, WS_WUP = 24 * MiB, WS_WDOWN = 56 * MiB, WS_WIN = 88 * MiB;
constexpr size_t WS_H = 128 * MiB;
constexpr size_t WS_PR = 192 * MiB, WS_PK = 224 * MiB, WS_PV = 256 * MiB, WS_PQ = 288 * MiB, WS_PKV = 320 * MiB, WS_PMG = 368 * MiB, WS_PMISC = 496 * MiB;
constexpr size_t WS_END = 512 * MiB;
constexpr size_t WS_GRW = 88 * MiB, WS_VST = 120 * MiB, WS_VWT = 128 * MiB;
constexpr size_t DO_OAB = 0;
constexpr size_t WS_STASH = 192 * MiB;
constexpr size_t WS_MIXED = 88 * MiB;
constexpr size_t WS_X1M = 368 * MiB;
constexpr size_t WS_U = 88 * MiB;
static_assert(WS_U + (size_t)M * DFF * 2 <= WS_X1M, "u vs x1m");
constexpr size_t DO_AT = 0, DO_BT = 32 * MiB, DO_KT = 64 * MiB, DO_RT = 96 * MiB;
constexpr size_t WS_VM = 136 * MiB, WS_GL = 168 * MiB;

constexpr int LDS_BYTES = 147456;
constexpr int NTHREADS = 512;

DI float bf2f(unsigned v) { return __uint_as_float(v << 16); }
DI unsigned pk2(float lo, float hi) { f32x2 v = {lo, hi}; bf16x2_t b = __builtin_convertvector(v, bf16x2_t); return __builtin_bit_cast(unsigned, b); }
DI unsigned f2bf(float f) { return pk2(f, 0.f) & 0xffffu; }
DI float lo16(unsigned u) { return __uint_as_float(u << 16); }
DI float hi16(unsigned u) { return __uint_as_float(u & 0xffff0000u); }
DI float wave_sum(float v) {
#pragma unroll
    for (int o = 1; o < 64; o <<= 1) v += __shfl_xor(v, o);
    return v;
}
DI void lds_barrier() { asm volatile("s_waitcnt lgkmcnt(0)\n\ts_barrier" ::: "memory"); }
DI float sigmoidf_(float x) { return __builtin_amdgcn_rcpf(1.f + __expf(-x)); }
template <int CTRL> DI float dpp_mov(float v) { return __builtin_bit_cast(float, __builtin_amdgcn_update_dpp(0, __builtin_bit_cast(int, v), CTRL, 0xf, 0xf, true)); }
DI float swap32_sum(float x) { auto r = __builtin_amdgcn_permlane32_swap(__float_as_uint(x), __float_as_uint(x), false, false); return __uint_as_float(r[0]) + __uint_as_float(r[1]); }
DI float swap32_max(float x) { auto r = __builtin_amdgcn_permlane32_swap(__float_as_uint(x), __float_as_uint(x), false, false); return fmaxf(__uint_as_float(r[0]), __uint_as_float(r[1])); }
DI float wave_sum_dpp(float x);
DI float swap16_sum(float x) { auto r = __builtin_amdgcn_permlane16_swap(__float_as_uint(x), __float_as_uint(x), false, false); return __uint_as_float(r[0]) + __uint_as_float(r[1]); }

DI float wave_sum_dpp(float x) {
    x += dpp_mov<0xB1>(x);
    x += dpp_mov<0x4E>(x);
    x += dpp_mov<0x141>(x);
    x += dpp_mov<0x140>(x);
    return swap32_sum(swap16_sum(x));
}

namespace pg8 {
constexpr int BM = 256, BK = 64, HALF = 128, HTB = HALF * BK * 2, STAGE_BYTES = 8 * HTB, NXCD = 8, WGM = 4;
__host__ __device__ __forceinline__ int lds_byte(int r, int c) { const int st = (r >> 4) * 2 + (c >> 5), rr = r & 15, cc = c & 31, ob = rr * 64 + cc * 2; return st * 1024 + (ob ^ (((ob >> 9) & 1) << 5)); }
__host__ __device__ __forceinline__ void stage_rc(int b, int& R, int& C) { const int st = b / 1024, sb = b % 1024, swz = sb ^ (((sb >> 9) & 1) << 5); R = (st >> 1) * 16 + swz / 64; C = (st & 1) * 32 + (swz % 64) / 2; }
__host__ __device__ __forceinline__ int perm32(int rho) { const int n = rho >> 4, i = rho & 15; return 8 * (i >> 2) + 4 * n + (i & 3); }

struct Unit { int pm, pn, z; };
struct Gemm { const bf16_t* A0; const bf16_t* A1; const bf16_t* B0; const bf16_t* B1; int K; };
struct StaticOrder {
    int nM, nN, nwg, G, c, nz, wgm;
    __device__ void init(int M_, int N_, int G_, int c_, int nz_, int wgm_ = WGM) { nM = M_ / BM; nN = N_ / BM; nwg = nM * nN; G = G_; c = c_; nz = nz_; wgm = wgm_; }
    __device__ bool next(int i, Unit& u) const {
        const int ti = i / nz; u.z = i - ti * nz;
        const long L = (long)ti * G + c; if (L >= nwg) return false;
        if (wgm < 0) { u.pm = c & 7; u.pn = 0; return true; }
        int wgid = (int)L; { const int q = nwg / NXCD, r = nwg % NXCD, xcd = wgid % NXCD, off = wgid / NXCD; wgid = (xcd < r ? xcd * (q + 1) : r * (q + 1) + (xcd - r) * q) + off; }
        const int nig = wgm * nN, gid = wgid / nig, fm = gid * wgm, gsz = (nM - fm) < wgm ? (nM - fm) : wgm;
        u.pm = fm + ((wgid % nig) % gsz); u.pn = (wgid % nig) / gsz; return true;
    }
};

template <class Epi, bool ALIGN_EPI, bool SP2>
__device__ __forceinline__ void gemm_phase(LAS unsigned char* lds, const Gemm g, const StaticOrder& S, const Epi& E) {
    const int tid = threadIdx.x, wid = __builtin_amdgcn_readfirstlane(tid >> 6), lane = tid & 63, wr = wid >> 2, wc = wid & 3, fr = lane & 15, fq = lane >> 4;
    const int K = g.K, nt = K / BK;
    unsigned voffA[2], voffB[2];
#pragma unroll
    for (int i = 0; i < 2; ++i) { int R, C; stage_rc(tid * 16 + i * 8192, R, C); const int Rb = Epi::PERM ? ((R & ~31) + perm32(R & 31)) : R;
        voffA[i] = (unsigned)(R * K + C) * 2u; voffB[i] = (unsigned)(Rb * K + C) * 2u; }
    const size_t kstep = (size_t)(BK * 2);
    const size_t hstep = (size_t)HALF * K * 2;
    const size_t tstep = 2 * hstep;
    const unsigned ldsw = (unsigned)wid * 1024u;
    const int aoff = lds_byte(wr * 64 + fr, fq * 8), boff = lds_byte(wc * 32 + fr, fq * 8);
#define PG8_SA(b, h) (((b) * 2 + (h)) * HTB)
#define PG8_SB(b, h) ((4 + (b) * 2 + (h)) * HTB)
#define PG8_STAGE(bufoff, gbase, voff) do { _Pragma("unroll") for (int _i = 0; _i < 2; ++_i) \
        __builtin_amdgcn_global_load_lds((const unsigned*)((const char*)(gbase) + (voff)[_i]), (LAS unsigned*)(lds + (bufoff) + ldsw + _i * 8192), 16, 0, 0); } while (0)
#define PG8_LDA(dst, b, h) do { _Pragma("unroll") for (int m = 0; m < 4; ++m) _Pragma("unroll") for (int k = 0; k < 2; ++k) dst[m][k] = *(const LAS bf16x8*)(lds + PG8_SA(b, h) + aoff + m * 2048 + k * 1024); } while (0)
#define PG8_LDB(dst, b, h) do { _Pragma("unroll") for (int n = 0; n < 2; ++n) _Pragma("unroll") for (int k = 0; k < 2; ++k) dst[n][k] = *(const LAS bf16x8*)(lds + PG8_SB(b, h) + boff + n * 2048 + k * 1024); } while (0)
#define PG8_MMA(ai, bj, At, Bt) do { __builtin_amdgcn_s_setprio(1); _Pragma("unroll") for (int m = 0; m < 4; ++m) _Pragma("unroll") for (int n = 0; n < 2; ++n) _Pragma("unroll") for (int k = 0; k < 2; ++k) \
        acc[ai][bj][m][n] = __builtin_amdgcn_mfma_f32_16x16x32_bf16(Bt[n][k], At[m][k], acc[ai][bj][m][n], 0, 0, 0); __builtin_amdgcn_s_setprio(0); } while (0)
#define PG8_WAIT_V(n) asm volatile("s_waitcnt vmcnt(" #n ")" ::: "memory")
#define PG8_WAIT_L(n) asm volatile("s_waitcnt lgkmcnt(" #n ")" ::: "memory")
#define PG8_BAR __builtin_amdgcn_s_barrier()
#define PG8_SCHED __builtin_amdgcn_sched_barrier(0)
    Unit cur, nxt; int ui = 0;
    if (!S.next(0, cur)) return;
    f32x4 acc[2][2][4][2];
#pragma unroll
    for (int a = 0; a < 2; ++a)
#pragma unroll
        for (int b = 0; b < 2; ++b)
#pragma unroll
            for (int m = 0; m < 4; ++m)
#pragma unroll
                for (int n = 0; n < 2; ++n) acc[a][b][m][n] = (f32x4){0.f, 0.f, 0.f, 0.f};
    bf16x8 At[4][2], B0[2][2], B1[2][2];
    const char* cA = (const char*)(cur.z ? g.A1 : g.A0) + (size_t)cur.pm * tstep; const char* cB = (const char*)(cur.z ? g.B1 : g.B0) + (size_t)cur.pn * tstep;
    if constexpr (SP2) {
        PG8_STAGE(PG8_SB(0, 0), cB, voffB); PG8_STAGE(PG8_SB(0, 1), cB + hstep, voffB); PG8_STAGE(PG8_SA(0, 0), cA, voffA); PG8_STAGE(PG8_SA(0, 1), cA + hstep, voffA);
        if (wr == 1) PG8_BAR;
        PG8_WAIT_V(2); PG8_BAR;
        PG8_STAGE(PG8_SB(1, 0), cB + kstep, voffB); PG8_STAGE(PG8_SA(1, 0), cA + kstep, voffA); PG8_STAGE(PG8_SB(1, 1), cB + hstep + kstep, voffB);
        PG8_WAIT_V(6); PG8_BAR;
    } else {
        PG8_STAGE(PG8_SB(0, 0), cB, voffB); PG8_STAGE(PG8_SA(0, 0), cA, voffA); PG8_STAGE(PG8_SB(0, 1), cB + hstep, voffB); PG8_STAGE(PG8_SA(0, 1), cA + hstep, voffA);
        if (wr == 1) PG8_BAR;
        PG8_WAIT_V(4); PG8_BAR;
        PG8_STAGE(PG8_SB(1, 0), cB + kstep, voffB); PG8_STAGE(PG8_SA(1, 0), cA + kstep, voffA); PG8_STAGE(PG8_SB(1, 1), cB + hstep + kstep, voffB);
        PG8_WAIT_V(6); PG8_BAR;
    }
    for (;;) {
        const bool has_next = S.next(ui + 1, nxt);
        const char* nA = has_next ? (const char*)(nxt.z ? g.A1 : g.A0) + (size_t)nxt.pm * tstep : cA; const char* nB = has_next ? (const char*)(nxt.z ? g.B1 : g.B0) + (size_t)nxt.pn * tstep : cB;
        for (int t = 0; t < nt; t += 2) {
            if constexpr (Epi::MID_T > 0) { if (t == Epi::MID_T) { E.mid(acc, cur, wr, wc, fr, fq); asm volatile("s_waitcnt vmcnt(0)" ::: "memory"); } }
            const bool last = (t == nt - 2);
            const char* a1 = cA + (size_t)(t + 1) * kstep;
            const char* a2 = last ? nA : cA + (size_t)(t + 2) * kstep; const char* b2 = last ? nB : cB + (size_t)(t + 2) * kstep;
            const char* a3 = a2 + kstep; const char* b3 = b2 + kstep;
            if constexpr (SP2) {
            PG8_LDB(B0, 0, 0); PG8_LDB(B1, 0, 1); PG8_SCHED; PG8_LDA(At, 0, 0); PG8_STAGE(PG8_SA(1, 1), a1 + hstep, voffA);
            PG8_WAIT_V(8); PG8_WAIT_L(0); PG8_BAR; PG8_MMA(0, 0, At, B0); PG8_MMA(0, 1, At, B1); PG8_BAR; PG8_SCHED;
            PG8_LDA(At, 0, 1); PG8_STAGE(PG8_SB(0, 0), b2, voffB); PG8_STAGE(PG8_SB(0, 1), b2 + hstep, voffB); PG8_STAGE(PG8_SA(0, 0), a2, voffA);
            PG8_WAIT_V(8); PG8_WAIT_L(0); PG8_BAR; PG8_MMA(1, 0, At, B0); PG8_MMA(1, 1, At, B1); PG8_BAR; PG8_SCHED;
            PG8_LDB(B0, 1, 0); PG8_LDB(B1, 1, 1); PG8_SCHED; PG8_LDA(At, 1, 0); PG8_STAGE(PG8_SA(0, 1), a2 + hstep, voffA);
            PG8_WAIT_V(8); PG8_WAIT_L(0); PG8_BAR; PG8_MMA(0, 0, At, B0); PG8_MMA(0, 1, At, B1); PG8_BAR; PG8_SCHED;
            PG8_LDA(At, 1, 1); PG8_STAGE(PG8_SB(1, 0), b3, voffB); PG8_STAGE(PG8_SB(1, 1), b3 + hstep, voffB); PG8_STAGE(PG8_SA(1, 0), a3, voffA);
            PG8_WAIT_V(8); PG8_WAIT_L(0); PG8_BAR; PG8_MMA(1, 0, At, B0); PG8_MMA(1, 1, At, B1); PG8_BAR; PG8_SCHED;
            } else {
            PG8_LDB(B0, 0, 0); PG8_SCHED; PG8_LDA(At, 0, 0); PG8_STAGE(PG8_SA(1, 1), a1 + hstep, voffA);
            PG8_WAIT_L(8); PG8_BAR; PG8_WAIT_L(0); PG8_MMA(0, 0, At, B0); PG8_BAR; PG8_SCHED;
            PG8_LDB(B1, 0, 1); PG8_STAGE(PG8_SB(0, 0), b2, voffB);
            PG8_BAR; PG8_WAIT_L(0); PG8_MMA(0, 1, At, B1); PG8_BAR;
            PG8_LDA(At, 0, 1); PG8_STAGE(PG8_SA(0, 0), a2, voffA);
            PG8_BAR; PG8_WAIT_L(0); PG8_MMA(1, 0, At, B0); PG8_BAR; PG8_SCHED;
            PG8_STAGE(PG8_SB(0, 1), b2 + hstep, voffB);
            PG8_WAIT_V(6); PG8_BAR; PG8_MMA(1, 1, At, B1); PG8_BAR;
            PG8_LDB(B0, 1, 0); PG8_SCHED; PG8_LDA(At, 1, 0); PG8_STAGE(PG8_SA(0, 1), a2 + hstep, voffA);
            PG8_WAIT_L(8); PG8_BAR; PG8_WAIT_L(0); PG8_MMA(0, 0, At, B0); PG8_BAR; PG8_SCHED;
            PG8_LDB(B1, 1, 1); PG8_STAGE(PG8_SB(1, 0), b3, voffB);
            PG8_BAR; PG8_WAIT_L(0); PG8_MMA(0, 1, At, B1); PG8_BAR;
            PG8_LDA(At, 1, 1); PG8_STAGE(PG8_SA(1, 0), a3, voffA);
            PG8_BAR; PG8_WAIT_L(0); PG8_MMA(1, 0, At, B0); PG8_BAR; PG8_SCHED;
            PG8_STAGE(PG8_SB(1, 1), b3 + hstep, voffB);
            PG8_WAIT_V(6); PG8_BAR; PG8_MMA(1, 1, At, B1); PG8_BAR;
            }
        }
        if constexpr (ALIGN_EPI) { if (wr == 0) PG8_BAR; }
        E(acc, cur, wr, wc, fr, fq);
        if (!has_next) break;
#pragma unroll
        for (int a = 0; a < 2; ++a)
#pragma unroll
            for (int b = 0; b < 2; ++b)
#pragma unroll
                for (int m = 0; m < 4; ++m)
#pragma unroll
                    for (int n = 0; n < 2; ++n) acc[a][b][m][n] = (f32x4){0.f, 0.f, 0.f, 0.f};
        cur = nxt; cA = nA; cB = nB; ++ui;
        if constexpr (ALIGN_EPI) { if (wr == 1) PG8_BAR; }
    }
    PG8_WAIT_V(0);
    if constexpr (!ALIGN_EPI) { if (wr == 0) PG8_BAR; }
    PG8_BAR;
#undef PG8_SA
#undef PG8_SB
#undef PG8_STAGE
#undef PG8_LDA
#undef PG8_LDB
#undef PG8_MMA
#undef PG8_WAIT_V
#undef PG8_WAIT_L
#undef PG8_BAR
#undef PG8_SCHED
}
}
using pg8::Unit; using pg8::HALF; using pg8::BM;
typedef const f32x4 (&AccRef)[2][2][4][2];

template <int MODE> struct EpiInProjT {
    static constexpr bool PERM = true; static constexpr int MID_T = 0;
    unsigned char* ws;
    DI void operator()(AccRef acc, const Unit& u, int wr, int wc, int fr, int fq) const {
        if (MODE == 2) { f32x4 t = {0.f, 0.f, 0.f, 0.f};
#pragma unroll
            for (int ai = 0; ai < 2; ++ai)
#pragma unroll
                for (int bj = 0; bj < 2; ++bj)
#pragma unroll
                    for (int m = 0; m < 4; ++m) { t += acc[ai][bj][m][0]; t += acc[ai][bj][m][1]; }
            if (t[0] + t[1] + t[2] + t[3] == 123.456f) *(float*)ws = 1.f; return; }
        const int pn = u.pn; bf16_t* base; int ld, ct; bool sig = false;
        if (pn < 4) { base = (bf16_t*)(ws + WS_PR); ld = 1024; ct = pn; }
        else if (pn < 8) { base = (bf16_t*)(ws + WS_PK); ld = 1024; ct = pn - 4; }
        else if (pn < 12) { base = (bf16_t*)(ws + WS_PV); ld = 1024; ct = pn - 8; }
        else if (pn < 16) { base = (bf16_t*)(ws + WS_PQ); ld = 1024; ct = pn - 12; }
        else if (pn < 22) { base = (bf16_t*)(ws + WS_PKV); ld = 1536; ct = pn - 16; }
        else if (pn < 38) { base = (bf16_t*)(ws + WS_PMG); ld = 4096; ct = pn - 22; sig = true; }
        else { base = (bf16_t*)(ws + WS_PMISC); ld = 512; ct = pn - 38; }
        const int row0 = u.pm * BM + wr * 64 + fr, col0 = ct * BM + wc * 32 + 8 * fq;
#pragma unroll
        for (int ai = 0; ai < 2; ++ai)
#pragma unroll
            for (int m = 0; m < 4; ++m) { bf16_t* rowp = base + (size_t)(row0 + ai * HALF + m * 16) * ld + col0;
#pragma unroll
                for (int bj = 0; bj < 2; ++bj) { f32x4 v0 = acc[ai][bj][m][0], v1 = acc[ai][bj][m][1];
                    if (sig) {
#pragma unroll
                        for (int e = 0; e < 4; ++e) { v0[e] = sigmoidf_(v0[e]); v1[e] = sigmoidf_(v1[e]); } }
                    u32x4 w; w.x = pk2(v0[0], v0[1]); w.y = pk2(v0[2], v0[3]); w.z = pk2(v1[0], v1[1]); w.w = pk2(v1[2], v1[3]);
                    if (MODE == 0) *(u32x4*)(rowp + bj * HALF) = w; else if (w.x == 0x12345678u && w.w == 0x9abcdef0u) *(u32x4*)(rowp + bj * HALF) = w; } }
    }
};
typedef EpiInProjT<0> EpiInProj;
struct EpiMerge {
    static constexpr bool PERM = true;
    static constexpr int MID_T = 16;
    const bf16_t* mg; bf16_t* mixed;
    DI void mid(f32x4 (&acc)[2][2][4][2], const Unit& u, int wr, int wc, int fr, int fq) const {
        int row0 = u.pm * BM + wr * 64 + fr, col0 = u.pn * BM + wc * 32 + 8 * fq;
        asm volatile("" : "+v"(row0), "+v"(col0));
#pragma unroll
        for (int ai = 0; ai < 2; ++ai)
#pragma unroll
            for (int m = 0; m < 4; ++m) { const size_t row = (size_t)(row0 + ai * HALF + m * 16);
#pragma unroll
                for (int bj = 0; bj < 2; ++bj) { const int col = col0 + bj * HALF;
                    const u32x4 ga = *(const u32x4*)(mg + row * 4096 + col), gb = *(const u32x4*)(mg + row * 4096 + 2048 + col);
#pragma unroll
                    for (int e = 0; e < 4; ++e) { const float s0 = lo16(ga[e]) * __builtin_amdgcn_rcpf(fmaxf(lo16(gb[e]), 1e-20f)), s1 = hi16(ga[e]) * __builtin_amdgcn_rcpf(fmaxf(hi16(gb[e]), 1e-20f));
                        acc[ai][bj][m][e >> 1][2 * (e & 1)] *= s0; acc[ai][bj][m][e >> 1][2 * (e & 1) + 1] *= s1; } }
                __builtin_amdgcn_sched_barrier(0); }
    }
    DI void operator()(AccRef acc, const Unit& u, int wr, int wc, int fr, int fq) const {
        const int row0 = u.pm * BM + wr * 64 + fr, col0 = u.pn * BM + wc * 32 + 8 * fq;
#pragma unroll
        for (int ai = 0; ai < 2; ++ai)
#pragma unroll
            for (int m = 0; m < 4; ++m) { const size_t row = (size_t)(row0 + ai * HALF + m * 16);
#pragma unroll
                for (int bj = 0; bj < 2; ++bj) { const int col = col0 + bj * HALF;
                    const u32x4 gb = *(const u32x4*)(mg + row * 4096 + 2048 + col); u32x4 w;
#pragma unroll
                    for (int e = 0; e < 4; ++e) w[e] = pk2(acc[ai][bj][m][e >> 1][2 * (e & 1)] * fmaxf(lo16(gb[e]), 1e-20f), acc[ai][bj][m][e >> 1][2 * (e & 1) + 1] * fmaxf(hi16(gb[e]), 1e-20f));
                    *(u32x4*)(mixed + row * 2048 + col) = w; } }
    }
};
struct EpiWout {
    static constexpr bool PERM = false; static constexpr int MID_T = 0;
    const float* x; const float* mod; const float* m2v; float* x1; bf16_t* x1m; float* sumsq;
    DI void operator()(AccRef acc, const Unit& u, int wr, int wc, int fr, int fq) const {
        const int row0 = u.pm * BM + wr * 64 + fr, col0 = u.pn * BM + wc * 32 + 4 * fq; const int b = (u.pm * BM) / T;
        const float* gt1 = mod + (size_t)b * 12288 + 4096; const float* mv = m2v + (size_t)b * 2048;
        f32x4 gv[2][2], m2[2][2];
#pragma unroll
        for (int bj = 0; bj < 2; ++bj)
#pragma unroll
            for (int n = 0; n < 2; ++n) { gv[bj][n] = *(const f32x4*)(gt1 + col0 + bj * HALF + n * 16); m2[bj][n] = *(const f32x4*)(mv + col0 + bj * HALF + n * 16); }
        f32x4 xn[2][2];
#pragma unroll
        for (int bj = 0; bj < 2; ++bj)
#pragma unroll
            for (int n = 0; n < 2; ++n) xn[bj][n] = *(const f32x4*)(x + (size_t)row0 * D + col0 + bj * HALF + n * 16);
#pragma unroll
        for (int gi = 0; gi < 8; ++gi) { const int ai = gi >> 2, m = gi & 3; const size_t row = (size_t)(row0 + ai * HALF + m * 16); float ss = 0.f;
            f32x4 xc[2][2];
#pragma unroll
            for (int bj = 0; bj < 2; ++bj)
#pragma unroll
                for (int n = 0; n < 2; ++n) xc[bj][n] = xn[bj][n];
            if (gi < 7) { const size_t rown = (size_t)(row0 + ((gi + 1) >> 2) * HALF + ((gi + 1) & 3) * 16);
#pragma unroll
                for (int bj = 0; bj < 2; ++bj)
#pragma unroll
                    for (int n = 0; n < 2; ++n) xn[bj][n] = *(const f32x4*)(x + rown * D + col0 + bj * HALF + n * 16); }
#pragma unroll
            for (int bj = 0; bj < 2; ++bj)
#pragma unroll
                for (int n = 0; n < 2; ++n) { const int col = col0 + bj * HALF + n * 16;
                    const f32x4 v = xc[bj][n] + gv[bj][n] * acc[ai][bj][m][n];
                    *(f32x4*)(x1 + row * D + col) = v; ss += (v[0] * v[0] + v[1] * v[1]) + (v[2] * v[2] + v[3] * v[3]);
                    const f32x4 vm = v * m2[bj][n]; u32x2 w; w.x = pk2(vm[0], vm[1]); w.y = pk2(vm[2], vm[3]); *(u32x2*)(x1m + row * D + col) = w; }
            ss += __shfl_xor(ss, 16); ss += __shfl_xor(ss, 32);
            if (fq == 0) atomicAdd(sumsq + row, ss);
            __builtin_amdgcn_sched_barrier(0); }
    }
};
struct EpiUp {
    static constexpr bool PERM = true; static constexpr int MID_T = 0;
    const float* sumsq; const float* c2; bf16_t* uo;
    DI void operator()(AccRef acc, const Unit& u, int wr, int wc, int fr, int fq) const {
        const int row0 = u.pm * BM + wr * 64 + fr, col0 = u.pn * BM + wc * 32 + 8 * fq; const int b = (u.pm * BM) / T;
        const float* cb = c2 + (size_t)b * DFF + col0;
        f32x4 cv[2][2];
#pragma unroll
        for (int bj = 0; bj < 2; ++bj)
#pragma unroll
            for (int n = 0; n < 2; ++n) cv[bj][n] = *(const f32x4*)(cb + bj * HALF + 4 * n);
#pragma unroll
        for (int ai = 0; ai < 2; ++ai)
#pragma unroll
            for (int m = 0; m < 4; ++m) { const size_t row = (size_t)(row0 + ai * HALF + m * 16);
                const float rstd = rsqrtf(sumsq[row] * (1.f / D) + NORM_EPS);
#pragma unroll
                for (int bj = 0; bj < 2; ++bj) { f32x4 v0 = acc[ai][bj][m][0] * rstd + cv[bj][0], v1 = acc[ai][bj][m][1] * rstd + cv[bj][1];
#pragma unroll
                    for (int e = 0; e < 4; ++e) { const float a0 = fmaxf(v0[e], 0.f), a1 = fmaxf(v1[e], 0.f); v0[e] = a0 * a0; v1[e] = a1 * a1; }
                    u32x4 w; w.x = pk2(v0[0], v0[1]); w.y = pk2(v0[2], v0[3]); w.z = pk2(v1[0], v1[1]); w.w = pk2(v1[2], v1[3]);
                    *(u32x4*)(uo + row * DFF + col0 + bj * HALF) = w; } }
    }
};
struct EpiDown {
    static constexpr bool PERM = false; static constexpr int MID_T = 0;
    const float* mod; float* out;
    DI void operator()(AccRef acc, const Unit& u, int wr, int wc, int fr, int fq) const {
        const int row0 = u.pm * BM + wr * 64 + fr, col0 = u.pn * BM + wc * 32 + 4 * fq; const int b = (u.pm * BM) / T;
        const float* gt2 = mod + (size_t)b * 12288 + 10240;
        f32x4 gv[2][2];
#pragma unroll
        for (int bj = 0; bj < 2; ++bj)
#pragma unroll
            for (int n = 0; n < 2; ++n) gv[bj][n] = *(const f32x4*)(gt2 + col0 + bj * HALF + n * 16);
        f32x4 xn[2][2];
#pragma unroll
        for (int bj = 0; bj < 2; ++bj)
#pragma unroll
            for (int n = 0; n < 2; ++n) xn[bj][n] = *(const f32x4*)(out + (size_t)row0 * D + col0 + bj * HALF + n * 16);
#pragma unroll
        for (int gi = 0; gi < 8; ++gi) { const int ai = gi >> 2, m = gi & 3; const size_t row = (size_t)(row0 + ai * HALF + m * 16);
            f32x4 xc[2][2];
#pragma unroll
            for (int bj = 0; bj < 2; ++bj)
#pragma unroll
                for (int n = 0; n < 2; ++n) xc[bj][n] = xn[bj][n];
            if (gi < 7) { const size_t rown = (size_t)(row0 + ((gi + 1) >> 2) * HALF + ((gi + 1) & 3) * 16);
#pragma unroll
                for (int bj = 0; bj < 2; ++bj)
#pragma unroll
                    for (int n = 0; n < 2; ++n) xn[bj][n] = *(const f32x4*)(out + rown * D + col0 + bj * HALF + n * 16); }
#pragma unroll
            for (int bj = 0; bj < 2; ++bj)
#pragma unroll
                for (int n = 0; n < 2; ++n) *(f32x4*)(out + row * D + col0 + bj * HALF + n * 16) = xc[bj][n] + gv[bj][n] * acc[ai][bj][m][n];
            __builtin_amdgcn_sched_barrier(0); }
    }
};

struct Args { const float* in[32]; float* out; unsigned char* ws; int ph_lo, ph_hi; };
struct Frame {
    unsigned char* lds; LAS unsigned char* lds3;
    int tid, lane, wave, gw, NGW, G, blk;
    const float* const* in; float* out; unsigned char* ws;
};
#define LDS_WAIT() asm volatile("s_waitcnt lgkmcnt(0)" ::: "memory")

DI int win_map(int n) {
    if (n < 3072) return n;
    if (n < 4096) return 3360 + (n - 3072);
    if (n < 5632) return 4384 + (n - 4096);
    if (n < 9728) return 5968 + (n - 5632);
    if (n < 10016) return 3072 + (n - 9728);
    if (n < 10064) return 5920 + (n - 10016);
    return -1;
}
DI void transpose_item(const float* __restrict__ W, int ldW, int K, bf16_t* __restrict__ WT, int ldT, int k0, int n0, bool wmap, unsigned* scr, int lane) {
    const int n4 = lane & 15, kq = lane >> 4; const int nn = n0 + 4 * n4; const int src = wmap ? win_map(nn) : nn;
    f32x4 v[16];
#pragma unroll
    for (int i = 0; i < 16; ++i) { const int k = k0 + 8 * (i >> 1) + 2 * kq + (i & 1);
        v[i] = (f32x4){0.f, 0.f, 0.f, 0.f}; if (src >= 0 && k < K) v[i] = *(const f32x4*)(W + (size_t)k * ldW + src); }
#pragma unroll
    for (int p = 0; p < 8; ++p)
#pragma unroll
        for (int e = 0; e < 4; ++e) scr[(4 * n4 + e) * 33 + 4 * p + kq] = pk2(v[2 * p][e], v[2 * p + 1][e]);
    LDS_WAIT(); asm volatile("" ::: "memory");
    const int c = lane & 7;
    if (k0 + 8 * c < K) {
#pragma unroll
        for (int j = 0; j < 8; ++j) { const int n = (lane >> 3) + 8 * j; const unsigned* sp = scr + n * 33 + 4 * c;
            *(u32x4*)(WT + (size_t)(n0 + n) * ldT + k0 + 8 * c) = (u32x4){sp[0], sp[1], sp[2], sp[3]}; }
    }
    LDS_WAIT(); asm volatile("" ::: "memory");
}
DI int rel_bucket_dev(int rel) {
    if (rel < 16) return rel;
    const int thr[15] = {19, 21, 24, 27, 31, 35, 40, 46, 52, 59, 67, 77, 87, 99, 113};
    int bkt = 16;
#pragma unroll
    for (int i = 0; i < 15; ++i) bkt += (rel >= thr[i]) ? 1 : 0;
    return bkt;
}
DI void phase_a(Frame& F, bool first) {
    unsigned* scr = (unsigned*)(F.lds + F.wave * 8448);
    float* sc = (float*)(F.lds + 73728);
    const float* c = F.in[1];
    for (int i = F.tid; i < BATCH * D; i += NTHREADS) { const int b = i >> 11, d = i & 2047; const float cv = c[i]; sc[d * 8 + b] = cv / (1.f + __expf(-cv)); }
    __syncthreads();
    if (first) {
        const float* w_ada = F.in[2]; const float* b_ada = F.in[3]; float* mod = (float*)(F.ws + WS_MOD);
        for (int item = F.gw; item < 1536; item += F.NGW) {
            const int cgi = item % 48, ds = item / 48, c0 = 256 * cgi + 4 * F.lane, d0 = 64 * ds;
            f32x4 acc[8];
#pragma unroll
            for (int b = 0; b < 8; ++b) acc[b] = (f32x4){0.f, 0.f, 0.f, 0.f};
#pragma unroll 8
            for (int d = d0; d < d0 + 64; ++d) {
                const f32x4 wv = *(const f32x4*)(w_ada + (size_t)d * 12288 + c0);
                const f32x4 s0 = *(const f32x4*)(sc + d * 8), s1 = *(const f32x4*)(sc + d * 8 + 4);
                acc[0] += s0[0] * wv; acc[1] += s0[1] * wv; acc[2] += s0[2] * wv; acc[3] += s0[3] * wv;
                acc[4] += s1[0] * wv; acc[5] += s1[1] * wv; acc[6] += s1[2] * wv; acc[7] += s1[3] * wv;
            }
            f32x4 bv = (f32x4){0.f, 0.f, 0.f, 0.f}; if (ds == 0) bv = *(const f32x4*)(b_ada + c0);
#pragma unroll
            for (int b = 0; b < 8; ++b)
#pragma unroll
                for (int e = 0; e < 4; ++e) atomicAdd(mod + (size_t)b * 12288 + c0 + e, acc[b][e] + bv[e]);
        }
    }
    {
        struct MatD { const float* W; int ldW, K; size_t off; int ldT, nblk, kblk; bool wmap; };
        const MatD mats[13] = {
            {F.in[6], IN_COLS, 2048, WS_WIN, 2048, NCOLS / 64, 32, true},
            {F.in[27], 2048, 1024, WS_WOA, 2048, 32, 16, false},
            {F.in[28], 2048, 1024, WS_WOA + 2048, 2048, 32, 16, false},
            {F.in[29], 2048, 2048, WS_WOUT, 2048, 32, 32, false},
            {F.in[30], 8192, 2048, WS_WUP, 2048, 128, 32, false},
            {F.in[31], 2048, 8192, WS_WDOWN, 8192, 32, 128, false},
            {F.in[9], 1024, 64, WS_W2T, 64, 16, 1, false},
            {F.in[11], 1024, 64, WS_A2T, 64, 16, 1, false},
            {F.in[12], 1024, 160, WS_G2T, 160, 16, 3, false},
            {F.in[19], 64, 2048, WS_CW1K, 2048, 1, 32, false},
            {F.in[22], 64, 2048, WS_CW1V, 2048, 1, 32, false},
            {F.in[20], 64, 64, WS_CW2K, 64, 1, 1, false},
            {F.in[23], 64, 64, WS_CW2V, 64, 1, 1, false}};
        int total = 0;
#pragma unroll
        for (int i = 0; i < 13; ++i) total += mats[i].nblk * mats[i].kblk;
        for (int it = F.gw; it < total; it += F.NGW) {
            int r = it, mi = 0;
#pragma unroll
            for (int i = 0; i < 12; ++i) { const int cnt = mats[i].nblk * mats[i].kblk; if (mi == i && r >= cnt) { r -= cnt; mi = i + 1; } }
            const float* W = mats[0].W; int ldW = mats[0].ldW, K = mats[0].K, ldT = mats[0].ldT, nblk = mats[0].nblk; size_t off = mats[0].off; bool wm = mats[0].wmap;
#pragma unroll
            for (int i = 1; i < 13; ++i) if (mi == i) { W = mats[i].W; ldW = mats[i].ldW; K = mats[i].K; ldT = mats[i].ldT; nblk = mats[i].nblk; off = mats[i].off; wm = mats[i].wmap; }
            const int kb = r / nblk, nb = r % nblk;
            transpose_item(W, ldW, K, (bf16_t*)(F.ws + off), ldT, 64 * kb, 64 * nb, wm, scr, F.lane);
        }
    }
    const int gt = F.blk * NTHREADS + F.tid;
    if (gt < 2048) { const int hq = gt >> 7, rel = gt & 127; const float* rb = F.in[26];
        ((float*)(F.ws + WS_BIAS))[gt] = rb[rel_bucket_dev(rel) * 16 + hq] - rb[31 * 16 + hq]; }
    if (gt >= 4096 && gt < 4096 + 2048) { const int i = gt - 4096, b = i >> 8, e = i & 255; ((bf16_t*)(F.ws + WS_KC))[((size_t)(b * 128 + 127)) * 256 + e] = 0; }
    if (gt >= 8192 && gt < 8192 + 2048) { const int i = gt - 8192; ((bf16_t*)(F.ws + WS_VCT))[(size_t)i * 128 + 127] = 0; }
    if (F.gw == F.NGW - 1 || F.gw == F.NGW - 2) {
        const int kv = (F.gw == F.NGW - 1) ? 0 : 1; const float* pe = F.in[kv ? 21 : 18]; const float* w1 = F.in[kv ? 22 : 19];
        float a = 0.f;
        for (int k = 0; k < 2048; ++k) a += pe[k] * w1[(size_t)k * 64 + F.lane];
        ((float*)(F.ws + WS_CPE))[kv * 64 + F.lane] = a;
    }
}

DI void phase_b(Frame& F) {
    const float* mod = (const float*)(F.ws + WS_MOD);
    const float* x = F.in[0]; const float* g1 = F.in[4]; const float* g2 = F.in[5];
    bf16_t* H = (bf16_t*)(F.ws + WS_H);
    float* sh2 = (float*)F.lds;
    for (int i = F.tid; i < BATCH * D; i += NTHREADS) { const int b = i >> 11, d = i & 2047; sh2[i] = mod[(size_t)b * 12288 + 6144 + d]; }
    __syncthreads();
    for (int m0 = F.gw * 8; m0 < M; m0 += F.NGW * 8) {
        const int b = m0 / T; const float* mb = mod + (size_t)b * 12288;
        f32x4 cf[8], sh[8], v[8], vn[8];
#pragma unroll
        for (int j = 0; j < 8; ++j) { const int col = 4 * F.lane + 256 * j; vn[j] = *(const f32x4*)(x + (size_t)m0 * D + col);
            cf[j] = *(const f32x4*)(g1 + col) * (1.f + *(const f32x4*)(mb + 2048 + col)); sh[j] = *(const f32x4*)(mb + col); }
#pragma unroll 1
        for (int k = 0; k < 8; ++k) { const int m = m0 + k;
#pragma unroll
            for (int j = 0; j < 8; ++j) v[j] = vn[j];
            const int mn = (k < 7) ? m + 1 : m;
#pragma unroll
            for (int j = 0; j < 8; ++j) vn[j] = *(const f32x4*)(x + (size_t)mn * D + 4 * F.lane + 256 * j);
            float ss = 0.f;
#pragma unroll
            for (int j = 0; j < 8; ++j) ss += (v[j][0] * v[j][0] + v[j][1] * v[j][1]) + (v[j][2] * v[j][2] + v[j][3] * v[j][3]);
            const float rstd = rsqrtf(wave_sum_dpp(ss) * (1.f / D) + NORM_EPS);
#pragma unroll
            for (int j = 0; j < 8; ++j) { const int col = 4 * F.lane + 256 * j;
                const f32x4 o = (v[j] * rstd) * cf[j] + sh[j];
                u32x2 w; w.x = pk2(o[0], o[1]); w.y = pk2(o[2], o[3]); *(u32x2*)(H + (size_t)m * D + col) = w; }
        }
    }
    for (int i = F.blk * NTHREADS + F.tid; i < BATCH * D; i += F.G * NTHREADS) { const int b = i >> 11, d = i & 2047;
        ((float*)(F.ws + WS_M2V))[i] = g2[d] * (1.f + mod[(size_t)b * 12288 + 8192 + d]); }
    const bf16_t* wup = (const bf16_t*)(F.ws + WS_WUP); float* c2 = (float*)(F.ws + WS_C2);
    for (int n = F.gw; n < DFF; n += F.NGW) {
        u32x4 wv[4];
#pragma unroll
        for (int j = 0; j < 4; ++j) wv[j] = *(const u32x4*)(wup + (size_t)n * D + 8 * F.lane + 512 * j);
#pragma unroll 1
        for (int b = 0; b < 8; ++b) { float p = 0.f;
#pragma unroll
            for (int j = 0; j < 4; ++j) { const float* s = sh2 + b * 2048 + 8 * F.lane + 512 * j; const f32x4 s0 = *(const f32x4*)s, s1 = *(const f32x4*)(s + 4);
                p += lo16(wv[j].x) * s0[0] + hi16(wv[j].x) * s0[1] + lo16(wv[j].y) * s0[2] + hi16(wv[j].y) * s0[3]
                   + lo16(wv[j].z) * s1[0] + hi16(wv[j].z) * s1[1] + lo16(wv[j].w) * s1[2] + hi16(wv[j].w) * s1[3]; }
            p = wave_sum_dpp(p); if (F.lane == 0) c2[(size_t)b * DFF + n] = p; }
    }
}

DI f32x4 mfma16(bf16x8 a, bf16x8 b, f32x4 c) { return __builtin_amdgcn_mfma_f32_16x16x32_bf16(a, b, c, 0, 0, 0); }
DI f32x16 mfma32(bf16x8 a, bf16x8 b, f32x16 c) { return __builtin_amdgcn_mfma_f32_32x32x16_bf16(a, b, c, 0, 0, 0); }
DI float fast_tanh(float x) { const float xc = fminf(fmaxf(x, -15.f), 15.f); const float t = __expf(2.f * xc); return (t - 1.f) * __builtin_amdgcn_rcpf(t + 1.f); }
DI float gelu_tanh(float x) { const float u = 0.7978845608028654f * (x + 0.044715f * x * x * x); return 0.5f * x * (1.f + fast_tanh(u)); }
DI float softplusf_(float x) { return fmaxf(x, 0.f) + __logf(1.f + __expf(-fabsf(x))); }
DI unsigned short f2h(float f) { return __builtin_bit_cast(unsigned short, (_Float16)f); }
DI float h2f(unsigned short u) { return (float)__builtin_bit_cast(_Float16, u); }

DI void compress_pair(Frame& F, int pair) {
    const int grp = F.wave >> 2, wq = F.wave & 3, it = 2 * pair + grp;
    const int kv = it >> 8, r_ = it & 255, b = r_ >> 5, g = (r_ >> 3) & 3, nb = r_ & 7;
    const int m = F.lane & 15, q = F.lane >> 4, n = 16 * nb + m; const bool nvalid = n < NC;
    const bf16_t* PKV = (const bf16_t*)(F.ws + WS_PKV);
    const bf16_t* xbase = PKV + (size_t)(b * T + 16 * n) * 1536 + kv * 256 + g * 64;
    const bf16_t* w1t = (const bf16_t*)(F.ws + (kv ? WS_CW1V : WS_CW1K));
    const bf16_t* w2t = (const bf16_t*)(F.ws + (kv ? WS_CW2V : WS_CW2K));
    const float* cpe = (const float*)(F.ws + WS_CPE) + kv * 64;
    f32x4* part = (f32x4*)F.lds;
    f32x4 acc[4];
#pragma unroll
    for (int i = 0; i < 4; ++i) acc[i] = (f32x4){0.f, 0.f, 0.f, 0.f};
#pragma unroll 4
    for (int ks = 16 * wq; ks < 16 * wq + 16; ++ks) {
        const int k = 32 * ks + 8 * q, tok = k >> 6, d = k & 63;
        bf16x8 bfr = (bf16x8){0, 0, 0, 0, 0, 0, 0, 0};
        if (nvalid) bfr = *(const bf16x8*)(xbase + (size_t)tok * 1536 + d);
#pragma unroll
        for (int ht = 0; ht < 4; ++ht) { const bf16x8 afr = *(const bf16x8*)(w1t + (size_t)(16 * ht + m) * 2048 + k); acc[ht] = mfma16(afr, bfr, acc[ht]); }
    }
#pragma unroll
    for (int ht = 0; ht < 4; ++ht) part[((grp * 4 + wq) * 4 + ht) * 64 + F.lane] = acc[ht];
    __syncthreads();
    if (wq == 0) {
#pragma unroll
        for (int ht = 0; ht < 4; ++ht) { acc[ht] = (part[((grp * 4 + 0) * 4 + ht) * 64 + F.lane] + part[((grp * 4 + 1) * 4 + ht) * 64 + F.lane]) + (part[((grp * 4 + 2) * 4 + ht) * 64 + F.lane] + part[((grp * 4 + 3) * 4 + ht) * 64 + F.lane]);
            const f32x4 cp = *(const f32x4*)(cpe + 16 * ht + 4 * q);
#pragma unroll
            for (int e = 0; e < 4; ++e) acc[ht][e] = gelu_tanh(acc[ht][e] + cp[e]); }
        f32x4 out[4];
#pragma unroll
        for (int i = 0; i < 4; ++i) out[i] = (f32x4){0.f, 0.f, 0.f, 0.f};
#pragma unroll
        for (int kk2 = 0; kk2 < 2; ++kk2) {
            u32x4 bw; bw.x = pk2(acc[2 * kk2][0], acc[2 * kk2][1]); bw.y = pk2(acc[2 * kk2][2], acc[2 * kk2][3]); bw.z = pk2(acc[2 * kk2 + 1][0], acc[2 * kk2 + 1][1]); bw.w = pk2(acc[2 * kk2 + 1][2], acc[2 * kk2 + 1][3]);
            const bf16x8 bfr = __builtin_bit_cast(bf16x8, bw);
#pragma unroll
            for (int dt = 0; dt < 4; ++dt) { const bf16_t* wp = w2t + (size_t)(16 * dt + m) * 64 + 32 * kk2 + 4 * q;
                const u32x2 lo = *(const u32x2*)wp, hi = *(const u32x2*)(wp + 16); u32x4 aw = {lo.x, lo.y, hi.x, hi.y};
                out[dt] = mfma16(__builtin_bit_cast(bf16x8, aw), bfr, out[dt]); }
        }
        if (kv == 0) {
            float ss = 0.f;
#pragma unroll
            for (int dt = 0; dt < 4; ++dt)
#pragma unroll
                for (int e = 0; e < 4; ++e) ss += out[dt][e] * out[dt][e];
            ss += __shfl_xor(ss, 16); ss += __shfl_xor(ss, 32);
            const float rstd = rsqrtf(ss * (1.f / 64.f) + NORM_EPS); const float* kg = F.in[25];
            if (nvalid) {
                bf16_t* kc = (bf16_t*)(F.ws + WS_KC) + ((size_t)(b * 128 + n) * 4 + g) * 64;
#pragma unroll
                for (int dt = 0; dt < 4; ++dt) { const int d = 16 * dt + 4 * q; const f32x4 gv = *(const f32x4*)(kg + d); const f32x4 o = out[dt] * rstd * gv;
                    u32x2 w; w.x = pk2(o[0], o[1]); w.y = pk2(o[2], o[3]); *(u32x2*)(kc + d) = w; }
            }
        } else if (nvalid) {
            bf16_t* vct = (bf16_t*)(F.ws + WS_VCT) + (size_t)(b * 4 + g) * 64 * 128 + n;
#pragma unroll
            for (int dt = 0; dt < 4; ++dt)
#pragma unroll
                for (int e = 0; e < 4; ++e) vct[(size_t)(16 * dt + 4 * q + e) * 128] = (bf16_t)f2bf(out[dt][e]);
        }
    }
    __syncthreads();
}

template <int N> DI float row_shr(float v) { return __builtin_bit_cast(float, __builtin_amdgcn_update_dpp(0, __builtin_bit_cast(int, v), 0x110 + N, 0xf, 0xf, true)); }
DI float row_bcast15(float v) { return __builtin_bit_cast(float, __builtin_amdgcn_update_dpp(0, __builtin_bit_cast(int, v), 0x150 + 15, 0xf, 0xf, true)); }
template <int DMODE, int SV = 0> DI void phase_d(Frame& F) {
    constexpr bool first = (DMODE == 0);
    if (DMODE != 3) for (int pr = F.blk; pr < 256; pr += F.G) compress_pair(F, pr);
    const bf16_t* PR = (const bf16_t*)(F.ws + WS_PR); const bf16_t* PK = (const bf16_t*)(F.ws + WS_PK); const bf16_t* PV = (const bf16_t*)(F.ws + WS_PV);
    const bf16_t* PMISC = (const bf16_t*)(F.ws + WS_PMISC);
    bf16_t* PQ = (bf16_t*)(F.ws + WS_PQ); bf16_t* PKV = (bf16_t*)(F.ws + WS_PKV);
    bf16_t* AT = (bf16_t*)((char*)F.out + DO_AT); bf16_t* BT = (bf16_t*)((char*)F.out + DO_BT); bf16_t* KT = (bf16_t*)((char*)F.out + DO_KT); bf16_t* RT = (bf16_t*)((char*)F.out + DO_RT);
    bf16_t* VM = (bf16_t*)(F.ws + WS_VM); float* GL = (float*)(F.ws + WS_GL);
    bf16_t* GRW = (bf16_t*)(F.ws + WS_GRW); float* BSUM = (float*)(F.ws + WS_BSUM); float* GATES = (float*)(F.ws + WS_GATES);
    const bf16_t* W2T = (const bf16_t*)(F.ws + WS_W2T); const bf16_t* A2T = (const bf16_t*)(F.ws + WS_A2T); const bf16_t* G2T = (const bf16_t*)(F.ws + WS_G2T);
    const float* mu = F.in[7]; const float* w0 = F.in[8]; const float* a0 = F.in[10]; const float* k_k = F.in[13]; const float* k_a = F.in[14]; const float* r_k = F.in[15];
    const float* q_g = F.in[24]; const float* k_g = F.in[25];
    bf16_t* XW = (bf16_t*)F.lds; bf16_t* XA = (bf16_t*)(F.lds + 9216); bf16_t* XG = (bf16_t*)(F.lds + 18432); bf16_t* VT = (bf16_t*)(F.lds + 40960);
    const int q = F.lane >> 4, l16 = F.lane & 15;
    for (int tl = F.blk; tl < M / 64; tl += F.G) {
        const int rowbase = tl * 64, b = rowbase / T, t0 = rowbase % T;
        int tidl = threadIdx.x; asm volatile("" : "+v"(tidl));
#pragma unroll 10
        for (int idx = tidl; idx < 64 * 160; idx += NTHREADS) { const int tok = idx / 160, c = 128 + (idx - tok * 160); const size_t row = rowbase + tok;
            const float cur = bf2f(PMISC[row * 512 + c]); const float prev = (t0 + tok > 0) ? bf2f(PMISC[(row - 1) * 512 + c]) : 0.f;
            const float mv = cur + (prev - cur) * mu[3072 + c];
            XG[tok * 168 + c - 128] = (bf16_t)f2bf(sigmoidf_(mv)); }
#pragma unroll 3
        for (int idx = tidl; idx < 64 * 48; idx += NTHREADS) { const int tok = idx / 48, j = idx - tok * 48; const size_t row = rowbase + tok;
            GATES[row * 48 + j] = sigmoidf_(bf2f(PMISC[row * 512 + 288 + j])); }
#pragma unroll
        for (int i = 0; i < 8; ++i) { const int idx = tidl + NTHREADS * i, s = idx >> 11, rem = idx & 2047, tok = rem >> 5, ch8 = rem & 31;
            const u32x4 v = *(const u32x4*)(PKV + (size_t)(rowbase + tok) * 1536 + (3 + 2 * s) * 256 + ch8 * 8);
            *(u32x4*)(VT + (size_t)(s * 64 + tok) * 264 + ch8 * 8) = v; }
        __syncthreads();
        if (DMODE != 3) { const int s = tidl >> 8, gd = tidl & 255;
          bf16_t* dst = (bf16_t*)(F.ws + (s ? WS_VWT : WS_VST)) + ((size_t)(b * 4 + (gd >> 6)) * 64 + (gd & 63)) * 2048 + t0;
#pragma unroll
          for (int i = 0; i < 8; ++i) { unsigned pk[4];
#pragma unroll
              for (int e = 0; e < 4; ++e) pk[e] = (unsigned)VT[(size_t)(s * 64 + 8 * i + 2 * e) * 264 + gd] | ((unsigned)VT[(size_t)(s * 64 + 8 * i + 2 * e + 1) * 264 + gd] << 16);
              *(u32x4*)(dst + 8 * i) = (u32x4){pk[0], pk[1], pk[2], pk[3]}; } }
#pragma unroll 1
        for (int hh = 0; hh < ((DMODE == 2) ? 0 : 2); ++hh) {
            const int head = 2 * F.wave + hh;
            const unsigned rowoff0 = (unsigned)(rowbase + l16) * 1024u + (unsigned)(head * 64 + 4 * q);
            bf16x8 fgn[5];
#pragma unroll
            for (int ks = 0; ks < 5; ++ks) fgn[ks] = *(const bf16x8*)(G2T + (size_t)(head * 64 + l16) * 160 + 32 * ks + 8 * q);
#pragma unroll 1
            for (int ct = 0; ct < 4; ++ct) {
                bf16x8 fg[5];
#pragma unroll
                for (int ks = 0; ks < 5; ++ks) fg[ks] = fgn[ks];
                { const int ctn = (ct < 3) ? ct + 1 : ct;
#pragma unroll
                  for (int ks = 0; ks < 5; ++ks) fgn[ks] = *(const bf16x8*)(G2T + (size_t)(head * 64 + 16 * ctn + l16) * 160 + 32 * ks + 8 * q); }
#pragma unroll
                for (int tt = 0; tt < 4; ++tt) { const int tokl = 16 * tt + l16; f32x4 ag = {0.f, 0.f, 0.f, 0.f};
#pragma unroll
                    for (int ks = 0; ks < 5; ++ks) ag = mfma16(fg[ks], *(const bf16x8*)(XG + tokl * 168 + 32 * ks + 8 * q), ag);
                    u32x2 w; w.x = pk2(ag[0], ag[1]); w.y = pk2(ag[2], ag[3]); *(u32x2*)(GRW + (rowoff0 + (unsigned)(tt * 16384) + (unsigned)(ct * 16))) = w; }
            }
        }
#pragma unroll 8
        for (int it = 0; it < (first ? 32 : 0); ++it) { const int pair = (F.wave * 32 + it) * 4 + q, tok = pair >> 4, head = pair & 15;
            bf16_t* p = PQ + (size_t)(rowbase + tok) * 1024 + head * 64 + 4 * l16; const u32x2 v = *(const u32x2*)p;
            f32x4 f = {lo16(v.x), hi16(v.x), lo16(v.y), hi16(v.y)}; float ss = (f[0] * f[0] + f[1] * f[1]) + (f[2] * f[2] + f[3] * f[3]);
            ss += __shfl_xor(ss, 1); ss += __shfl_xor(ss, 2); ss += __shfl_xor(ss, 4); ss += __shfl_xor(ss, 8);
            const float rstd = rsqrtf(ss * (1.f / 64.f) + NORM_EPS) * (0.125f * LOG2E); f = f * rstd * *(const f32x4*)(q_g + 4 * l16);
            u32x2 w; w.x = pk2(f[0], f[1]); w.y = pk2(f[2], f[3]); *(u32x2*)p = w; }
#pragma unroll 8
        for (int it = 0; it < (first ? 16 : 0); ++it) { const int pair = (F.wave * 16 + it) * 4 + q, tok = pair >> 3, sg = pair & 7, slot = (sg >> 2) ? 4 : 2, g = sg & 3;
            bf16_t* p = PKV + (size_t)(rowbase + tok) * 1536 + slot * 256 + g * 64 + 4 * l16; const u32x2 v = *(const u32x2*)p;
            f32x4 f = {lo16(v.x), hi16(v.x), lo16(v.y), hi16(v.y)}; float ss = (f[0] * f[0] + f[1] * f[1]) + (f[2] * f[2] + f[3] * f[3]);
            ss += __shfl_xor(ss, 1); ss += __shfl_xor(ss, 2); ss += __shfl_xor(ss, 4); ss += __shfl_xor(ss, 8);
            const float rstd = rsqrtf(ss * (1.f / 64.f) + NORM_EPS); f = f * rstd * *(const f32x4*)(k_g + ((slot == 2) ? 64 : 128) + 4 * l16);
            u32x2 w; w.x = pk2(f[0], f[1]); w.y = pk2(f[2], f[3]); *(u32x2*)p = w; }
        __syncthreads();
    }
}

typedef short s16x4v __attribute__((ext_vector_type(4)));
DI f32x4 mfma16k(s16x4v a, s16x4v b, f32x4 c) { return __builtin_amdgcn_mfma_f32_16x16x16bf16_1k(a, b, c, 0, 0, 0); }
DI s16x4v packbf4(f32x4 v) { u32x2 w = {pk2(v[0], v[1]), pk2(v[2], v[3])}; return __builtin_bit_cast(s16x4v, w); }
DI f32x4 unpackbf4(s16x4v v) { const u32x2 w = __builtin_bit_cast(u32x2, v); return (f32x4){lo16(w.x), hi16(w.x), lo16(w.y), hi16(w.y)}; }
DI s16x4v trread(LAS unsigned char* p) { return __builtin_bit_cast(s16x4v, __builtin_amdgcn_ds_read_tr16_b64_v4i16((LAS s16x4v*)p)); }
constexpr int RC_AT = 0, RC_BT = 9216, RC_KT = 18432, RC_RT = 27648, RC_VV = 36864;
constexpr int RC_MAB = 46080, RC_T = 54272, RC_YO = 46080;
constexpr int RC_MBR = 63488, RC_GY = 71680, RC_GS = 79872, RC_HY = 88064, RC_HS = 96256, RC_S = 104448;
DI f32x4 tile_ch64(const unsigned char* Am, int a0, const unsigned char* Bm, int b0, int c16, int g) {
    f32x4 acc = {0.f, 0.f, 0.f, 0.f};
#pragma unroll
    for (int ks = 0; ks < 2; ++ks) acc = mfma16(*(const bf16x8*)(Am + (a0 + c16) * 144 + (32 * ks + 8 * g) * 2), *(const bf16x8*)(Bm + (b0 + c16) * 144 + (32 * ks + 8 * g) * 2), acc);
    return acc;
}
constexpr int RC_XW = 46080, RC_XA = 55296;
constexpr int RC_RAWR = 64512, RC_RAWK = 73872, RC_RAWV = 83232;
constexpr int RC_RAWX = 120832;
constexpr int RC_SSK = 138512, RC_BSP = 139536, RC_GLV = 140560, RC_BS = 140816, RC_PRM = 141072, RC_CARRY = 143120, RC_MUX = 143760;
DI void rwkv_head(Frame& F, int hd) {
    const int b = hd >> 4, h = hd & 15;
    unsigned char* L = F.lds; LAS unsigned char* L3 = F.lds3;
    const int lane0 = F.lane, w = F.wave;
    const bf16_t* PR = (const bf16_t*)(F.ws + WS_PR); const bf16_t* PK = (const bf16_t*)(F.ws + WS_PK); const bf16_t* PV = (const bf16_t*)(F.ws + WS_PV); const bf16_t* PMISC = (const bf16_t*)(F.ws + WS_PMISC);
    const bf16_t* GRW = (const bf16_t*)(F.ws + WS_GRW);
    bf16_t* OA = (bf16_t*)((char*)F.out + DO_OAB);
    const float* ln_w = F.in[16]; const float* ln_b = F.in[17]; const float* mu = F.in[7];
    float* SSK = (float*)(L + RC_SSK); float* BSP = (float*)(L + RC_BSP); float* GLV = (float*)(L + RC_GLV); float* BS = (float*)(L + RC_BS); float* PRM = (float*)(L + RC_PRM);
    u32x4 pre[5];
    auto fetch = [&](int c, int tid_) { const int srow = tid_ >> 3, sch = tid_ & 7, xrow = tid_ >> 4, xch = tid_ & 15; const size_t row = (size_t)b * T + 64 * c;
        const size_t off = (row + srow) * 1024 + h * 64 + 8 * sch;
        pre[0] = *(const u32x4*)(PR + off); pre[1] = *(const u32x4*)(PK + off); pre[2] = *(const u32x4*)(PV + off);
        pre[3] = *(const u32x4*)(PMISC + (row + xrow) * 512 + 8 * xch); pre[4] = *(const u32x4*)(PMISC + (row + xrow + 32) * 512 + 8 * xch); };
    auto commit = [&](int tid_) { const int srow = tid_ >> 3, sch = tid_ & 7, xrow = tid_ >> 4, xch = tid_ & 15;
        *(u32x4*)(L + RC_RAWR + (srow + 1) * 144 + sch * 16) = pre[0]; *(u32x4*)(L + RC_RAWK + (srow + 1) * 144 + sch * 16) = pre[1]; *(u32x4*)(L + RC_RAWV + (srow + 1) * 144 + sch * 16) = pre[2];
        *(u32x4*)(L + RC_RAWX + (xrow + 1) * 272 + xch * 16) = pre[3]; *(u32x4*)(L + RC_RAWX + (xrow + 33) * 272 + xch * 16) = pre[4];
        if (tid_ < 24) *(u32x4*)(L + RC_RAWR + (tid_ >> 3) * 9360 + (tid_ & 7) * 16) = *(const u32x4*)(L + RC_CARRY + tid_ * 16);
        if (tid_ >= 32 && tid_ < 48) *(u32x4*)(L + RC_RAWX + (tid_ & 15) * 16) = *(const u32x4*)(L + RC_CARRY + 384 + (tid_ & 15) * 16); };
    for (int i = F.tid; i < 8192 / 4; i += NTHREADS) ((unsigned*)(L + RC_S))[i] = 0u;
    if (F.tid < 40) *(u32x4*)(L + RC_CARRY + F.tid * 16) = (u32x4){0u, 0u, 0u, 0u};
    __syncthreads();
    { const float* w0 = F.in[8]; const float* a0 = F.in[10]; const float* k_k = F.in[13]; const float* k_a = F.in[14]; const float* r_k = F.in[15];
      const int arr = F.tid >> 6, ch = h * 64 + (F.tid & 63);
      PRM[F.tid] = (arr < 3) ? mu[arr * 1024 + ch] : (arr == 3) ? w0[ch] : (arr == 4) ? a0[ch] : (arr == 5) ? k_k[ch] : (arr == 6) ? k_a[ch] : r_k[ch]; }
    fetch(0, F.tid); commit(F.tid);
    const int ct = w & 3, th = w >> 2;
    bf16x8 fw[2], fa[2];
    { const bf16_t* W2T = (const bf16_t*)(F.ws + WS_W2T); const bf16_t* A2T = (const bf16_t*)(F.ws + WS_A2T); const int c16 = lane0 & 15, g = lane0 >> 4; const int chr = h * 64 + 16 * ct + c16;
#pragma unroll
      for (int ks = 0; ks < 2; ++ks) { fw[ks] = *(const bf16x8*)(W2T + (size_t)chr * 64 + 32 * ks + 8 * g); fa[ks] = *(const bf16x8*)(A2T + (size_t)chr * 64 + 32 * ks + 8 * g); } }
    __syncthreads();
    const int mytile = (w < 4) ? w : (w - 4);
    if (F.tid < 128) ((float*)(L + RC_MUX))[F.tid] = mu[3072 + F.tid];
    const float lnw = ln_w[h * 64 + lane0], lnb = ln_b[h * 64 + lane0];
    asm volatile("" :: "v"(lnw), "v"(lnb), "v"(fw[0]), "v"(fw[1]), "v"(fa[0]), "v"(fa[1]));
    __syncthreads();
#pragma unroll 1
    for (int c = 0; c < T / 64; ++c) {
        const int sb_cur = (c & 1) * 8192, sb_nxt = 8192 - sb_cur;
        int lane = lane0; asm volatile("" : "+v"(lane));
        const int c16 = lane & 15, g = lane >> 4;
        int tidl = F.tid; asm volatile("" : "+v"(tidl));
        if (c + 1 < T / 64) fetch(c + 1, tidl);
        unsigned short pgr[8];
#pragma unroll
        for (int it = 0; it < 8; ++it) { const size_t row = (size_t)b * T + 64 * c + w * 8 + it; pgr[it] = GRW[row * 1024 + h * 64 + lane]; }
        const f32x4 mxa = *(const f32x4*)(L + RC_MUX + (F.tid & 15) * 32), mxb = *(const f32x4*)(L + RC_MUX + (F.tid & 15) * 32 + 16);
        const float mux[8] = {mxa[0], mxa[1], mxa[2], mxa[3], mxb[0], mxb[1], mxb[2], mxb[3]};
#pragma unroll
        for (int i = 0; i < 2; ++i) { const int idx8 = F.tid + NTHREADS * i, tok = idx8 >> 4, cg = idx8 & 15;
            const u32x4 cu = *(const u32x4*)(L + RC_RAWX + (tok + 1) * 272 + cg * 16), pr = *(const u32x4*)(L + RC_RAWX + tok * 272 + cg * 16); u32x4 o;
#pragma unroll
            for (int e = 0; e < 4; ++e) { const float c0 = lo16(cu[e]), c1 = hi16(cu[e]), p0 = lo16(pr[e]), p1 = hi16(pr[e]);
                float m0 = c0 + (p0 - c0) * mux[2 * e], m1 = c1 + (p1 - c1) * mux[2 * e + 1];
                if (cg < 8) { m0 = fast_tanh(m0); m1 = fast_tanh(m1); }
                o[e] = pk2(m0, m1); }
            *(u32x4*)(L + ((cg < 8) ? (RC_XW + (tok * 72 + cg * 8) * 2) : (RC_XA + (tok * 72 + (cg - 8) * 8) * 2))) = o; }
        {
            const int tok = F.tid >> 3, c8 = F.tid & 7;
            const u32x4 kc = *(const u32x4*)(L + RC_RAWK + (tok + 1) * 144 + c8 * 16), kp = *(const u32x4*)(L + RC_RAWK + tok * 144 + c8 * 16);
            const f32x4 m0 = *(const f32x4*)(PRM + 64 + 8 * c8), m1 = *(const f32x4*)(PRM + 64 + 8 * c8 + 4), q0 = *(const f32x4*)(PRM + 5 * 64 + 8 * c8), q1 = *(const f32x4*)(PRM + 5 * 64 + 8 * c8 + 4);
            float ss = 0.f;
#pragma unroll
            for (int e = 0; e < 4; ++e) { const float c0 = lo16(kc[e]), c1 = hi16(kc[e]), p0 = lo16(kp[e]), p1 = hi16(kp[e]);
                const float mu0 = (e < 2) ? m0[2 * e] : m1[2 * e - 4], mu1 = (e < 2) ? m0[2 * e + 1] : m1[2 * e - 3], kq0 = (e < 2) ? q0[2 * e] : q1[2 * e - 4], kq1 = (e < 2) ? q0[2 * e + 1] : q1[2 * e - 3];
                const float k0 = (c0 + (p0 - c0) * mu0) * kq0, k1 = (c1 + (p1 - c1) * mu1) * kq1; ss += k0 * k0 + k1 * k1; }
            ss += dpp_mov<0xB1>(ss); ss += dpp_mov<0x4E>(ss); ss += dpp_mov<0x141>(ss);
            if (c8 == 0) SSK[tok] = ss; }
        lds_barrier();
        f32x4 axv[2], bxv[2];
        {
            f32x4 inc0 = {0.f, 0.f, 0.f, 0.f}, inc1 = inc0, wl0 = inc0, wl1 = inc0, carry = inc0;
            const float* prm = PRM + 16 * ct + 4 * g;
            const f32x4 w0v = *(const f32x4*)(prm + 3 * 64);
#pragma unroll
            for (int tt = 0; tt < 4; ++tt) {
                f32x4 aw = {0.f, 0.f, 0.f, 0.f};
#pragma unroll
                for (int ks = 0; ks < 2; ++ks) aw = mfma16(fw[ks], *(const bf16x8*)(L + RC_XW + ((16 * tt + c16) * 72 + 32 * ks + 8 * g) * 2), aw);
                f32x4 ic, wv;
#pragma unroll
                for (int e = 0; e < 4; ++e) { const float wpre = w0v[e] + aw[e]; const float wl = -0.6065306597126334f * __builtin_amdgcn_rcpf(1.f + __expf(-wpre));
                    float x = wl; x += row_shr<1>(x); x += row_shr<2>(x); x += row_shr<4>(x); x += row_shr<8>(x);
                    ic[e] = x + carry[e]; carry[e] += row_bcast15(x); wv[e] = wl; }
                if (tt == 2 * th) { inc0 = ic; wl0 = wv; }
                if (tt == 2 * th + 1) { inc1 = ic; wl1 = wv; }
            }
            const f32x4 mur = *(const f32x4*)(prm), muk = *(const f32x4*)(prm + 64), muv = *(const f32x4*)(prm + 128);
            const f32x4 a0v = *(const f32x4*)(prm + 4 * 64), kkw = *(const f32x4*)(prm + 5 * 64), kaw = *(const f32x4*)(prm + 6 * 64), rkw = *(const f32x4*)(prm + 7 * 64);
#pragma unroll
            for (int j = 0; j < 2; ++j) {
                const int tok = 32 * th + 16 * j + c16;
                f32x4 aa = {0.f, 0.f, 0.f, 0.f};
#pragma unroll
                for (int ks = 0; ks < 2; ++ks) aa = mfma16(fa[ks], *(const bf16x8*)(L + RC_XA + (tok * 72 + 32 * ks + 8 * g) * 2), aa);
                const f32x4 inc = (j == 0) ? inc0 : inc1, wl4 = (j == 0) ? wl0 : wl1;
                const int ro = ((tok + 1) * 72 + 16 * ct + 4 * g) * 2;
                const u32x2 kc_ = *(const u32x2*)(L + RC_RAWK + ro), kp_ = *(const u32x2*)(L + RC_RAWK + ro - 144), rc_ = *(const u32x2*)(L + RC_RAWR + ro), rp_ = *(const u32x2*)(L + RC_RAWR + ro - 144),
                            vc_ = *(const u32x2*)(L + RC_RAWV + ro), vp_ = *(const u32x2*)(L + RC_RAWV + ro - 144);
                const f32x4 kc4 = {lo16(kc_.x), hi16(kc_.x), lo16(kc_.y), hi16(kc_.y)}, kp4 = {lo16(kp_.x), hi16(kp_.x), lo16(kp_.y), hi16(kp_.y)};
                const f32x4 rc4 = {lo16(rc_.x), hi16(rc_.x), lo16(rc_.y), hi16(rc_.y)}, rp4 = {lo16(rp_.x), hi16(rp_.x), lo16(rp_.y), hi16(rp_.y)};
                const f32x4 vc4 = {lo16(vc_.x), hi16(vc_.x), lo16(vc_.y), hi16(vc_.y)}, vp4 = {lo16(vp_.x), hi16(vp_.x), lo16(vp_.y), hi16(vp_.y)};
                const f32x4 km = kc4 + (kp4 - kc4) * muk, rm = rc4 + (rp4 - rc4) * mur, vm = vc4 + (vp4 - vc4) * muv; f32x4 kt, rt;
                float bs = 0.f;
                const float inv = __builtin_amdgcn_rsqf(fmaxf(SSK[tok], 1e-24f));
#pragma unroll
                for (int e = 0; e < 4; ++e) {
                    const float ei = __expf(inc[e]), eiv = __builtin_amdgcn_rcpf(ei);
                    const float a = __builtin_amdgcn_rcpf(1.f + __expf(-(a0v[e] + aa[e])));
                    const float kk = km[e] * kkw[e] * inv;
                    axv[j][e] = -kk * (ei * __expf(-wl4[e])); bxv[j][e] = kk * a * eiv;
                    const float kpn = km[e] * (1.f + (a - 1.f) * kaw[e]);
                    bs += rm[e] * kpn * rkw[e];
                    kt[e] = kpn * eiv; rt[e] = rm[e] * ei;
                    if (th == 1 && j == 1 && c16 == 15) GLV[16 * ct + 4 * g + e] = ei;
                }
                bs = swap32_sum(swap16_sum(bs));
                if (g == 0) BSP[ct * 64 + tok] = bs;
                { const int o = (tok * 72 + 16 * ct + 4 * g) * 2;
                  *(s16x4v*)(L + RC_AT + o) = packbf4(axv[j]); *(s16x4v*)(L + RC_BT + o) = packbf4(bxv[j]);
                  *(s16x4v*)(L + RC_KT + o) = packbf4(kt); *(s16x4v*)(L + RC_RT + o) = packbf4(rt); *(s16x4v*)(L + RC_VV + o) = packbf4(vm); }
            }
        }
        lds_barrier();
        if (F.tid < 64) BS[F.tid] = (BSP[F.tid] + BSP[64 + F.tid]) + (BSP[128 + F.tid] + BSP[192 + F.tid]);
        if (F.tid >= 64 && F.tid < 88) { const int i = F.tid - 64, arr = i >> 3, pc = i & 7; *(u32x4*)(L + RC_CARRY + i * 16) = *(const u32x4*)(L + RC_RAWR + arr * 9360 + 64 * 144 + pc * 16); }
        if (F.tid >= 96 && F.tid < 112) { const int pc = F.tid - 96; *(u32x4*)(L + RC_CARRY + 384 + pc * 16) = *(const u32x4*)(L + RC_RAWX + 64 * 272 + pc * 16); }
        f32x4 glv;
#pragma unroll
        for (int cb = 0; cb < 4; ++cb) glv[cb] = GLV[16 * cb + c16];
        f32x4 Nq, NTq;
        {
            auto other_tile = [&](int idx) {
                int sb, tb; bool isbr;
                if (idx < 6) { isbr = false; sb = (int)((0x211000u >> (4 * idx)) & 0xfu); tb = (int)((0x332321u >> (4 * idx)) & 0xfu); }
                else { isbr = true; const int k = idx - 6; sb = (int)((0x3221110000ull >> (4 * k)) & 0xfull); tb = (int)((0x3323213210ull >> (4 * k)) & 0xfull); }
                f32x4 acc = tile_ch64(L + RC_BT, 16 * sb, L + (isbr ? RC_RT : RC_AT), 16 * tb, c16, g);
                if (isbr && sb == tb) {
#pragma unroll
                    for (int e = 0; e < 4; ++e) if (4 * g + e > c16) acc[e] = 0.f;
                }
                *(s16x4v*)(L + (isbr ? RC_MBR : RC_MAB) + (sb * 4 + tb) * 512 + lane * 8) = packbf4(acc);
            };
            if (w < 4) {
                Nq = tile_ch64(L + RC_BT, 16 * w, L + RC_AT, 16 * w, c16, g);
                NTq = tile_ch64(L + RC_AT, 16 * w, L + RC_BT, 16 * w, c16, g);
#pragma unroll
                for (int e = 0; e < 4; ++e) { if (4 * g + e >= c16) Nq[e] = 0.f; if (c16 >= 4 * g + e) NTq[e] = 0.f; }
#pragma unroll
                for (int k = 0; k < 4; ++k) other_tile(4 * w + k);
            }
        }
        f32x4 maktT[4], mkr[4];
        if (w < 4) {
            const f32x4 zero = {0.f, 0.f, 0.f, 0.f};
            f32x4 Id;
#pragma unroll
            for (int e = 0; e < 4; ++e) Id[e] = (4 * g + e == c16) ? 1.f : 0.f;
            const s16x4v nb = packbf4(Nq), ntb = packbf4(NTq);
            const f32x4 N2 = mfma16k(ntb, nb, zero), N2T = mfma16k(nb, ntb, zero);
            const s16x4v n2b = packbf4(N2), n2tb = packbf4(N2T);
            const f32x4 N4 = mfma16k(n2tb, n2b, zero), N4T = mfma16k(n2b, n2tb, zero);
            const s16x4v n4b = packbf4(N4), n4tb = packbf4(N4T);
            const s16x4v n8b = packbf4(mfma16k(n4tb, n4b, zero));
            const f32x4 T1 = Id + Nq, T1T = Id + NTq; const s16x4v t1tb = packbf4(T1T);
            const f32x4 T2 = mfma16k(t1tb, n2b, T1), T2T = mfma16k(n2b, t1tb, T1T); const s16x4v t2tb = packbf4(T2T);
            const f32x4 T3 = mfma16k(t2tb, n4b, T2), T3T = mfma16k(n4b, t2tb, T2T);
            const f32x4 T4 = mfma16k(packbf4(T3T), n8b, T3);
            *(s16x4v*)(L + RC_T + w * 512 + lane * 8) = packbf4(T4);
#pragma unroll
            for (int q = 0; q < 4; ++q) { maktT[q] = zero; mkr[q] = zero; }
        } else {
            const int st = w - 4;
#pragma unroll
            for (int tb = 0; tb < 4; ++tb) {
                f32x4 a1 = {0.f, 0.f, 0.f, 0.f}, a2 = a1;
                if (tb >= st) {
                    a1 = tile_ch64(L + RC_AT, 16 * tb, L + RC_KT, 16 * st, c16, g);
                    a2 = tile_ch64(L + RC_KT, 16 * st, L + RC_RT, 16 * tb, c16, g);
                    if (tb == st) {
#pragma unroll
                        for (int e = 0; e < 4; ++e) { if (c16 >= 4 * g + e) a1[e] = 0.f; if (4 * g + e > c16) a2[e] = 0.f; }
                    }
                }
                maktT[tb] = a1; mkr[tb] = a2;
            }
        }
        lds_barrier();
        s16x4v xb[4];
        {
            s16x4v mabi[6], ti[4], yi[4];
            mabi[0] = *(const s16x4v*)(L + RC_MAB + (0 * 4 + 1) * 512 + lane * 8); mabi[1] = *(const s16x4v*)(L + RC_MAB + (0 * 4 + 2) * 512 + lane * 8); mabi[2] = *(const s16x4v*)(L + RC_MAB + (1 * 4 + 2) * 512 + lane * 8);
            mabi[3] = *(const s16x4v*)(L + RC_MAB + (0 * 4 + 3) * 512 + lane * 8); mabi[4] = *(const s16x4v*)(L + RC_MAB + (1 * 4 + 3) * 512 + lane * 8); mabi[5] = *(const s16x4v*)(L + RC_MAB + (2 * 4 + 3) * 512 + lane * 8);
#pragma unroll
            for (int q = 0; q < 4; ++q) { ti[q] = *(const s16x4v*)(L + RC_T + q * 512 + lane * 8);
                if (w < 4) yi[q] = trread(L3 + RC_AT + (16 * q + 4 * g + ((lane >> 2) & 3)) * 144 + (16 * w) * 2 + 8 * (lane & 3)); }
            __builtin_amdgcn_sched_barrier(0);
#pragma unroll
            for (int q = 0; q < 4; ++q) {
                f32x4 y = (w < 4) ? unpackbf4(yi[q]) : maktT[q];
#pragma unroll
                for (int p = 0; p < 4; ++p) if (p < q) y = mfma16k(mabi[(q == 1) ? 0 : (q == 2) ? (1 + p) : (3 + p)], xb[p], y);
                const f32x4 xq = mfma16k(ti[q], packbf4(y), (f32x4){0.f, 0.f, 0.f, 0.f});
                xb[q] = packbf4(xq);
            }
        }
        {
            s16x4v mbri[10]; u32x2 rvi[4];
#pragma unroll
            for (int tb = 0; tb < 4; ++tb) {
#pragma unroll
                for (int sb = 0; sb < 4; ++sb) if (sb <= tb) mbri[tb * (tb + 1) / 2 + sb] = *(const s16x4v*)(L + RC_MBR + (sb * 4 + tb) * 512 + lane * 8);
                if (w < 4) rvi[tb] = *(const u32x2*)(L + RC_RT + (16 * tb + c16) * 144 + (16 * w + 4 * g) * 2); }
            __builtin_amdgcn_sched_barrier(0);
#pragma unroll
            for (int tb = 0; tb < 4; ++tb) {
                f32x4 acc;
                if (w < 4) acc = (f32x4){lo16(rvi[tb].x), hi16(rvi[tb].x), lo16(rvi[tb].y), hi16(rvi[tb].y)};
                else acc = mkr[tb];
#pragma unroll
                for (int sb = 0; sb < 4; ++sb) if (sb <= tb) acc = mfma16k(xb[sb], mbri[tb * (tb + 1) / 2 + sb], acc);
                *(s16x4v*)(L + ((w < 4) ? RC_GY : RC_HY) + (mytile * 4 + tb) * 512 + lane * 8) = packbf4(acc);
            }
        }
#pragma unroll
        for (int ch2 = 0; ch2 < 2; ++ch2) {
            s16x4v bti[8], kti[2];
#pragma unroll
            for (int c1 = 0; c1 < 2; ++c1) { const int cb = 2 * ch2 + c1;
#pragma unroll
                for (int tb = 0; tb < 4; ++tb) bti[c1 * 4 + tb] = trread(L3 + RC_BT + (16 * tb + 4 * g + ((lane >> 2) & 3)) * 144 + (16 * cb) * 2 + 8 * (lane & 3));
                if (w >= 4) kti[c1] = trread(L3 + RC_KT + (16 * (w - 4) + 4 * g + ((lane >> 2) & 3)) * 144 + (16 * cb) * 2 + 8 * (lane & 3)); }
            __builtin_amdgcn_sched_barrier(0);
#pragma unroll
            for (int c1 = 0; c1 < 2; ++c1) { const int cb = 2 * ch2 + c1;
                f32x4 acc = {0.f, 0.f, 0.f, 0.f};
#pragma unroll
                for (int tb = 0; tb < 4; ++tb) acc = mfma16k(xb[tb], bti[c1 * 4 + tb], acc);
                if (w < 4) {
#pragma unroll
                    for (int e = 0; e < 4; ++e) if (16 * w + 4 * g + e == 16 * cb + c16) acc[e] += 1.f;
                } else acc += unpackbf4(kti[c1]);
                acc = acc * glv[cb];
                *(s16x4v*)(L + ((w < 4) ? RC_GS : RC_HS) + (mytile * 4 + cb) * 512 + lane * 8) = packbf4(acc);
            }
            __builtin_amdgcn_sched_barrier(0);
        }
        lds_barrier();
        {
            const int ib = w & 3, hf = w >> 2;
            s16x4v simg[4], vtr[4];
#pragma unroll
            for (int k = 0; k < 4; ++k) { simg[k] = *(const s16x4v*)(L + RC_S + sb_cur + (k * 4 + ib) * 512 + lane * 8);
                vtr[k] = trread(L3 + RC_VV + (16 * k + 4 * g + ((lane >> 2) & 3)) * 144 + (16 * ib) * 2 + 8 * (lane & 3)); }
#pragma unroll
            for (int j = 0; j < 2; ++j) {
                const int tb = 2 * hf + j, cb = 2 * hf + j;
                f32x4 y = {0.f, 0.f, 0.f, 0.f}, sn = y;
                { s16x4v gyi[4], hyi[4];
#pragma unroll
                  for (int k = 0; k < 4; ++k) { gyi[k] = *(const s16x4v*)(L + RC_GY + (k * 4 + tb) * 512 + lane * 8); hyi[k] = *(const s16x4v*)(L + RC_HY + (k * 4 + tb) * 512 + lane * 8); }
                  __builtin_amdgcn_sched_barrier(0);
#pragma unroll
                  for (int k = 0; k < 4; ++k) y = mfma16k(simg[k], gyi[k], y);
#pragma unroll
                  for (int k = 0; k < 4; ++k) if (k <= tb) y = mfma16k(vtr[k], hyi[k], y); }
                { s16x4v gsi[4], hsi[4];
#pragma unroll
                  for (int k = 0; k < 4; ++k) { gsi[k] = *(const s16x4v*)(L + RC_GS + (k * 4 + cb) * 512 + lane * 8); hsi[k] = *(const s16x4v*)(L + RC_HS + (k * 4 + cb) * 512 + lane * 8); }
                  __builtin_amdgcn_sched_barrier(0);
#pragma unroll
                  for (int k = 0; k < 4; ++k) sn = mfma16k(gsi[k], simg[k], sn);
#pragma unroll
                  for (int k = 0; k < 4; ++k) sn = mfma16k(hsi[k], vtr[k], sn); }
                *(f32x4*)(L + RC_YO + ((16 * tb + c16) * 68 + 16 * ib + 4 * g) * 4) = y;
                *(s16x4v*)(L + RC_S + sb_nxt + (cb * 4 + ib) * 512 + lane * 8) = packbf4(sn);
            }
        }
        lds_barrier();
        if (c + 1 < T / 64) commit(tidl);
        {
            float yv[8], mean[8], var[8];
#pragma unroll
            for (int it = 0; it < 8; ++it) yv[it] = *(const float*)(L + RC_YO + ((w * 8 + it) * 68 + lane) * 4);
#pragma unroll
            for (int it = 0; it < 8; ++it) mean[it] = wave_sum_dpp(yv[it]) * (1.f / 64.f);
#pragma unroll
            for (int it = 0; it < 8; ++it) { yv[it] -= mean[it]; var[it] = wave_sum_dpp(yv[it] * yv[it]) * (1.f / 64.f); }
            const float lw = lnw, lb = lnb;
#pragma unroll
            for (int it = 0; it < 8; ++it) { const size_t row = (size_t)b * T + 64 * c + w * 8 + it;
                const float yn = yv[it] * rsqrtf(var[it] + GN_EPS) * lw + lb;
                const int tk = w * 8 + it; const float vv = bf2f(*(const bf16_t*)(L + RC_VV + (tk * 72 + lane) * 2));
                OA[row * 2048 + h * 64 + lane] = (bf16_t)f2bf((yn + BS[tk] * vv) * bf2f(pgr[it])); }
        }
        lds_barrier();
    }
}

DI int crow(int reg, int hh) { return (reg & 3) + 8 * (reg >> 2) + 4 * hh; }
constexpr int NSA_KB = 0, NSA_VB = 18432, NSA_PSUM = 36864, NSA_IMP = 70656, NSA_SEL = 79360, NSA_UNI = 79616, NSA_ITEM = 79620, NSA_BT = 79872, NSA_Q = 90112;
constexpr float NEGBIG = -1e30f;
constexpr int NSA_EXT = 122880, EXT_STRIDE = 1040, NSA_WED = NSA_EXT + 16 * EXT_STRIDE, WED_STRIDE = 784, NSA_END = NSA_WED + 4 * WED_STRIDE;
static_assert(NSA_END <= LDS_BYTES - 16, "NSA tables overflow the LDS");
DI void add_ext(f32x16& s0, f32x16& s1, const unsigned char* tp) {
    f32x4 a[4], b[4];
#pragma unroll
    for (int q = 0; q < 4; ++q) { a[q] = *(const f32x4*)(tp + 32 * q); b[q] = *(const f32x4*)(tp + 128 + 32 * q); }
#pragma unroll
    for (int q = 0; q < 4; ++q)
#pragma unroll
        for (int e = 0; e < 4; ++e) { float x = s0[4 * q + e], y = s1[4 * q + e];
            asm("v_add_f32 %0, %0, %1" : "+v"(x) : "v"(a[q][e])); asm("v_add_f32 %0, %0, %1" : "+v"(y) : "v"(b[q][e]));
            s0[4 * q + e] = x; s1[4 * q + e] = y; }
}
struct TileRegs { u32x4 k, v; };
DI void tile_fetch(TileRegs& r, const bf16_t* Kp, size_t kstride, const bf16_t* Vp, size_t vstride, int tid) {
    const int row = tid >> 3, ch = tid & 7;
    r.k = *(const u32x4*)(Kp + (size_t)row * kstride + ch * 8);
    r.v = *(const u32x4*)(Vp + (size_t)row * vstride + ch * 8);
}
DI void tile_commit(const TileRegs& r, unsigned char* lds, int buf, int tid) {
    const int row = tid >> 3, ch = tid & 7;
    *(u32x4*)(lds + NSA_KB + buf * 9216 + row * 144 + ch * 16) = r.k;
    unsigned char* vp = lds + NSA_VB + buf * 8704 + row * 136 + ch * 16;
    *(u32x2*)vp = (u32x2){r.v.x, r.v.y}; *(u32x2*)(vp + 8) = (u32x2){r.v.z, r.v.w};
}
DI void tile_scores_q(f32x16& s0, f32x16& s1, const unsigned char* lds, int buf, const bf16x8 (&qf)[4], int r, int hh) {
    const unsigned char* kb = lds + NSA_KB + buf * 9216 + r * 144 + hh * 16;
    s0 = (f32x16){0.f, 0.f, 0.f, 0.f, 0.f, 0.f, 0.f, 0.f, 0.f, 0.f, 0.f, 0.f, 0.f, 0.f, 0.f, 0.f}; s1 = s0;
#pragma unroll
    for (int d0 = 0; d0 < 4; ++d0) {
        const bf16x8 k0 = *(const bf16x8*)(kb + d0 * 32), k1 = *(const bf16x8*)(kb + 32 * 144 + d0 * 32);
        s0 = mfma32(k0, qf[d0], s0); s1 = mfma32(k1, qf[d0], s1);
    }
}
DI void tile_scores(f32x16& s0, f32x16& s1, const unsigned char* lds, int buf, const unsigned char* qb, int r, int hh, const unsigned char* row = nullptr) {
    const unsigned char* kb = lds + NSA_KB + buf * 9216 + r * 144 + hh * 16;
    if (row) {
#pragma unroll
        for (int q = 0; q < 4; ++q) { const f32x4 a = *(const f32x4*)(row + 32 * q), b = *(const f32x4*)(row + 128 + 32 * q);
#pragma unroll
            for (int e = 0; e < 4; ++e) { s0[4 * q + e] = a[e]; s1[4 * q + e] = b[e]; } }
    } else { s0 = (f32x16){0.f, 0.f, 0.f, 0.f, 0.f, 0.f, 0.f, 0.f, 0.f, 0.f, 0.f, 0.f, 0.f, 0.f, 0.f, 0.f}; s1 = s0; }
#pragma unroll
    for (int d0 = 0; d0 < 4; ++d0) {
        const bf16x8 k0 = *(const bf16x8*)(kb + d0 * 32), k1 = *(const bf16x8*)(kb + 32 * 144 + d0 * 32);
        const bf16x8 qf = *(const bf16x8*)(qb + d0 * 8192);
        s0 = mfma32(k0, qf, s0); s1 = mfma32(k1, qf, s1);
    }
}
DI bf16x8 pack8(const f32x16& p, int s2) { u32x4 w; w.x = pk2(p[8 * s2], p[8 * s2 + 1]); w.y = pk2(p[8 * s2 + 2], p[8 * s2 + 3]); w.z = pk2(p[8 * s2 + 4], p[8 * s2 + 5]); w.w = pk2(p[8 * s2 + 6], p[8 * s2 + 7]); return __builtin_bit_cast(bf16x8, w); }
DI void tile_pv(f32x16 (&o)[2], const f32x16& p0, const f32x16& p1, const unsigned char* lds, int buf, int r, int hh) {
    const unsigned char* vb = lds + NSA_VB + buf * 8704;
#pragma unroll
    for (int half = 0; half < 2; ++half)
#pragma unroll
        for (int s2 = 0; s2 < 2; ++s2) {
            const bf16x8 pf = pack8(half ? p1 : p0, s2);
#pragma unroll
            for (int dh = 0; dh < 2; ++dh) { const unsigned char* vp = vb + (32 * dh + r) * 136 + (32 * half + 16 * s2 + 4 * hh) * 2;
                const u32x2 lo = *(const u32x2*)vp, hi = *(const u32x2*)(vp + 16); u32x4 vw = {lo.x, lo.y, hi.x, hi.y};
                o[dh] = mfma32(__builtin_bit_cast(bf16x8, vw), pf, o[dh]); }
        }
}
constexpr float MINIT = -1e20f;
DI float max3f(float a, float b, float c) { float r; asm("v_max3_f32 %0, %1, %2, %3" : "=v"(r) : "v"(a), "v"(b), "v"(c)); return r; }
DI void online_update(f32x16& s0, f32x16& s1, float& mrun, float& lrun, f32x16 (&o)[2], bool live = true) {
    float mt = max3f(s0[0], s1[0], s0[1]);
#pragma unroll
    for (int i = 2; i < 16; i += 2) mt = max3f(mt, s0[i], s0[i + 1]);
#pragma unroll
    for (int i = 1; i < 15; i += 2) mt = max3f(mt, s1[i], s1[i + 1]);
    mt = max3f(mt, s1[15], s1[15]);
    mt = live ? mt : NEGBIG;
    mt = swap32_max(mt);
    if (__any(mt > mrun)) {
        const float mnew = fmaxf(mrun, mt); const float alpha = __builtin_amdgcn_exp2f(mrun - mnew);
        lrun *= alpha; mrun = mnew;
#pragma unroll
        for (int i = 0; i < 16; ++i) { o[0][i] *= alpha; o[1][i] *= alpha; }
    }
    float ps0 = 0.f, ps1 = 0.f; const float msub = live ? mrun : 1e30f;
#pragma unroll
    for (int i = 0; i < 16; ++i) { s0[i] = __builtin_amdgcn_exp2f(s0[i] - msub); s1[i] = __builtin_amdgcn_exp2f(s1[i] - msub); ps0 += s0[i]; ps1 += s1[i]; }
    lrun += swap32_sum(ps0 + ps1);
}

template <int VAR> DI void nsa_worker(Frame& F) {
    unsigned char* lds = F.lds;
    float* PSUM = (float*)(lds + NSA_PSUM); float* IMP = (float*)(lds + NSA_IMP); unsigned* SEL = (unsigned*)(lds + NSA_SEL); unsigned* UNI = (unsigned*)(lds + NSA_UNI);
    int* ITEM = (int*)(lds + NSA_ITEM); float* BT = (float*)(lds + NSA_BT);
    const bf16_t* PQ = (const bf16_t*)(F.ws + WS_PQ); const bf16_t* PKV = (const bf16_t*)(F.ws + WS_PKV);
    const bf16_t* KC = (const bf16_t*)(F.ws + WS_KC); const bf16_t* VCT = (const bf16_t*)(F.ws + WS_VCT);
    const bf16_t* VST = (const bf16_t*)(F.ws + WS_VST); const bf16_t* VWT = (const bf16_t*)(F.ws + WS_VWT);
    const float* GATES = (const float*)(F.ws + WS_GATES); bf16_t* OB = (bf16_t*)((char*)F.out + DO_OAB) + 1024;
    unsigned* ctr = (unsigned*)(F.ws + WS_CTL) + 64;
    { int t0_ = (int)threadIdx.x; asm volatile("" : "+v"(t0_));
      for (int i = t0_; i < 2048; i += NTHREADS) BT[i] = ((const float*)(F.ws + WS_BIAS))[i] * LOG2E;
      for (int i = t0_; i < 4 * 196; i += NTHREADS) { const int sft = i / 196, w = i - sft * 196; ((float*)(lds + NSA_WED + sft * WED_STRIDE))[w] = (w + sft > 63) ? 0.f : NEGBIG; } }
    int g_tab = -1;
    const int hg = F.wave >> 1, th = F.wave & 1;
    const int myx = (int)((unsigned)__builtin_amdgcn_s_getreg((3 << 11) | 20) & 7u); int qsel = 0;
    for (;;) {
        lds_barrier();
        if (((int)threadIdx.x) == 0) { int it = -1;
            while (qsel < 8) { const int qx = (myx + qsel) & 7; const unsigned v = atomicAdd(ctr + 16 * qx, 1u); if (v < 128u) { it = (int)v * 8 + qx; break; } ++qsel; }
            *ITEM = it; }
        lds_barrier();
        const int item0 = *ITEM; if (item0 < 0) break;
        const int item = ((item0 >> 3) << 3) | (item0 & 7);
        int tidl = threadIdx.x; asm volatile("" : "+v"(tidl));
        const int r = tidl & 31, hh = (tidl >> 5) & 1, tl = 32 * th + r;
        const int qidx = item >> 3, qx_ = item & 7; const int qt = 31 - (qidx >> 2), bg = 8 * (qidx & 3) + qx_, b = bg >> 2, g = bg & 3, t0 = 64 * qt, cur = qt;
        const int hq = 4 * g + hg, t = t0 + tl; const size_t row = (size_t)b * T + t;
        const unsigned char* qr = lds + NSA_Q + tidl * 16;
#pragma unroll
        for (int d0 = 0; d0 < 4; ++d0) *(bf16x8*)(lds + NSA_Q + d0 * 8192 + tidl * 16) = *(const bf16x8*)(PQ + row * 1024 + hq * 64 + 16 * d0 + 8 * hh);
        const float gate_c = GATES[row * 48 + hq * 3], gate_s = GATES[row * 48 + hq * 3 + 1], gate_w = GATES[row * 48 + hq * 3 + 2];
        const float* bt = BT + hq * 128;
        if (g != g_tab) { g_tab = g;
#pragma unroll
            for (int k = 0; k < 8; ++k) { const int c = (tidl >> 8) + 2 * k, w = tidl & 255, rel = 191 - (w + (c & 3));
                ((float*)(lds + NSA_EXT + c * EXT_STRIDE))[w] = (rel < 0) ? NEGBIG : BT[(4 * g + (c >> 2)) * 128 + min(rel, 127)]; } }
        const int yb0 = 191 - tl + 4 * hh;
        const unsigned char* tp0 = lds + NSA_EXT + (hg * 4 + (yb0 & 3)) * EXT_STRIDE + (yb0 & ~3) * 4;
        const unsigned char* tpw = lds + NSA_WED + (yb0 & 3) * WED_STRIDE + ((yb0 - 128) & ~3) * 4;
        f32x16 oacc[2];
#pragma unroll
        for (int i = 0; i < 16; ++i) { oacc[0][i] = 0.f; oacc[1][i] = 0.f; }
        TileRegs tr;
        {
            const bf16_t* Kp = KC + ((size_t)b * 128 * 4 + g) * 64; const bf16_t* Vp = VCT + (size_t)(b * 4 + g) * 64 * 128;
            tile_fetch(tr, Kp, 256, Vp, 128, tidl); tile_commit(tr, lds, 0, tidl);
            tile_fetch(tr, Kp + (size_t)64 * 256, 256, Vp + 64, 128, tidl); tile_commit(tr, lds, 1, tidl);
            lds_barrier();
            tile_fetch(tr, PKV + (size_t)b * T * 1536 + 2 * 256 + g * 64, 1536, VST + (size_t)(b * 4 + g) * 64 * 2048, 2048, tidl);
            f32x16 sc[2][2];
            tile_scores(sc[0][0], sc[0][1], lds, 0, qr, r, hh); __builtin_amdgcn_sched_barrier(0); tile_scores(sc[1][0], sc[1][1], lds, 1, qr, r, hh); __builtin_amdgcn_sched_barrier(0);
            const int nmax = (t >= 31) ? ((t - 31) >> 4) : -1;
            float mx = NEGBIG;
            const int tmin_w = t0 + 32 * th;
#define CMP_MASK(S_, NB_) do { \
                if (16 * (NB_) + 31 > tmin_w + 31) { _Pragma("unroll") for (int i = 0; i < 16; ++i) S_[i] = NEGBIG; }                                     \
                else if (16 * ((NB_) + 31) + 31 + 128 <= tmin_w) { _Pragma("unroll") for (int i = 0; i < 16; ++i) mx = fmaxf(mx, S_[i]); }               \
                else { _Pragma("unroll") for (int i = 0; i < 16; ++i) { const int n = (NB_) + crow(i, hh); const int rel = t - 16 * n - 31; float s = S_[i]; \
                    const float bv = bt[min(max(rel, 0), 127)]; if (n <= nmax) { s += bv; mx = fmaxf(mx, s); } else s = NEGBIG; S_[i] = s; } } \
                __builtin_amdgcn_sched_barrier(0); } while (0)
            CMP_MASK(sc[0][0], 0); CMP_MASK(sc[0][1], 32); CMP_MASK(sc[1][0], 64); CMP_MASK(sc[1][1], 96);
#undef CMP_MASK
            mx = swap32_max(mx);
            float ps = 0.f;
#pragma unroll
            for (int kt = 0; kt < 2; ++kt)
#pragma unroll
                for (int half = 0; half < 2; ++half)
#pragma unroll
                    for (int i = 0; i < 16; ++i) { const float s = sc[kt][half][i]; const float p = (s > -1e29f) ? __builtin_amdgcn_exp2f(s - mx) : 0.f; sc[kt][half][i] = p; ps += p; }
            ps = swap32_sum(ps);
            const float inv = (ps > 0.f) ? 1.f / ps : 0.f;
#pragma unroll
            for (int kt = 0; kt < 2; ++kt)
#pragma unroll
                for (int half = 0; half < 2; ++half)
#pragma unroll
                    for (int i = 0; i < 16; ++i) sc[kt][half][i] *= inv;
            if (cur >= 8) {
                if (hg == 0) {
#pragma unroll
                    for (int kt = 0; kt < 2; ++kt)
#pragma unroll
                        for (int half = 0; half < 2; ++half) { float* pb = PSUM + tl * 132 + 64 * kt + 32 * half + 4 * hh;
#pragma unroll
                            for (int q = 0; q < 4; ++q) *(f32x4*)(pb + 8 * q) = (f32x4){sc[kt][half][4 * q], sc[kt][half][4 * q + 1], sc[kt][half][4 * q + 2], sc[kt][half][4 * q + 3]}; }
                }
                lds_barrier();
#pragma unroll 1
                for (int hgi = 1; hgi < 4; ++hgi) {
                    if (hg == hgi) {
#pragma unroll
                        for (int kt = 0; kt < 2; ++kt)
#pragma unroll
                            for (int half = 0; half < 2; ++half) { float* pb = PSUM + tl * 132 + 64 * kt + 32 * half + 4 * hh; f32x4 old[4];
#pragma unroll
                                for (int q = 0; q < 4; ++q) old[q] = *(const f32x4*)(pb + 8 * q);
#pragma unroll
                                for (int q = 0; q < 4; ++q) *(f32x4*)(pb + 8 * q) = old[q] + (f32x4){sc[kt][half][4 * q], sc[kt][half][4 * q + 1], sc[kt][half][4 * q + 2], sc[kt][half][4 * q + 3]}; }
                    }
                    lds_barrier();
                }
            }
#pragma unroll
            for (int kt = 0; kt < 2; ++kt)
#pragma unroll
                for (int half = 0; half < 2; ++half)
#pragma unroll
                    for (int i = 0; i < 16; ++i) sc[kt][half][i] *= gate_c;
            tile_pv(oacc, sc[0][0], sc[0][1], lds, 0, r, hh); __builtin_amdgcn_sched_barrier(0); tile_pv(oacc, sc[1][0], sc[1][1], lds, 1, r, hh); __builtin_amdgcn_sched_barrier(0);
            if (cur >= 8) {
#pragma unroll
                for (int i = 0; i < 4; ++i) { const int tok = tidl >> 3, j = (tidl & 7) + 8 * i; const float* pp = PSUM + tok * 132 + 4 * j;
                    float v = pp[0] + pp[1] + pp[2] + 0.5f * pp[3]; if (j > 0) v += 0.5f * pp[-1];
                    IMP[tok * 33 + j] = v; }
                lds_barrier();
                if (F.wave == 0) {
                    const int tok = tidl & 63; float scv[32];
#pragma unroll
                    for (int j = 0; j < 32; ++j) { const bool forced = (j == 0) || (j == cur) || (j == cur - 1); scv[j] = forced ? 1e4f : ((j <= cur) ? IMP[tok * 33 + j] : -1.f); }
                    unsigned msk = 1u | (1u << cur) | (1u << (cur - 1));
#pragma unroll 1
                    for (int k = 0; k < 5; ++k) { float best = -3e38f; int bi = 0;
#pragma unroll
                        for (int j = 0; j < 32; ++j) { const bool tk = ((msk >> j) & 1u) == 0u && scv[j] > best; best = tk ? scv[j] : best; bi = tk ? j : bi; }
                        msk |= 1u << bi; }
                    msk &= (cur >= 31) ? 0xffffffffu : ((1u << (cur + 1)) - 1u);
                    SEL[tok] = msk;
                    unsigned um = msk;
#pragma unroll
                    for (int o = 1; o < 64; o <<= 1) um |= (unsigned)__shfl_xor((int)um, o);
                    if ((tidl & 63) == 0) *UNI = um;
                }
            } else {
                if (tidl < 64) SEL[tidl] = (1u << (cur + 1)) - 1u;
                if (tidl == 0) *UNI = (1u << (cur + 1)) - 1u;
            }
            lds_barrier();
        }
        bf16x8 qreg[4];
#pragma unroll
        for (int d0 = 0; d0 < 4; ++d0) qreg[d0] = *(const bf16x8*)(qr + d0 * 8192);
        {
            const unsigned uni = *UNI, mysel = SEL[tl];
            const bf16_t* Kb = PKV + (size_t)b * T * 1536 + 2 * 256 + g * 64; const bf16_t* Vb = VST + (size_t)(b * 4 + g) * 64 * 2048;
            float mrun = MINIT, lrun = 0.f; f32x16 o[2];
#pragma unroll
            for (int i = 0; i < 16; ++i) { o[0][i] = 0.f; o[1][i] = 0.f; }
            unsigned rem = uni; int j = 0; rem &= rem - 1u; int buf = 0;
            const bf16_t* Kbw = PKV + (size_t)b * T * 1536 + 4 * 256 + g * 64; const bf16_t* Vbw = VWT + (size_t)(b * 4 + g) * 64 * 2048; const int jw0 = (cur >= 8) ? cur - 8 : 0;
            for (;;) {
                tile_commit(tr, lds, buf, tidl);
                lds_barrier();
                const int jn = rem ? __builtin_ctz(rem) : -1; rem &= rem - 1u;
                if (jn >= 0) tile_fetch(tr, Kb + (size_t)64 * jn * 1536, 1536, Vb + 64 * jn, 2048, tidl);
                else tile_fetch(tr, Kbw + (size_t)64 * jw0 * 1536, 1536, Vbw + 64 * jw0, 2048, tidl);
                f32x16 s0, s1;
                const bool selb = (mysel >> j) & 1u;
                if (VAR <= 1) tile_scores_q(s0, s1, lds, buf, qreg, r, hh); else { s0 = o[0]; s1 = o[1]; }
                if (VAR == 0 && j >= cur - 2) add_ext(s0, s1, tp0 - 256 * (cur - j));
                if (VAR == 0) online_update(s0, s1, mrun, lrun, o, selb);
                if (VAR <= 1) tile_pv(o, s0, s1, lds, buf, r, hh);
                if (jn < 0) break;
                j = jn; buf ^= 1;
            }
            const float sc_ = gate_s / lrun;
#pragma unroll
            for (int i = 0; i < 16; ++i) { oacc[0][i] += sc_ * o[0][i]; oacc[1][i] += sc_ * o[1][i]; }
            lds_barrier();
        }
        {
            const bf16_t* Kb = PKV + (size_t)b * T * 1536 + 4 * 256 + g * 64; const bf16_t* Vb = VWT + (size_t)(b * 4 + g) * 64 * 2048;
            float mrun = MINIT, lrun = 0.f; f32x16 o[2];
#pragma unroll
            for (int i = 0; i < 16; ++i) { o[0][i] = 0.f; o[1][i] = 0.f; }
            int j = (cur >= 8) ? cur - 8 : 0, buf = 0;
            for (;;) {
                tile_commit(tr, lds, buf, tidl);
                lds_barrier();
                const int jn = (j < cur) ? j + 1 : -1;
                if (jn >= 0) tile_fetch(tr, Kb + (size_t)64 * jn * 1536, 1536, Vb + 64 * jn, 2048, tidl);
                f32x16 s0, s1;
                if (VAR <= 1) tile_scores_q(s0, s1, lds, buf, qreg, r, hh); else { s0 = o[0]; s1 = o[1]; }
                if (VAR == 0 && (j >= cur - 2 || j == cur - 8)) add_ext(s0, s1, (j >= cur - 2) ? tp0 - 256 * (cur - j) : tpw);
                if (VAR == 0) online_update(s0, s1, mrun, lrun, o);
                if (VAR <= 1) tile_pv(o, s0, s1, lds, buf, r, hh);
                if (jn < 0) break;
                j = jn; buf ^= 1;
            }
            const float sc_ = gate_w / lrun;
#pragma unroll
            for (int i = 0; i < 16; ++i) { oacc[0][i] += sc_ * o[0][i]; oacc[1][i] += sc_ * o[1][i]; }
        }
        bf16_t* op = OB + row * 2048 + hq * 64;
        if (VAR != 0) { if (oacc[0][0] + oacc[1][5] == 123.456f) op[0] = 0; continue; }
#pragma unroll
        for (int dh = 0; dh < 2; ++dh)
#pragma unroll
            for (int gq = 0; gq < 4; ++gq) { u32x2 w; w.x = pk2(oacc[dh][4 * gq], oacc[dh][4 * gq + 1]); w.y = pk2(oacc[dh][4 * gq + 2], oacc[dh][4 * gq + 3]);
                *(u32x2*)(op + 32 * dh + 8 * gq + 4 * hh) = w; }
    }
}


#define XB_TMO      128
#define XB_XCNT(j)  (256  + 64 * (j))
#define XB_XSUB(j)  (1280 + 64 * (j))
#define XB_XGEN(j)  (2304 + 64 * (j))
#define XB_TOP      3328
#define XB_TOPGEN   3392
#define XCD_BAR_WORDS 3456
#define XB_SPIN_CAP (1u << 22)
DI unsigned xb_ld(unsigned* p)              { return __hip_atomic_load(p, __ATOMIC_RELAXED, __HIP_MEMORY_SCOPE_AGENT); }
DI unsigned xb_add(unsigned* p, unsigned v) { return __hip_atomic_fetch_add(p, v, __ATOMIC_RELAXED, __HIP_MEMORY_SCOPE_AGENT); }
DI unsigned xb_xcc_id() { return (unsigned)__builtin_amdgcn_s_getreg((3 << 11) | 20) & 0xFu; }
#define XB_SPIN(cond, bar) do { unsigned _sp = 0; while (cond) { __builtin_amdgcn_s_sleep(1); \
    if ((++_sp & 255u) == 0u) { if (xb_ld(&(bar)[XB_TMO])) break; if (_sp > XB_SPIN_CAP) { atomicAdd(&(bar)[XB_TMO], 1u); break; } } } } while (0)
struct XcdBarrier { unsigned* bar; unsigned x; volatile LAS unsigned* st; };
DI XcdBarrier xcd_barrier_post(unsigned* bar, volatile LAS unsigned* st) {
    XcdBarrier b; b.bar = bar; b.x = xb_xcc_id(); b.st = st;
    if (threadIdx.x == 0) (void)xb_add(&bar[XB_XCNT(b.x)], 1u);
    return b;
}
DI void xcd_barrier_complete(unsigned* bar, unsigned x, unsigned& nloc, unsigned& nx) {
    const unsigned G = gridDim.x * gridDim.y * gridDim.z;
    unsigned sum, cnt, mine, sp = 0u;
    for (;;) {
        sum = 0u; cnt = 0u; mine = 0u;
#pragma unroll
        for (unsigned j = 0; j < 16; ++j) { const unsigned c = xb_ld(&bar[XB_XCNT(j)]); sum += c; cnt += (c > 0u) ? 1u : 0u; mine = (j == x) ? c : mine; }
        if (sum == G) break;
        __builtin_amdgcn_s_sleep(1);
        if ((++sp & 255u) == 0u) { if (xb_ld(&bar[XB_TMO])) break; if (sp > XB_SPIN_CAP) { atomicAdd(&bar[XB_TMO], 1u); break; } }
    }
    nloc = mine > 0u ? mine : 1u; nx = cnt > 0u ? cnt : 1u;
}
DI void xcd_barrier(const XcdBarrier& b) {
    asm volatile("s_waitcnt vmcnt(0)" ::: "memory");
    __syncthreads();
    if (threadIdx.x == 0) {
        unsigned* bar = b.bar;
        __builtin_amdgcn_s_waitcnt(0);
        unsigned nloc = b.st[0], nx = b.st[1];
        if (nloc == 0u) { xcd_barrier_complete(bar, b.x, nloc, nx); b.st[0] = nloc; b.st[1] = nx; }
        const unsigned old = xb_add(&bar[XB_XSUB(b.x)], 1u);
        const unsigned gen = old / nloc;
        if (old + 1u == (gen + 1u) * nloc) {
            __builtin_amdgcn_fence(__ATOMIC_RELEASE, "agent");
            asm volatile("s_waitcnt vmcnt(0)" ::: "memory");
            const unsigned og = xb_add(&bar[XB_TOP], 1u);
            const unsigned tg = og / nx;
            if (og + 1u == (tg + 1u) * nx) xb_add(&bar[XB_TOPGEN], 1u);
            else XB_SPIN(xb_ld(&bar[XB_TOPGEN]) == tg, bar);
            __builtin_amdgcn_fence(__ATOMIC_ACQUIRE, "agent");
            xb_add(&bar[XB_XGEN(b.x)], 1u);
            asm volatile("s_waitcnt vmcnt(0)" ::: "memory");
        } else {
            XB_SPIN(xb_ld(&bar[XB_XGEN(b.x)]) == gen, bar);
            __builtin_amdgcn_fence(__ATOMIC_ACQUIRE, "agent");
            asm volatile("s_waitcnt vmcnt(0)" ::: "memory");
        }
    }
    __syncthreads();
}

constexpr int N_LAUNCHES = MK_N_LAUNCHES, N_PHASES = 9;
constexpr int WGM_C = 4, WGM_F = 4, WGM_G = 4, WGM_H = 4, WGM_I = 4;
__global__ void __launch_bounds__(NTHREADS, 2) hybrid_fwd(Args args) {
    extern __shared__ __attribute__((aligned(16))) unsigned char lds[];
    Frame F;
    F.lds = lds; F.lds3 = (LAS unsigned char*)lds;
    F.tid = threadIdx.x; F.lane = F.tid & 63; F.wave = __builtin_amdgcn_readfirstlane(F.tid >> 6);
    F.G = gridDim.x; F.blk = blockIdx.x; F.gw = F.blk * 8 + F.wave; F.NGW = F.G * 8;
    F.in = args.in; F.out = args.out; F.ws = args.ws;
    volatile LAS unsigned* bst = (volatile LAS unsigned*)(F.lds3 + LDS_BYTES - 16);
    if (F.tid < 2) bst[F.tid] = 0u;
    __syncthreads();
    XcdBarrier bar = xcd_barrier_post((unsigned*)(args.ws + WS_CTL) + 1024, bst);
    const int lo = args.ph_lo, hi = args.ph_hi;
#ifndef PH_MASK
#define PH_MASK 0x1ff
#endif
#ifndef REP_MASK
#define REP_MASK 0
#endif
#define REP(k) ((REP_MASK >> (k)) & 1)
#define IN(k) (((PH_MASK >> (k)) & 1) && lo <= (k) && (k) < hi)
#define SEAM(k) do { if (IN(k) && IN((k) + 1)) { xcd_barrier(bar); } } while (0)
    unsigned char* ws = args.ws;
#ifdef CLKP
    unsigned long long ck0 = 0, rt0 = 0, ck1 = 0, rt1 = 0;
#define CLK0(k) do { if (CLKP == (k)) { ck0 = __builtin_amdgcn_s_memtime(); rt0 = __builtin_amdgcn_s_memrealtime(); } } while (0)
#define CLK1(k) do { if (CLKP == (k)) { ck1 = __builtin_amdgcn_s_memtime(); rt1 = __builtin_amdgcn_s_memrealtime(); } } while (0)
#else
#define CLK0(k)
#define CLK1(k)
#endif
    if (IN(0)) { CLK0(0); phase_a(F, true); if (REP(0)) { __syncthreads(); phase_a(F, false); } CLK1(0); } SEAM(0);
    if (IN(1)) { CLK0(1); phase_b(F); if (REP(1)) { __syncthreads(); phase_b(F); } CLK1(1); } SEAM(1);
    if (IN(2)) { CLK0(2);
        pg8::Gemm g; g.A0 = g.A1 = (const bf16_t*)(ws + WS_H); g.B0 = g.B1 = (const bf16_t*)(ws + WS_WIN); g.K = D;
        pg8::StaticOrder S; S.init(M, NCOLS, F.G, F.blk, 1, WGM_C);
        EpiInProj E{ws};
        pg8::gemm_phase<EpiInProj, true, true>(F.lds3, g, S, E);
        if (REP(2)) { EpiInProjT<(REP_MASK >> 16) & 3> E2{ws}; if (REP_MASK & 0x100000) S.init(M, NCOLS, F.G, F.blk, 1, -1); pg8::gemm_phase<EpiInProjT<(REP_MASK >> 16) & 3>, true, true>(F.lds3, g, S, E2); }
    CLK1(2); } SEAM(2);
    if (IN(3)) { CLK0(3); phase_d<0>(F); if (REP(3)) { __syncthreads(); phase_d<((REP_MASK >> 16) & 3) ? ((REP_MASK >> 16) & 3) : 1, (REP_MASK >> 18) & 3>(F); } CLK1(3); } SEAM(3);
    if (IN(4)) { CLK0(4);
        const int nscan = (F.G >= 256) ? 128 : F.G / 2;
#ifndef NO_SCAN
        if (F.blk < nscan) { for (int hd = F.blk; hd < BATCH * RH; hd += nscan) rwkv_head(F, hd); }
#endif
#ifndef NO_NSA
        nsa_worker<0>(F);
#endif
        if (REP(4)) {
            xcd_barrier(bar); if (F.blk == 0 && F.tid < 8) __hip_atomic_store((unsigned*)(ws + WS_CTL) + 64 + 16 * F.tid, 0u, __ATOMIC_RELAXED, __HIP_MEMORY_SCOPE_AGENT); xcd_barrier(bar);
            if (REP_MASK & 0x1000) { if (F.blk < nscan) { for (int hd = F.blk; hd < BATCH * RH; hd += nscan) rwkv_head(F, hd); } }
            if (REP_MASK & 0x2000) { nsa_worker<(REP_MASK >> 16) & 3>(F); }
        }
    CLK1(4); } SEAM(4);
    if (IN(5)) { CLK0(5);
        pg8::Gemm g; g.A0 = g.A1 = (const bf16_t*)((const char*)args.out + DO_OAB); g.B0 = g.B1 = (const bf16_t*)(ws + WS_WOA); g.K = D;
        pg8::StaticOrder S; S.init(M, D, F.G, F.blk, 1, WGM_F);
        EpiMerge E{(const bf16_t*)(ws + WS_PMG), (bf16_t*)(ws + WS_MIXED)};
        pg8::gemm_phase<EpiMerge, true, true>(F.lds3, g, S, E);
        if (REP(5)) { if ((REP_MASK >> 16) & 3) { EpiInProjT<2> E2{ws}; pg8::gemm_phase<EpiInProjT<2>, true, true>(F.lds3, g, S, E2); } else pg8::gemm_phase<EpiMerge, true, true>(F.lds3, g, S, E); }
    CLK1(5); } SEAM(5);
    if (IN(6)) { CLK0(6);
        pg8::Gemm g; g.A0 = g.A1 = (const bf16_t*)(ws + WS_MIXED); g.B0 = g.B1 = (const bf16_t*)(ws + WS_WOUT); g.K = D;
        pg8::StaticOrder S; S.init(M, D, F.G, F.blk, 1, WGM_G);
        EpiWout E{args.in[0], (const float*)(ws + WS_MOD), (const float*)(ws + WS_M2V), args.out, (bf16_t*)(ws + WS_X1M), (float*)(ws + WS_SUMSQ)};
        pg8::gemm_phase<EpiWout, true, true>(F.lds3, g, S, E);
    CLK1(6); } SEAM(6);
    if (IN(7)) { CLK0(7);
        pg8::Gemm g; g.A0 = g.A1 = (const bf16_t*)(ws + WS_X1M); g.B0 = g.B1 = (const bf16_t*)(ws + WS_WUP); g.K = D;
        pg8::StaticOrder S; S.init(M, DFF, F.G, F.blk, 1, WGM_H);
        EpiUp E{(const float*)(ws + WS_SUMSQ), (const float*)(ws + WS_C2), (bf16_t*)(ws + WS_U)};
        pg8::gemm_phase<EpiUp, true, true>(F.lds3, g, S, E);
        if (REP(7)) pg8::gemm_phase<EpiUp, true, true>(F.lds3, g, S, E);
    CLK1(7); } SEAM(7);
    if (IN(8)) { CLK0(8);
        pg8::Gemm g; g.A0 = g.A1 = (const bf16_t*)(ws + WS_U); g.B0 = g.B1 = (const bf16_t*)(ws + WS_WDOWN); g.K = DFF;
        pg8::StaticOrder S; S.init(M, D, F.G, F.blk, 1, WGM_I);
        EpiDown E{(const float*)(ws + WS_MOD), args.out};
        pg8::gemm_phase<EpiDown, true, true>(F.lds3, g, S, E);
        CLK1(8);
    }
#ifdef CLKP
    if (F.blk == 0) { const float mhz = (float)(ck1 - ck0) * 100.f / (float)(rt1 - rt0); const unsigned long long t = __builtin_amdgcn_s_memrealtime(), dl = (unsigned long long)(mhz * 100.f);
        while (__builtin_amdgcn_s_memrealtime() - t < dl) __builtin_amdgcn_s_sleep(20); }
#endif
#undef IN
#undef SEAM
}

extern "C" void kernel_launch(void* const* d_in, const int* in_sizes, int n_in, void* d_out, int out_size, void* d_ws, size_t ws_size, hipStream_t stream) {
    static int grid = 0;
    if (grid == 0) {
        if (n_in != 32 || in_sizes[0] != M * D || out_size != M * D || ws_size < WS_END) {
            fprintf(stderr, "kernel_launch: unexpected shapes (n_in %d, in0 %d, out %d, ws %zu); nothing launched\n", n_in, n_in > 0 ? in_sizes[0] : -1, out_size, ws_size); grid = -1; return; }
        int dev = 0, cus = 0, per_cu = 0;
        if (hipGetDevice(&dev) != hipSuccess || hipDeviceGetAttribute(&cus, hipDeviceAttributeMultiprocessorCount, dev) != hipSuccess) { grid = -1; return; }
        if (hipFuncSetAttribute((const void*)hybrid_fwd, hipFuncAttributeMaxDynamicSharedMemorySize, LDS_BYTES) != hipSuccess) { fprintf(stderr, "kernel_launch: hipFuncSetAttribute failed\n"); grid = -1; return; }
        if (hipOccupancyMaxActiveBlocksPerMultiprocessor(&per_cu, (const void*)hybrid_fwd, NTHREADS, LDS_BYTES) != hipSuccess || per_cu < 1) { fprintf(stderr, "kernel_launch: occupancy query gives %d blocks per CU; nothing launched\n", per_cu); per_cu = 0; }
        (void)hipGetLastError();
        if (per_cu < 1) { grid = -1; return; }
        grid = cus;
        if (grid > 256) grid = 256;
    }
    if (grid < 0) return;
    if (hipMemsetAsync((char*)d_ws + WS_CTL, 0, CTL_ZERO_BYTES, stream) != hipSuccess) { fprintf(stderr, "kernel_launch: memset failed\n"); return; }
    Args a{};
    for (int i = 0; i < 32; ++i) a.in[i] = (const float*)d_in[i];
    a.out = (float*)d_out; a.ws = (unsigned char*)d_ws;
    if (N_LAUNCHES == 1) {
        a.ph_lo = 0; a.ph_hi = N_PHASES;
        hipLaunchKernelGGL(hybrid_fwd, dim3(grid), dim3(NTHREADS), LDS_BYTES, stream, a);
        const hipError_t e = hipPeekAtLastError();
        if (e != hipSuccess) fprintf(stderr, "kernel_launch: launch failed: %s (grid %d)\n", hipGetErrorString(e), grid);
    } else {
        for (int p = 0; p < N_PHASES; ++p) { a.ph_lo = p; a.ph_hi = p + 1; hipLaunchKernelGGL(hybrid_fwd, dim3(grid), dim3(NTHREADS), LDS_BYTES, stream, a); }
    }
}
```

```cpp
#include <hip/hip_runtime.h>
#include <cstdio>
#include <cstdint>

#ifndef MK_N_LAUNCHES
#define MK_N_LAUNCHES 1
#endif

#define DI __device__ __forceinline__
#define LAS __attribute__((address_space(3)))
typedef unsigned short bf16_t;
typedef short bf16x8 __attribute__((ext_vector_type(8)));
typedef short s16x4 __attribute__((ext_vector_type(4)));
typedef float f32x2 __attribute__((ext_vector_type(2)));
typedef float f32x4 __attribute__((ext_vector_type(4)));
typedef float f32x16 __attribute__((ext_vector_type(16)));
typedef unsigned u32x2 __attribute__((ext_vector_type(2)));
typedef unsigned u32x4 __attribute__((ext_vector_type(4)));
typedef __bf16 bf16x2_t __attribute__((ext_vector_type(2)));

constexpr int D = 2048, BATCH = 8, T = 2048, M = BATCH * T, DFF = 8192;
constexpr int RW = 1024, RH = 16, HD = 64;
constexpr int NCOLS = 10240;
constexpr int IN_COLS = 10064;
constexpr int NC = 127;
constexpr float NORM_EPS = 1e-6f, GN_EPS = 64e-5f;
constexpr float LOG2E = 1.4426950408889634f;

constexpr size_t MiB = 1u << 20;
constexpr size_t WS_CTL = 0, CTL_ZERO_BYTES = 1 * MiB;
constexpr size_t WS_MOD = 64 * 1024;
constexpr size_t WS_SUMSQ = 512 * 1024;
constexpr size_t WS_C2 = 1 * MiB;
constexpr size_t WS_M2V = WS_C2 + 256 * 1024;
constexpr size_t WS_BIAS = WS_M2V + 64 * 1024;
constexpr size_t WS_CPE = WS_BIAS + 8 * 1024;
constexpr size_t WS_W2T = WS_CPE + 1024;
constexpr size_t WS_A2T = WS_W2T + 128 * 1024;
constexpr size_t WS_G2T = WS_A2T + 128 * 1024;
constexpr size_t WS_CW1K = WS_G2T + 320 * 1024;
constexpr size_t WS_CW1V = WS_CW1K + 256 * 1024;
constexpr size_t WS_CW2K = WS_CW1V + 256 * 1024;
constexpr size_t WS_CW2V = WS_CW2K + 8 * 1024;
constexpr size_t WS_KC = WS_CW2V + 8 * 1024;
constexpr size_t WS_VCT = WS_KC + 512 * 1024;
constexpr size_t WS_BSUM = WS_VCT + 512 * 1024;
constexpr size_t WS_GATES = WS_BSUM + 1 * MiB;
static_assert(WS_GATES + 3 * MiB <= 8 * MiB, "small region");
constexpr size_t WS_WOA = 8 * MiB, WS_WOB = 12 * MiB, WS_WOUT = 16 * MiB, WS_WUP = 24 * MiB, WS_WDOWN = 56 * MiB, WS_WIN = 88 * MiB;
constexpr size_t WS_H = 128 * MiB;
constexpr size_t WS_PR = 192 * MiB, WS_PK = 224 * MiB, WS_PV = 256 * MiB, WS_PQ = 288 * MiB, WS_PKV = 320 * MiB, WS_PMG = 368 * MiB, WS_PMISC = 496 * MiB;
constexpr size_t WS_END = 512 * MiB;
constexpr size_t WS_GRW = 88 * MiB, WS_VST = 120 * MiB, WS_VWT = 128 * MiB;
constexpr size_t DO_OAB = 0;
constexpr size_t WS_STASH = 192 * MiB;
constexpr size_t WS_MIXED = 88 * MiB;
constexpr size_t WS_X1M = 368 * MiB;
constexpr size_t WS_U = 88 * MiB;
static_assert(WS_U + (size_t)M * DFF * 2 <= WS_X1M, "u vs x1m");
constexpr size_t DO_AT = 0, DO_BT = 32 * MiB, DO_KT = 64 * MiB, DO_RT = 96 * MiB;
constexpr size_t WS_VM = 136 * MiB, WS_GL = 168 * MiB;

constexpr int LDS_BYTES = 147456;
constexpr int NTHREADS = 512;

DI float bf2f(unsigned v) { return __uint_as_float(v << 16); }
DI unsigned pk2(float lo, float hi) { f32x2 v = {lo, hi}; bf16x2_t b = __builtin_convertvector(v, bf16x2_t); return __builtin_bit_cast(unsigned, b); }
DI unsigned f2bf(float f) { return pk2(f, 0.f) & 0xffffu; }
DI float lo16(unsigned u) { return __uint_as_float(u << 16); }
DI float hi16(unsigned u) { return __uint_as_float(u & 0xffff0000u); }
DI float wave_sum(float v) {
#pragma unroll
    for (int o = 1; o < 64; o <<= 1) v += __shfl_xor(v, o);
    return v;
}
DI void lds_barrier() { asm volatile("s_waitcnt lgkmcnt(0)\n\ts_barrier" ::: "memory"); }
DI float sigmoidf_(float x) { return __builtin_amdgcn_rcpf(1.f + __expf(-x)); }
template <int CTRL> DI float dpp_mov(float v) { return __builtin_bit_cast(float, __builtin_amdgcn_update_dpp(0, __builtin_bit_cast(int, v), CTRL, 0xf, 0xf, true)); }
DI float swap32_sum(float x) { auto r = __builtin_amdgcn_permlane32_swap(__float_as_uint(x), __float_as_uint(x), false, false); return __uint_as_float(r[0]) + __uint_as_float(r[1]); }
DI float swap32_max(float x) { auto r = __builtin_amdgcn_permlane32_swap(__float_as_uint(x), __float_as_uint(x), false, false); return fmaxf(__uint_as_float(r[0]), __uint_as_float(r[1])); }
DI float wave_sum_dpp(float x);
DI float swap16_sum(float x) { auto r = __builtin_amdgcn_permlane16_swap(__float_as_uint(x), __float_as_uint(x), false, false); return __uint_as_float(r[0]) + __uint_as_float(r[1]); }

DI float wave_sum_dpp(float x) {
    x += dpp_mov<0xB1>(x);
    x += dpp_mov<0x4E>(x);
    x += dpp_mov<0x141>(x);
    x += dpp_mov<0x140>(x);
    return swap32_sum(swap16_sum(x));
}

namespace pg8 {
constexpr int BM = 256, BK = 64, HALF = 128, HTB = HALF * BK * 2, STAGE_BYTES = 8 * HTB, NXCD = 8, WGM = 4;
__host__ __device__ __forceinline__ int lds_byte(int r, int c) { const int st = (r >> 4) * 2 + (c >> 5), rr = r & 15, cc = c & 31, ob = rr * 64 + cc * 2; return st * 1024 + (ob ^ (((ob >> 9) & 1) << 5)); }
__host__ __device__ __forceinline__ void stage_rc(int b, int& R, int& C) { const int st = b / 1024, sb = b % 1024, swz = sb ^ (((sb >> 9) & 1) << 5); R = (st >> 1) * 16 + swz / 64; C = (st & 1) * 32 + (swz % 64) / 2; }
__host__ __device__ __forceinline__ int perm32(int rho) { const int n = rho >> 4, i = rho & 15; return 8 * (i >> 2) + 4 * n + (i & 3); }

struct Unit { int pm, pn, z; };
struct Gemm { const bf16_t* A0; const bf16_t* A1; const bf16_t* B0; const bf16_t* B1; int K; };
struct StaticOrder {
    int nM, nN, nwg, G, c, nz, wgm;
    __device__ void init(int M_, int N_, int G_, int c_, int nz_, int wgm_ = WGM) { nM = M_ / BM; nN = N_ / BM; nwg = nM * nN; G = G_; c = c_; nz = nz_; wgm = wgm_; }
    __device__ bool next(int i, Unit& u) const {
        const int ti = i / nz; u.z = i - ti * nz;
        const long L = (long)ti * G + c; if (L >= nwg) return false;
        if (wgm < 0) { u.pm = c & 7; u.pn = 0; return true; }
        int wgid = (int)L; { const int q = nwg / NXCD, r = nwg % NXCD, xcd = wgid % NXCD, off = wgid / NXCD; wgid = (xcd < r ? xcd * (q + 1) : r * (q + 1) + (xcd - r) * q) + off; }
        const int nig = wgm * nN, gid = wgid / nig, fm = gid * wgm, gsz = (nM - fm) < wgm ? (nM - fm) : wgm;
        u.pm = fm + ((wgid % nig) % gsz); u.pn = (wgid % nig) / gsz; return true;
    }
};

template <class Epi, bool ALIGN_EPI, bool SP2>
__device__ __forceinline__ void gemm_phase(LAS unsigned char* lds, const Gemm g, const StaticOrder& S, const Epi& E) {
    const int tid = threadIdx.x, wid = __builtin_amdgcn_readfirstlane(tid >> 6), lane = tid & 63, wr = wid >> 2, wc = wid & 3, fr = lane & 15, fq = lane >> 4;
    const int K = g.K, nt = K / BK;
    unsigned voffA[2], voffB[2];
#pragma unroll
    for (int i = 0; i < 2; ++i) { int R, C; stage_rc(tid * 16 + i * 8192, R, C); const int Rb = Epi::PERM ? ((R & ~31) + perm32(R & 31)) : R;
        voffA[i] = (unsigned)(R * K + C) * 2u; voffB[i] = (unsigned)(Rb * K + C) * 2u; }
    const size_t kstep = (size_t)(BK * 2);
    const size_t hstep = (size_t)HALF * K * 2;
    const size_t tstep = 2 * hstep;
    const unsigned ldsw = (unsigned)wid * 1024u;
    const int aoff = lds_byte(wr * 64 + fr, fq * 8), boff = lds_byte(wc * 32 + fr, fq * 8);
#define PG8_SA(b, h) (((b) * 2 + (h)) * HTB)
#define PG8_SB(b, h) ((4 + (b) * 2 + (h)) * HTB)
#define PG8_STAGE(bufoff, gbase, voff) do { _Pragma("unroll") for (int _i = 0; _i < 2; ++_i) \
        __builtin_amdgcn_global_load_lds((const unsigned*)((const char*)(gbase) + (voff)[_i]), (LAS unsigned*)(lds + (bufoff) + ldsw + _i * 8192), 16, 0, 0); } while (0)
#define PG8_LDA(dst, b, h) do { _Pragma("unroll") for (int m = 0; m < 4; ++m) _Pragma("unroll") for (int k = 0; k < 2; ++k) dst[m][k] = *(const LAS bf16x8*)(lds + PG8_SA(b, h) + aoff + m * 2048 + k * 1024); } while (0)
#define PG8_LDB(dst, b, h) do { _Pragma("unroll") for (int n = 0; n < 2; ++n) _Pragma("unroll") for (int k = 0; k < 2; ++k) dst[n][k] = *(const LAS bf16x8*)(lds + PG8_SB(b, h) + boff + n * 2048 + k * 1024); } while (0)
#define PG8_MMA(ai, bj, At, Bt) do { __builtin_amdgcn_s_setprio(1); _Pragma("unroll") for (int m = 0; m < 4; ++m) _Pragma("unroll") for (int n = 0; n < 2; ++n) _Pragma("unroll") for (int k = 0; k < 2; ++k) \
        acc[ai][bj][m][n] = __builtin_amdgcn_mfma_f32_16x16x32_bf16(Bt[n][k], At[m][k], acc[ai][bj][m][n], 0, 0, 0); __builtin_amdgcn_s_setprio(0); } while (0)
#define PG8_WAIT_V(n) asm volatile("s_waitcnt vmcnt(" #n ")" ::: "memory")
#define PG8_WAIT_L(n) asm volatile("s_waitcnt lgkmcnt(" #n ")" ::: "memory")
#define PG8_BAR __builtin_amdgcn_s_barrier()
#define PG8_SCHED __builtin_amdgcn_sched_barrier(0)
    Unit cur, nxt; int ui = 0;
    if (!S.next(0, cur)) return;
    f32x4 acc[2][2][4][2];
#pragma unroll
    for (int a = 0; a < 2; ++a)
#pragma unroll
        for (int b = 0; b < 2; ++b)
#pragma unroll
            for (int m = 0; m < 4; ++m)
#pragma unroll
                for (int n = 0; n < 2; ++n) acc[a][b][m][n] = (f32x4){0.f, 0.f, 0.f, 0.f};
    bf16x8 At[4][2], B0[2][2], B1[2][2];
    const char* cA = (const char*)(cur.z ? g.A1 : g.A0) + (size_t)cur.pm * tstep; const char* cB = (const char*)(cur.z ? g.B1 : g.B0) + (size_t)cur.pn * tstep;
    if constexpr (SP2) {
        PG8_STAGE(PG8_SB(0, 0), cB, voffB); PG8_STAGE(PG8_SB(0, 1), cB + hstep, voffB); PG8_STAGE(PG8_SA(0, 0), cA, voffA); PG8_STAGE(PG8_SA(0, 1), cA + hstep, voffA);
        if (wr == 1) PG8_BAR;
        PG8_WAIT_V(2); PG8_BAR;
        PG8_STAGE(PG8_SB(1, 0), cB + kstep, voffB); PG8_STAGE(PG8_SA(1, 0), cA + kstep, voffA); PG8_STAGE(PG8_SB(1, 1), cB + hstep + kstep, voffB);
        PG8_WAIT_V(6); PG8_BAR;
    } else {
        PG8_STAGE(PG8_SB(0, 0), cB, voffB); PG8_STAGE(PG8_SA(0, 0), cA, voffA); PG8_STAGE(PG8_SB(0, 1), cB + hstep, voffB); PG8_STAGE(PG8_SA(0, 1), cA + hstep, voffA);
        if (wr == 1) PG8_BAR;
        PG8_WAIT_V(4); PG8_BAR;
        PG8_STAGE(PG8_SB(1, 0), cB + kstep, voffB); PG8_STAGE(PG8_SA(1, 0), cA + kstep, voffA); PG8_STAGE(PG8_SB(1, 1), cB + hstep + kstep, voffB);
        PG8_WAIT_V(6); PG8_BAR;
    }
    for (;;) {
        const bool has_next = S.next(ui + 1, nxt);
        const char* nA = has_next ? (const char*)(nxt.z ? g.A1 : g.A0) + (size_t)nxt.pm * tstep : cA; const char* nB = has_next ? (const char*)(nxt.z ? g.B1 : g.B0) + (size_t)nxt.pn * tstep : cB;
        for (int t = 0; t < nt; t += 2) {
            if constexpr (Epi::MID_T > 0) { if (t == Epi::MID_T) { E.mid(acc, cur, wr, wc, fr, fq); asm volatile("s_waitcnt vmcnt(0)" ::: "memory"); } }
            const bool last = (t == nt - 2);
            const char* a1 = cA + (size_t)(t + 1) * kstep;
            const char* a2 = last ? nA : cA + (size_t)(t + 2) * kstep; const char* b2 = last ? nB : cB + (size_t)(t + 2) * kstep;
            const char* a3 = a2 + kstep; const char* b3 = b2 + kstep;
            if constexpr (SP2) {
            PG8_LDB(B0, 0, 0); PG8_LDB(B1, 0, 1); PG8_SCHED; PG8_LDA(At, 0, 0); PG8_STAGE(PG8_SA(1, 1), a1 + hstep, voffA);
            PG8_WAIT_V(8); PG8_WAIT_L(0); PG8_BAR; PG8_MMA(0, 0, At, B0); PG8_MMA(0, 1, At, B1); PG8_BAR; PG8_SCHED;
            PG8_LDA(At, 0, 1); PG8_STAGE(PG8_SB(0, 0), b2, voffB); PG8_STAGE(PG8_SB(0, 1), b2 + hstep, voffB); PG8_STAGE(PG8_SA(0, 0), a2, voffA);
            PG8_WAIT_V(8); PG8_WAIT_L(0); PG8_BAR; PG8_MMA(1, 0, At, B0); PG8_MMA(1, 1, At, B1); PG8_BAR; PG8_SCHED;
            PG8_LDB(B0, 1, 0); PG8_LDB(B1, 1, 1); PG8_SCHED; PG8_LDA(At, 1, 0); PG8_STAGE(PG8_SA(0, 1), a2 + hstep, voffA);
            PG8_WAIT_V(8); PG8_WAIT_L(0); PG8_BAR; PG8_MMA(0, 0, At, B0); PG8_MMA(0, 1, At, B1); PG8_BAR; PG8_SCHED;
            PG8_LDA(At, 1, 1); PG8_STAGE(PG8_SB(1, 0), b3, voffB); PG8_STAGE(PG8_SB(1, 1), b3 + hstep, voffB); PG8_STAGE(PG8_SA(1, 0), a3, voffA);
            PG8_WAIT_V(8); PG8_WAIT_L(0); PG8_BAR; PG8_MMA(1, 0, At, B0); PG8_MMA(1, 1, At, B1); PG8_BAR; PG8_SCHED;
            } else {
            PG8_LDB(B0, 0, 0); PG8_SCHED; PG8_LDA(At, 0, 0); PG8_STAGE(PG8_SA(1, 1), a1 + hstep, voffA);
            PG8_WAIT_L(8); PG8_BAR; PG8_WAIT_L(0); PG8_MMA(0, 0, At, B0); PG8_BAR; PG8_SCHED;
            PG8_LDB(B1, 0, 1); PG8_STAGE(PG8_SB(0, 0), b2, voffB);
            PG8_BAR; PG8_WAIT_L(0); PG8_MMA(0, 1, At, B1); PG8_BAR;
            PG8_LDA(At, 0, 1); PG8_STAGE(PG8_SA(0, 0), a2, voffA);
            PG8_BAR; PG8_WAIT_L(0); PG8_MMA(1, 0, At, B0); PG8_BAR; PG8_SCHED;
            PG8_STAGE(PG8_SB(0, 1), b2 + hstep, voffB);
            PG8_WAIT_V(6); PG8_BAR; PG8_MMA(1, 1, At, B1); PG8_BAR;
            PG8_LDB(B0, 1, 0); PG8_SCHED; PG8_LDA(At, 1, 0); PG8_STAGE(PG8_SA(0, 1), a2 + hstep, voffA);
            PG8_WAIT_L(8); PG8_BAR; PG8_WAIT_L(0); PG8_MMA(0, 0, At, B0); PG8_BAR; PG8_SCHED;
            PG8_LDB(B1, 1, 1); PG8_STAGE(PG8_SB(1, 0), b3, voffB);
            PG8_BAR; PG8_WAIT_L(0); PG8_MMA(0, 1, At, B1); PG8_BAR;
            PG8_LDA(At, 1, 1); PG8_STAGE(PG8_SA(1, 0), a3, voffA);
            PG8_BAR; PG8_WAIT_L(0); PG8_MMA(1, 0, At, B0); PG8_BAR; PG8_SCHED;
            PG8_STAGE(PG8_SB(1, 1), b3 + hstep, voffB);
            PG8_WAIT_V(6); PG8_BAR; PG8_MMA(1, 1, At, B1); PG8_BAR;
            }
        }
        if constexpr (ALIGN_EPI) { if (wr == 0) PG8_BAR; }
        E(acc, cur, wr, wc, fr, fq);
        if (!has_next) break;
#pragma unroll
        for (int a = 0; a < 2; ++a)
#pragma unroll
            for (int b = 0; b < 2; ++b)
#pragma unroll
                for (int m = 0; m < 4; ++m)
#pragma unroll
                    for (int n = 0; n < 2; ++n) acc[a][b][m][n] = (f32x4){0.f, 0.f, 0.f, 0.f};
        cur = nxt; cA = nA; cB = nB; ++ui;
        if constexpr (ALIGN_EPI) { if (wr == 1) PG8_BAR; }
    }
    PG8_WAIT_V(0);
    if constexpr (!ALIGN_EPI) { if (wr == 0) PG8_BAR; }
    PG8_BAR;
#undef PG8_SA
#undef PG8_SB
#undef PG8_STAGE
#undef PG8_LDA
#undef PG8_LDB
#undef PG8_MMA
#undef PG8_WAIT_V
#undef PG8_WAIT_L
#undef PG8_BAR
#undef PG8_SCHED
}
}
using pg8::Unit; using pg8::HALF; using pg8::BM;
typedef const f32x4 (&AccRef)[2][2][4][2];

template <int MODE> struct EpiInProjT {
    static constexpr bool PERM = true; static constexpr int MID_T = 0;
    unsigned char* ws;
    DI void operator()(AccRef acc, const Unit& u, int wr, int wc, int fr, int fq) const {
        if (MODE == 2) { f32x4 t = {0.f, 0.f, 0.f, 0.f};
#pragma unroll
            for (int ai = 0; ai < 2; ++ai)
#pragma unroll
                for (int bj = 0; bj < 2; ++bj)
#pragma unroll
                    for (int m = 0; m < 4; ++m) { t += acc[ai][bj][m][0]; t += acc[ai][bj][m][1]; }
            if (t[0] + t[1] + t[2] + t[3] == 123.456f) *(float*)ws = 1.f; return; }
        const int pn = u.pn; bf16_t* base; int ld, ct; bool sig = false;
        if (pn < 4) { base = (bf16_t*)(ws + WS_PR); ld = 1024; ct = pn; }
        else if (pn < 8) { base = (bf16_t*)(ws + WS_PK); ld = 1024; ct = pn - 4; }
        else if (pn < 12) { base = (bf16_t*)(ws + WS_PV); ld = 1024; ct = pn - 8; }
        else if (pn < 16) { base = (bf16_t*)(ws + WS_PQ); ld = 1024; ct = pn - 12; }
        else if (pn < 22) { base = (bf16_t*)(ws + WS_PKV); ld = 1536; ct = pn - 16; }
        else if (pn < 38) { base = (bf16_t*)(ws + WS_PMG); ld = 4096; ct = pn - 22; sig = true; }
        else { base = (bf16_t*)(ws + WS_PMISC); ld = 512; ct = pn - 38; }
        const int row0 = u.pm * BM + wr * 64 + fr, col0 = ct * BM + wc * 32 + 8 * fq;
#pragma unroll
        for (int ai = 0; ai < 2; ++ai)
#pragma unroll
            for (int m = 0; m < 4; ++m) { bf16_t* rowp = base + (size_t)(row0 + ai * HALF + m * 16) * ld + col0;
#pragma unroll
                for (int bj = 0; bj < 2; ++bj) { f32x4 v0 = acc[ai][bj][m][0], v1 = acc[ai][bj][m][1];
                    if (sig) {
#pragma unroll
                        for (int e = 0; e < 4; ++e) { v0[e] = sigmoidf_(v0[e]); v1[e] = sigmoidf_(v1[e]); } }
                    u32x4 w; w.x = pk2(v0[0], v0[1]); w.y = pk2(v0[2], v0[3]); w.z = pk2(v1[0], v1[1]); w.w = pk2(v1[2], v1[3]);
                    if (MODE == 0) *(u32x4*)(rowp + bj * HALF) = w; else if (w.x == 0x12345678u && w.w == 0x9abcdef0u) *(u32x4*)(rowp + bj * HALF) = w; } }
    }
};
typedef EpiInProjT<0> EpiInProj;
struct EpiMerge {
    static constexpr bool PERM = true;
    static constexpr int MID_T = 16;
    const bf16_t* mg; bf16_t* mixed;
    DI void mid(f32x4 (&acc)[2][2][4][2], const Unit& u, int wr, int wc, int fr, int fq) const {
        int row0 = u.pm * BM + wr * 64 + fr, col0 = u.pn * BM + wc * 32 + 8 * fq;
        asm volatile("" : "+v"(row0), "+v"(col0));
#pragma unroll
        for (int ai = 0; ai < 2; ++ai)
#pragma unroll
            for (int m = 0; m < 4; ++m) { const size_t row = (size_t)(row0 + ai * HALF + m * 16);
#pragma unroll
                for (int bj = 0; bj < 2; ++bj) { const int col = col0 + bj * HALF;
                    const u32x4 ga = *(const u32x4*)(mg + row * 4096 + col), gb = *(const u32x4*)(mg + row * 4096 + 2048 + col);
#pragma unroll
                    for (int e = 0; e < 4; ++e) { const float s0 = lo16(ga[e]) * __builtin_amdgcn_rcpf(fmaxf(lo16(gb[e]), 1e-20f)), s1 = hi16(ga[e]) * __builtin_amdgcn_rcpf(fmaxf(hi16(gb[e]), 1e-20f));
                        acc[ai][bj][m][e >> 1][2 * (e & 1)] *= s0; acc[ai][bj][m][e >> 1][2 * (e & 1) + 1] *= s1; } }
                __builtin_amdgcn_sched_barrier(0); }
    }
    DI void operator()(AccRef acc, const Unit& u, int wr, int wc, int fr, int fq) const {
        const int row0 = u.pm * BM + wr * 64 + fr, col0 = u.pn * BM + wc * 32 + 8 * fq;
#pragma unroll
        for (int ai = 0; ai < 2; ++ai)
#pragma unroll
            for (int m = 0; m < 4; ++m) { const size_t row = (size_t)(row0 + ai * HALF + m * 16);
#pragma unroll
                for (int bj = 0; bj < 2; ++bj) { const int col = col0 + bj * HALF;
                    const u32x4 gb = *(const u32x4*)(mg + row * 4096 + 2048 + col); u32x4 w;
#pragma unroll
                    for (int e = 0; e < 4; ++e) w[e] = pk2(acc[ai][bj][m][e >> 1][2 * (e & 1)] * fmaxf(lo16(gb[e]), 1e-20f), acc[ai][bj][m][e >> 1][2 * (e & 1) + 1] * fmaxf(hi16(gb[e]), 1e-20f));
                    *(u32x4*)(mixed + row * 2048 + col) = w; } }
    }
};
struct EpiWout {
    static constexpr bool PERM = false; static constexpr int MID_T = 0;
    const float* x; const float* mod; const float* m2v; float* x1; bf16_t* x1m; float* sumsq;
    DI void operator()(AccRef acc, const Unit& u, int wr, int wc, int fr, int fq) const {
        const int row0 = u.pm * BM + wr * 64 + fr, col0 = u.pn * BM + wc * 32 + 4 * fq; const int b = (u.pm * BM) / T;
        const float* gt1 = mod + (size_t)b * 12288 + 4096; const float* mv = m2v + (size_t)b * 2048;
        f32x4 gv[2][2], m2[2][2];
#pragma unroll
        for (int bj = 0; bj < 2; ++bj)
#pragma unroll
            for (int n = 0; n < 2; ++n) { gv[bj][n] = *(const f32x4*)(gt1 + col0 + bj * HALF + n * 16); m2[bj][n] = *(const f32x4*)(mv + col0 + bj * HALF + n * 16); }
        f32x4 xn[2][2];
#pragma unroll
        for (int bj = 0; bj < 2; ++bj)
#pragma unroll
            for (int n = 0; n < 2; ++n) xn[bj][n] = *(const f32x4*)(x + (size_t)row0 * D + col0 + bj * HALF + n * 16);
#pragma unroll
        for (int gi = 0; gi < 8; ++gi) { const int ai = gi >> 2, m = gi & 3; const size_t row = (size_t)(row0 + ai * HALF + m * 16); float ss = 0.f;
            f32x4 xc[2][2];
#pragma unroll
            for (int bj = 0; bj < 2; ++bj)
#pragma unroll
                for (int n = 0; n < 2; ++n) xc[bj][n] = xn[bj][n];
            if (gi < 7) { const size_t rown = (size_t)(row0 + ((gi + 1) >> 2) * HALF + ((gi + 1) & 3) * 16);
#pragma unroll
                for (int bj = 0; bj < 2; ++bj)
#pragma unroll
                    for (int n = 0; n < 2; ++n) xn[bj][n] = *(const f32x4*)(x + rown * D + col0 + bj * HALF + n * 16); }
#pragma unroll
            for (int bj = 0; bj < 2; ++bj)
#pragma unroll
                for (int n = 0; n < 2; ++n) { const int col = col0 + bj * HALF + n * 16;
                    const f32x4 v = xc[bj][n] + gv[bj][n] * acc[ai][bj][m][n];
                    *(f32x4*)(x1 + row * D + col) = v; ss += (v[0] * v[0] + v[1] * v[1]) + (v[2] * v[2] + v[3] * v[3]);
                    const f32x4 vm = v * m2[bj][n]; u32x2 w; w.x = pk2(vm[0], vm[1]); w.y = pk2(vm[2], vm[3]); *(u32x2*)(x1m + row * D + col) = w; }
            ss += __shfl_xor(ss, 16); ss += __shfl_xor(ss, 32);
            if (fq == 0) atomicAdd(sumsq + row, ss);
            __builtin_amdgcn_sched_barrier(0); }
    }
};
struct EpiUp {
    static constexpr bool PERM = true; static constexpr int MID_T = 0;
    const float* sumsq; const float* c2; bf16_t* uo;
    DI void operator()(AccRef acc, const Unit& u, int wr, int wc, int fr, int fq) const {
        const int row0 = u.pm * BM + wr * 64 + fr, col0 = u.pn * BM + wc * 32 + 8 * fq; const int b = (u.pm * BM) / T;
        const float* cb = c2 + (size_t)b * DFF + col0;
        f32x4 cv[2][2];
#pragma unroll
        for (int bj = 0; bj < 2; ++bj)
#pragma unroll
            for (int n = 0; n < 2; ++n) cv[bj][n] = *(const f32x4*)(cb + bj * HALF + 4 * n);
#pragma unroll
        for (int ai = 0; ai < 2; ++ai)
#pragma unroll
            for (int m = 0; m < 4; ++m) { const size_t row = (size_t)(row0 + ai * HALF + m * 16);
                const float rstd = rsqrtf(sumsq[row] * (1.f / D) + NORM_EPS);
#pragma unroll
                for (int bj = 0; bj < 2; ++bj) { f32x4 v0 = acc[ai][bj][m][0] * rstd + cv[bj][0], v1 = acc[ai][bj][m][1] * rstd + cv[bj][1];
#pragma unroll
                    for (int e = 0; e < 4; ++e) { const float a0 = fmaxf(v0[e], 0.f), a1 = fmaxf(v1[e], 0.f); v0[e] = a0 * a0; v1[e] = a1 * a1; }
                    u32x4 w; w.x = pk2(v0[0], v0[1]); w.y = pk2(v0[2], v0[3]); w.z = pk2(v1[0], v1[1]); w.w = pk2(v1[2], v1[3]);
                    *(u32x4*)(uo + row * DFF + col0 + bj * HALF) = w; } }
    }
};
struct EpiDown {
    static constexpr bool PERM = false; static constexpr int MID_T = 0;
    const float* mod; float* out;
    DI void operator()(AccRef acc, const Unit& u, int wr, int wc, int fr, int fq) const {
        const int row0 = u.pm * BM + wr * 64 + fr, col0 = u.pn * BM + wc * 32 + 4 * fq; const int b = (u.pm * BM) / T;
        const float* gt2 = mod + (size_t)b * 12288 + 10240;
        f32x4 gv[2][2];
#pragma unroll
        for (int bj = 0; bj < 2; ++bj)
#pragma unroll
            for (int n = 0; n < 2; ++n) gv[bj][n] = *(const f32x4*)(gt2 + col0 + bj * HALF + n * 16);
        f32x4 xn[2][2];
#pragma unroll
        for (int bj = 0; bj < 2; ++bj)
#pragma unroll
            for (int n = 0; n < 2; ++n) xn[bj][n] = *(const f32x4*)(out + (size_t)row0 * D + col0 + bj * HALF + n * 16);
#pragma unroll
        for (int gi = 0; gi < 8; ++gi) { const int ai = gi >> 2, m = gi & 3; const size_t row = (size_t)(row0 + ai * HALF + m * 16);
            f32x4 xc[2][2];
#pragma unroll
            for (int bj = 0; bj < 2; ++bj)
#pragma unroll
                for (int n = 0; n < 2; ++n) xc[bj][n] = xn[bj][n];
            if (gi < 7) { const size_t rown = (size_t)(row0 + ((gi + 1) >> 2) * HALF + ((gi + 1) & 3) * 16);
#pragma unroll
                for (int bj = 0; bj < 2; ++bj)
#pragma unroll
                    for (int n = 0; n < 2; ++n) xn[bj][n] = *(const f32x4*)(out + rown * D + col0 + bj * HALF + n * 16); }
#pragma unroll
            for (int bj = 0; bj < 2; ++bj)
#pragma unroll
                for (int n = 0; n < 2; ++n) *(f32x4*)(out + row * D + col0 + bj * HALF + n * 16) = xc[bj][n] + gv[bj][n] * acc[ai][bj][m][n];
            __builtin_amdgcn_sched_barrier(0); }
    }
};

struct Args { const float* in[32]; float* out; unsigned char* ws; int ph_lo, ph_hi; };
struct Frame {
    unsigned char* lds; LAS unsigned char* lds3;
    int tid, lane, wave, gw, NGW, G, blk;
    const float* const* in; float* out; unsigned char* ws;
};
#define LDS_WAIT() asm volatile("s_waitcnt lgkmcnt(0)" ::: "memory")

DI int win_map(int n) {
    if (n < 3072) return n;
    if (n < 4096) return 3360 + (n - 3072);
    if (n < 5632) return 4384 + (n - 4096);
    if (n < 9728) return 5968 + (n - 5632);
    if (n < 10016) return 3072 + (n - 9728);
    if (n < 10064) return 5920 + (n - 10016);
    return -1;
}
DI void transpose_item(const float* __restrict__ W, int ldW, int K, bf16_t* __restrict__ WT, int ldT, int k0, int n0, bool wmap, unsigned* scr, int lane) {
    const int n4 = lane & 15, kq = lane >> 4; const int nn = n0 + 4 * n4; const int src = wmap ? win_map(nn) : nn;
    f32x4 v[16];
#pragma unroll
    for (int i = 0; i < 16; ++i) { const int k = k0 + 8 * (i >> 1) + 2 * kq + (i & 1);
        v[i] = (f32x4){0.f, 0.f, 0.f, 0.f}; if (src >= 0 && k < K) v[i] = *(const f32x4*)(W + (size_t)k * ldW + src); }
#pragma unroll
    for (int p = 0; p < 8; ++p)
#pragma unroll
        for (int e = 0; e < 4; ++e) scr[(4 * n4 + e) * 33 + 4 * p + kq] = pk2(v[2 * p][e], v[2 * p + 1][e]);
    LDS_WAIT(); asm volatile("" ::: "memory");
    const int c = lane & 7;
    if (k0 + 8 * c < K) {
#pragma unroll
        for (int j = 0; j < 8; ++j) { const int n = (lane >> 3) + 8 * j; const unsigned* sp = scr + n * 33 + 4 * c;
            *(u32x4*)(WT + (size_t)(n0 + n) * ldT + k0 + 8 * c) = (u32x4){sp[0], sp[1], sp[2], sp[3]}; }
    }
    LDS_WAIT(); asm volatile("" ::: "memory");
}
DI int rel_bucket_dev(int rel) {
    if (rel < 16) return rel;
    const int thr[15] = {19, 21, 24, 27, 31, 35, 40, 46, 52, 59, 67, 77, 87, 99, 113};
    int bkt = 16;
#pragma unroll
    for (int i = 0; i < 15; ++i) bkt += (rel >= thr[i]) ? 1 : 0;
    return bkt;
}
DI void phase_a(Frame& F, bool first) {
    unsigned* scr = (unsigned*)(F.lds + F.wave * 8448);
    float* sc = (float*)(F.lds + 73728);
    const float* c = F.in[1];
    for (int i = F.tid; i < BATCH * D; i += NTHREADS) { const int b = i >> 11, d = i & 2047; const float cv = c[i]; sc[d * 8 + b] = cv / (1.f + __expf(-cv)); }
    __syncthreads();
    if (first) {
        const float* w_ada = F.in[2]; const float* b_ada = F.in[3]; float* mod = (float*)(F.ws + WS_MOD);
        for (int item = F.gw; item < 1536; item += F.NGW) {
            const int cgi = item % 48, ds = item / 48, c0 = 256 * cgi + 4 * F.lane, d0 = 64 * ds;
            f32x4 acc[8];
#pragma unroll
            for (int b = 0; b < 8; ++b) acc[b] = (f32x4){0.f, 0.f, 0.f, 0.f};
#pragma unroll 8
            for (int d = d0; d < d0 + 64; ++d) {
                const f32x4 wv = *(const f32x4*)(w_ada + (size_t)d * 12288 + c0);
                const f32x4 s0 = *(const f32x4*)(sc + d * 8), s1 = *(const f32x4*)(sc + d * 8 + 4);
                acc[0] += s0[0] * wv; acc[1] += s0[1] * wv; acc[2] += s0[2] * wv; acc[3] += s0[3] * wv;
                acc[4] += s1[0] * wv; acc[5] += s1[1] * wv; acc[6] += s1[2] * wv; acc[7] += s1[3] * wv;
            }
            f32x4 bv = (f32x4){0.f, 0.f, 0.f, 0.f}; if (ds == 0) bv = *(const f32x4*)(b_ada + c0);
#pragma unroll
            for (int b = 0; b < 8; ++b)
#pragma unroll
                for (int e = 0; e < 4; ++e) atomicAdd(mod + (size_t)b * 12288 + c0 + e, acc[b][e] + bv[e]);
        }
    }
    {
        struct MatD { const float* W; int ldW, K; size_t off; int ldT, nblk, kblk; bool wmap; };
        const MatD mats[13] = {
            {F.in[6], IN_COLS, 2048, WS_WIN, 2048, NCOLS / 64, 32, true},
            {F.in[27], 2048, 1024, WS_WOA, 2048, 32, 16, false},
            {F.in[28], 2048, 1024, WS_WOA + 2048, 2048, 32, 16, false},
            {F.in[29], 2048, 2048, WS_WOUT, 2048, 32, 32, false},
            {F.in[30], 8192, 2048, WS_WUP, 2048, 128, 32, false},
            {F.in[31], 2048, 8192, WS_WDOWN, 8192, 32, 128, false},
            {F.in[9], 1024, 64, WS_W2T, 64, 16, 1, false},
            {F.in[11], 1024, 64, WS_A2T, 64, 16, 1, false},
            {F.in[12], 1024, 160, WS_G2T, 160, 16, 3, false},
            {F.in[19], 64, 2048, WS_CW1K, 2048, 1, 32, false},
            {F.in[22], 64, 2048, WS_CW1V, 2048, 1, 32, false},
            {F.in[20], 64, 64, WS_CW2K, 64, 1, 1, false},
            {F.in[23], 64, 64, WS_CW2V, 64, 1, 1, false}};
        int total = 0;
#pragma unroll
        for (int i = 0; i < 13; ++i) total += mats[i].nblk * mats[i].kblk;
        for (int it = F.gw; it < total; it += F.NGW) {
            int r = it, mi = 0;
#pragma unroll
            for (int i = 0; i < 12; ++i) { const int cnt = mats[i].nblk * mats[i].kblk; if (mi == i && r >= cnt) { r -= cnt; mi = i + 1; } }
            const float* W = mats[0].W; int ldW = mats[0].ldW, K = mats[0].K, ldT = mats[0].ldT, nblk = mats[0].nblk; size_t off = mats[0].off; bool wm = mats[0].wmap;
#pragma unroll
            for (int i = 1; i < 13; ++i) if (mi == i) { W = mats[i].W; ldW = mats[i].ldW; K = mats[i].K; ldT = mats[i].ldT; nblk = mats[i].nblk; off = mats[i].off; wm = mats[i].wmap; }
            const int kb = r / nblk, nb = r % nblk;
            transpose_item(W, ldW, K, (bf16_t*)(F.ws + off), ldT, 64 * kb, 64 * nb, wm, scr, F.lane);
        }
    }
    const int gt = F.blk * NTHREADS + F.tid;
    if (gt < 2048) { const int hq = gt >> 7, rel = gt & 127; const float* rb = F.in[26];
        ((float*)(F.ws + WS_BIAS))[gt] = rb[rel_bucket_dev(rel) * 16 + hq] - rb[31 * 16 + hq]; }
    if (gt >= 4096 && gt < 4096 + 2048) { const int i = gt - 4096, b = i >> 8, e = i & 255; ((bf16_t*)(F.ws + WS_KC))[((size_t)(b * 128 + 127)) * 256 + e] = 0; }
    if (gt >= 8192 && gt < 8192 + 2048) { const int i = gt - 8192; ((bf16_t*)(F.ws + WS_VCT))[(size_t)i * 128 + 127] = 0; }
    if (F.gw == F.NGW - 1 || F.gw == F.NGW - 2) {
        const int kv = (F.gw == F.NGW - 1) ? 0 : 1; const float* pe = F.in[kv ? 21 : 18]; const float* w1 = F.in[kv ? 22 : 19];
        float a = 0.f;
        for (int k = 0; k < 2048; ++k) a += pe[k] * w1[(size_t)k * 64 + F.lane];
        ((float*)(F.ws + WS_CPE))[kv * 64 + F.lane] = a;
    }
}

DI void phase_b(Frame& F) {
    const float* mod = (const float*)(F.ws + WS_MOD);
    const float* x = F.in[0]; const float* g1 = F.in[4]; const float* g2 = F.in[5];
    bf16_t* H = (bf16_t*)(F.ws + WS_H);
    float* sh2 = (float*)F.lds;
    for (int i = F.tid; i < BATCH * D; i += NTHREADS) { const int b = i >> 11, d = i & 2047; sh2[i] = mod[(size_t)b * 12288 + 6144 + d]; }
    __syncthreads();
    for (int m0 = F.gw * 8; m0 < M; m0 += F.NGW * 8) {
        const int b = m0 / T; const float* mb = mod + (size_t)b * 12288;
        f32x4 cf[8], sh[8], v[8], vn[8];
#pragma unroll
        for (int j = 0; j < 8; ++j) { const int col = 4 * F.lane + 256 * j; vn[j] = *(const f32x4*)(x + (size_t)m0 * D + col);
            cf[j] = *(const f32x4*)(g1 + col) * (1.f + *(const f32x4*)(mb + 2048 + col)); sh[j] = *(const f32x4*)(mb + col); }
#pragma unroll 1
        for (int k = 0; k < 8; ++k) { const int m = m0 + k;
#pragma unroll
            for (int j = 0; j < 8; ++j) v[j] = vn[j];
            const int mn = (k < 7) ? m + 1 : m;
#pragma unroll
            for (int j = 0; j < 8; ++j) vn[j] = *(const f32x4*)(x + (size_t)mn * D + 4 * F.lane + 256 * j);
            float ss = 0.f;
#pragma unroll
            for (int j = 0; j < 8; ++j) ss += (v[j][0] * v[j][0] + v[j][1] * v[j][1]) + (v[j][2] * v[j][2] + v[j][3] * v[j][3]);
            const float rstd = rsqrtf(wave_sum_dpp(ss) * (1.f / D) + NORM_EPS);
#pragma unroll
            for (int j = 0; j < 8; ++j) { const int col = 4 * F.lane + 256 * j;
                const f32x4 o = (v[j] * rstd) * cf[j] + sh[j];
                u32x2 w; w.x = pk2(o[0], o[1]); w.y = pk2(o[2], o[3]); *(u32x2*)(H + (size_t)m * D + col) = w; }
        }
    }
    for (int i = F.blk * NTHREADS + F.tid; i < BATCH * D; i += F.G * NTHREADS) { const int b = i >> 11, d = i & 2047;
        ((float*)(F.ws + WS_M2V))[i] = g2[d] * (1.f + mod[(size_t)b * 12288 + 8192 + d]); }
    const bf16_t* wup = (const bf16_t*)(F.ws + WS_WUP); float* c2 = (float*)(F.ws + WS_C2);
    for (int n = F.gw; n < DFF; n += F.NGW) {
        u32x4 wv[4];
#pragma unroll
        for (int j = 0; j < 4; ++j) wv[j] = *(const u32x4*)(wup + (size_t)n * D + 8 * F.lane + 512 * j);
#pragma unroll 1
        for (int b = 0; b < 8; ++b) { float p = 0.f;
#pragma unroll
            for (int j = 0; j < 4; ++j) { const float* s = sh2 + b * 2048 + 8 * F.lane + 512 * j; const f32x4 s0 = *(const f32x4*)s, s1 = *(const f32x4*)(s + 4);
                p += lo16(wv[j].x) * s0[0] + hi16(wv[j].x) * s0[1] + lo16(wv[j].y) * s0[2] + hi16(wv[j].y) * s0[3]
                   + lo16(wv[j].z) * s1[0] + hi16(wv[j].z) * s1[1] + lo16(wv[j].w) * s1[2] + hi16(wv[j].w) * s1[3]; }
            p = wave_sum_dpp(p); if (F.lane == 0) c2[(size_t)b * DFF + n] = p; }
    }
}

DI f32x4 mfma16(bf16x8 a, bf16x8 b, f32x4 c) { return __builtin_amdgcn_mfma_f32_16x16x32_bf16(a, b, c, 0, 0, 0); }
DI f32x16 mfma32(bf16x8 a, bf16x8 b, f32x16 c) { return __builtin_amdgcn_mfma_f32_32x32x16_bf16(a, b, c, 0, 0, 0); }
DI float fast_tanh(float x) { const float xc = fminf(fmaxf(x, -15.f), 15.f); const float t = __expf(2.f * xc); return (t - 1.f) * __builtin_amdgcn_rcpf(t + 1.f); }
DI float gelu_tanh(float x) { const float u = 0.7978845608028654f * (x + 0.044715f * x * x * x); return 0.5f * x * (1.f + fast_tanh(u)); }
DI float softplusf_(float x) { return fmaxf(x, 0.f) + __logf(1.f + __expf(-fabsf(x))); }
DI unsigned short f2h(float f) { return __builtin_bit_cast(unsigned short, (_Float16)f); }
DI float h2f(unsigned short u) { return (float)__builtin_bit_cast(_Float16, u); }

DI void compress_pair(Frame& F, int pair) {
    const int grp = F.wave >> 2, wq = F.wave & 3, it = 2 * pair + grp;
    const int kv = it >> 8, r_ = it & 255, b = r_ >> 5, g = (r_ >> 3) & 3, nb = r_ & 7;
    const int m = F.lane & 15, q = F.lane >> 4, n = 16 * nb + m; const bool nvalid = n < NC;
    const bf16_t* PKV = (const bf16_t*)(F.ws + WS_PKV);
    const bf16_t* xbase = PKV + (size_t)(b * T + 16 * n) * 1536 + kv * 256 + g * 64;
    const bf16_t* w1t = (const bf16_t*)(F.ws + (kv ? WS_CW1V : WS_CW1K));
    const bf16_t* w2t = (const bf16_t*)(F.ws + (kv ? WS_CW2V : WS_CW2K));
    const float* cpe = (const float*)(F.ws + WS_CPE) + kv * 64;
    f32x4* part = (f32x4*)F.lds;
    f32x4 acc[4];
#pragma unroll
    for (int i = 0; i < 4; ++i) acc[i] = (f32x4){0.f, 0.f, 0.f, 0.f};
#pragma unroll 4
    for (int ks = 16 * wq; ks < 16 * wq + 16; ++ks) {
        const int k = 32 * ks + 8 * q, tok = k >> 6, d = k & 63;
        bf16x8 bfr = (bf16x8){0, 0, 0, 0, 0, 0, 0, 0};
        if (nvalid) bfr = *(const bf16x8*)(xbase + (size_t)tok * 1536 + d);
#pragma unroll
        for (int ht = 0; ht < 4; ++ht) { const bf16x8 afr = *(const bf16x8*)(w1t + (size_t)(16 * ht + m) * 2048 + k); acc[ht] = mfma16(afr, bfr, acc[ht]); }
    }
#pragma unroll
    for (int ht = 0; ht < 4; ++ht) part[((grp * 4 + wq) * 4 + ht) * 64 + F.lane] = acc[ht];
    __syncthreads();
    if (wq == 0) {
#pragma unroll
        for (int ht = 0; ht < 4; ++ht) { acc[ht] = (part[((grp * 4 + 0) * 4 + ht) * 64 + F.lane] + part[((grp * 4 + 1) * 4 + ht) * 64 + F.lane]) + (part[((grp * 4 + 2) * 4 + ht) * 64 + F.lane] + part[((grp * 4 + 3) * 4 + ht) * 64 + F.lane]);
            const f32x4 cp = *(const f32x4*)(cpe + 16 * ht + 4 * q);
#pragma unroll
            for (int e = 0; e < 4; ++e) acc[ht][e] = gelu_tanh(acc[ht][e] + cp[e]); }
        f32x4 out[4];
#pragma unroll
        for (int i = 0; i < 4; ++i) out[i] = (f32x4){0.f, 0.f, 0.f, 0.f};
#pragma unroll
        for (int kk2 = 0; kk2 < 2; ++kk2) {
            u32x4 bw; bw.x = pk2(acc[2 * kk2][0], acc[2 * kk2][1]); bw.y = pk2(acc[2 * kk2][2], acc[2 * kk2][3]); bw.z = pk2(acc[2 * kk2 + 1][0], acc[2 * kk2 + 1][1]); bw.w = pk2(acc[2 * kk2 + 1][2], acc[2 * kk2 + 1][3]);
            const bf16x8 bfr = __builtin_bit_cast(bf16x8, bw);
#pragma unroll
            for (int dt = 0; dt < 4; ++dt) { const bf16_t* wp = w2t + (size_t)(16 * dt + m) * 64 + 32 * kk2 + 4 * q;
                const u32x2 lo = *(const u32x2*)wp, hi = *(const u32x2*)(wp + 16); u32x4 aw = {lo.x, lo.y, hi.x, hi.y};
                out[dt] = mfma16(__builtin_bit_cast(bf16x8, aw), bfr, out[dt]); }
        }
        if (kv == 0) {
            float ss = 0.f;
#pragma unroll
            for (int dt = 0; dt < 4; ++dt)
#pragma unroll
                for (int e = 0; e < 4; ++e) ss += out[dt][e] * out[dt][e];
            ss += __shfl_xor(ss, 16); ss += __shfl_xor(ss, 32);
            const float rstd = rsqrtf(ss * (1.f / 64.f) + NORM_EPS); const float* kg = F.in[25];
            if (nvalid) {
                bf16_t* kc = (bf16_t*)(F.ws + WS_KC) + ((size_t)(b * 128 + n) * 4 + g) * 64;
#pragma unroll
                for (int dt = 0; dt < 4; ++dt) { const int d = 16 * dt + 4 * q; const f32x4 gv = *(const f32x4*)(kg + d); const f32x4 o = out[dt] * rstd * gv;
                    u32x2 w; w.x = pk2(o[0], o[1]); w.y = pk2(o[2], o[3]); *(u32x2*)(kc + d) = w; }
            }
        } else if (nvalid) {
            bf16_t* vct = (bf16_t*)(F.ws + WS_VCT) + (size_t)(b * 4 + g) * 64 * 128 + n;
#pragma unroll
            for (int dt = 0; dt < 4; ++dt)
#pragma unroll
                for (int e = 0; e < 4; ++e) vct[(size_t)(16 * dt + 4 * q + e) * 128] = (bf16_t)f2bf(out[dt][e]);
        }
    }
    __syncthreads();
}

template <int N> DI float row_shr(float v) { return __builtin_bit_cast(float, __builtin_amdgcn_update_dpp(0, __builtin_bit_cast(int, v), 0x110 + N, 0xf, 0xf, true)); }
DI float row_bcast15(float v) { return __builtin_bit_cast(float, __builtin_amdgcn_update_dpp(0, __builtin_bit_cast(int, v), 0x150 + 15, 0xf, 0xf, true)); }
template <int DMODE, int SV = 0> DI void phase_d(Frame& F) {
    constexpr bool first = (DMODE == 0);
    if (DMODE != 3) for (int pr = F.blk; pr < 256; pr += F.G) compress_pair(F, pr);
    const bf16_t* PR = (const bf16_t*)(F.ws + WS_PR); const bf16_t* PK = (const bf16_t*)(F.ws + WS_PK); const bf16_t* PV = (const bf16_t*)(F.ws + WS_PV);
    const bf16_t* PMISC = (const bf16_t*)(F.ws + WS_PMISC);
    bf16_t* PQ = (bf16_t*)(F.ws + WS_PQ); bf16_t* PKV = (bf16_t*)(F.ws + WS_PKV);
    bf16_t* AT = (bf16_t*)((char*)F.out + DO_AT); bf16_t* BT = (bf16_t*)((char*)F.out + DO_BT); bf16_t* KT = (bf16_t*)((char*)F.out + DO_KT); bf16_t* RT = (bf16_t*)((char*)F.out + DO_RT);
    bf16_t* VM = (bf16_t*)(F.ws + WS_VM); float* GL = (float*)(F.ws + WS_GL);
    bf16_t* GRW = (bf16_t*)(F.ws + WS_GRW); float* BSUM = (float*)(F.ws + WS_BSUM); float* GATES = (float*)(F.ws + WS_GATES);
    const bf16_t* W2T = (const bf16_t*)(F.ws + WS_W2T); const bf16_t* A2T = (const bf16_t*)(F.ws + WS_A2T); const bf16_t* G2T = (const bf16_t*)(F.ws + WS_G2T);
    const float* mu = F.in[7]; const float* w0 = F.in[8]; const float* a0 = F.in[10]; const float* k_k = F.in[13]; const float* k_a = F.in[14]; const float* r_k = F.in[15];
    const float* q_g = F.in[24]; const float* k_g = F.in[25];
    bf16_t* XW = (bf16_t*)F.lds; bf16_t* XA = (bf16_t*)(F.lds + 9216); bf16_t* XG = (bf16_t*)(F.lds + 18432); bf16_t* VT = (bf16_t*)(F.lds + 40960);
    const int q = F.lane >> 4, l16 = F.lane & 15;
    for (int tl = F.blk; tl < M / 64; tl += F.G) {
        const int rowbase = tl * 64, b = rowbase / T, t0 = rowbase % T;
        int tidl = threadIdx.x; asm volatile("" : "+v"(tidl));
#pragma unroll 10
        for (int idx = tidl; idx < 64 * 160; idx += NTHREADS) { const int tok = idx / 160, c = 128 + (idx - tok * 160); const size_t row = rowbase + tok;
            const float cur = bf2f(PMISC[row * 512 + c]); const float prev = (t0 + tok > 0) ? bf2f(PMISC[(row - 1) * 512 + c]) : 0.f;
            const float mv = cur + (prev - cur) * mu[3072 + c];
            XG[tok * 168 + c - 128] = (bf16_t)f2bf(sigmoidf_(mv)); }
#pragma unroll 3
        for (int idx = tidl; idx < 64 * 48; idx += NTHREADS) { const int tok = idx / 48, j = idx - tok * 48; const size_t row = rowbase + tok;
            GATES[row * 48 + j] = sigmoidf_(bf2f(PMISC[row * 512 + 288 + j])); }
#pragma unroll
        for (int i = 0; i < 8; ++i) { const int idx = tidl + NTHREADS * i, s = idx >> 11, rem = idx & 2047, tok = rem >> 5, ch8 = rem & 31;
            const u32x4 v = *(const u32x4*)(PKV + (size_t)(rowbase + tok) * 1536 + (3 + 2 * s) * 256 + ch8 * 8);
            *(u32x4*)(VT + (size_t)(s * 64 + tok) * 264 + ch8 * 8) = v; }
        __syncthreads();
        if (DMODE != 3) { const int s = tidl >> 8, gd = tidl & 255;
          bf16_t* dst = (bf16_t*)(F.ws + (s ? WS_VWT : WS_VST)) + ((size_t)(b * 4 + (gd >> 6)) * 64 + (gd & 63)) * 2048 + t0;
#pragma unroll
          for (int i = 0; i < 8; ++i) { unsigned pk[4];
#pragma unroll
              for (int e = 0; e < 4; ++e) pk[e] = (unsigned)VT[(size_t)(s * 64 + 8 * i + 2 * e) * 264 + gd] | ((unsigned)VT[(size_t)(s * 64 + 8 * i + 2 * e + 1) * 264 + gd] << 16);
              *(u32x4*)(dst + 8 * i) = (u32x4){pk[0], pk[1], pk[2], pk[3]}; } }
#pragma unroll 1
        for (int hh = 0; hh < ((DMODE == 2) ? 0 : 2); ++hh) {
            const int head = 2 * F.wave + hh;
            const unsigned rowoff0 = (unsigned)(rowbase + l16) * 1024u + (unsigned)(head * 64 + 4 * q);
            bf16x8 fgn[5];
#pragma unroll
            for (int ks = 0; ks < 5; ++ks) fgn[ks] = *(const bf16x8*)(G2T + (size_t)(head * 64 + l16) * 160 + 32 * ks + 8 * q);
#pragma unroll 1
            for (int ct = 0; ct < 4; ++ct) {
                bf16x8 fg[5];
#pragma unroll
                for (int ks = 0; ks < 5; ++ks) fg[ks] = fgn[ks];
                { const int ctn = (ct < 3) ? ct + 1 : ct;
#pragma unroll
                  for (int ks = 0; ks < 5; ++ks) fgn[ks] = *(const bf16x8*)(G2T + (size_t)(head * 64 + 16 * ctn + l16) * 160 + 32 * ks + 8 * q); }
#pragma unroll
                for (int tt = 0; tt < 4; ++tt) { const int tokl = 16 * tt + l16; f32x4 ag = {0.f, 0.f, 0.f, 0.f};
#pragma unroll
                    for (int ks = 0; ks < 5; ++ks) ag = mfma16(fg[ks], *(const bf16x8*)(XG + tokl * 168 + 32 * ks + 8 * q), ag);
                    u32x2 w; w.x = pk2(ag[0], ag[1]); w.y = pk2(ag[2], ag[3]); *(u32x2*)(GRW + (rowoff0 + (unsigned)(tt * 16384) + (unsigned)(ct * 16))) = w; }
            }
        }
#pragma unroll 8
        for (int it = 0; it < (first ? 32 : 0); ++it) { const int pair = (F.wave * 32 + it) * 4 + q, tok = pair >> 4, head = pair & 15;
            bf16_t* p = PQ + (size_t)(rowbase + tok) * 1024 + head * 64 + 4 * l16; const u32x2 v = *(const u32x2*)p;
            f32x4 f = {lo16(v.x), hi16(v.x), lo16(v.y), hi16(v.y)}; float ss = (f[0] * f[0] + f[1] * f[1]) + (f[2] * f[2] + f[3] * f[3]);
            ss += __shfl_xor(ss, 1); ss += __shfl_xor(ss, 2); ss += __shfl_xor(ss, 4); ss += __shfl_xor(ss, 8);
            const float rstd = rsqrtf(ss * (1.f / 64.f) + NORM_EPS) * (0.125f * LOG2E); f = f * rstd * *(const f32x4*)(q_g + 4 * l16);
            u32x2 w; w.x = pk2(f[0], f[1]); w.y = pk2(f[2], f[3]); *(u32x2*)p = w; }
#pragma unroll 8
        for (int it = 0; it < (first ? 16 : 0); ++it) { const int pair = (F.wave * 16 + it) * 4 + q, tok = pair >> 3, sg = pair & 7, slot = (sg >> 2) ? 4 : 2, g = sg & 3;
            bf16_t* p = PKV + (size_t)(rowbase + tok) * 1536 + slot * 256 + g * 64 + 4 * l16; const u32x2 v = *(const u32x2*)p;
            f32x4 f = {lo16(v.x), hi16(v.x), lo16(v.y), hi16(v.y)}; float ss = (f[0] * f[0] + f[1] * f[1]) + (f[2] * f[2] + f[3] * f[3]);
            ss += __shfl_xor(ss, 1); ss += __shfl_xor(ss, 2); ss += __shfl_xor(ss, 4); ss += __shfl_xor(ss, 8);
            const float rstd = rsqrtf(ss * (1.f / 64.f) + NORM_EPS); f = f * rstd * *(const f32x4*)(k_g + ((slot == 2) ? 64 : 128) + 4 * l16);
            u32x2 w; w.x = pk2(f[0], f[1]); w.y = pk2(f[2], f[3]); *(u32x2*)p = w; }
        __syncthreads();
    }
}

typedef short s16x4v __attribute__((ext_vector_type(4)));
DI f32x4 mfma16k(s16x4v a, s16x4v b, f32x4 c) { return __builtin_amdgcn_mfma_f32_16x16x16bf16_1k(a, b, c, 0, 0, 0); }
DI s16x4v packbf4(f32x4 v) { u32x2 w = {pk2(v[0], v[1]), pk2(v[2], v[3])}; return __builtin_bit_cast(s16x4v, w); }
DI f32x4 unpackbf4(s16x4v v) { const u32x2 w = __builtin_bit_cast(u32x2, v); return (f32x4){lo16(w.x), hi16(w.x), lo16(w.y), hi16(w.y)}; }
DI s16x4v trread(LAS unsigned char* p) { return __builtin_bit_cast(s16x4v, __builtin_amdgcn_ds_read_tr16_b64_v4i16((LAS s16x4v*)p)); }
constexpr int RC_AT = 0, RC_BT = 9216, RC_KT = 18432, RC_RT = 27648, RC_VV = 36864;
constexpr int RC_MAB = 46080, RC_T = 54272, RC_YO = 46080;
constexpr int RC_MBR = 63488, RC_GY = 71680, RC_GS = 79872, RC_HY = 88064, RC_HS = 96256, RC_S = 104448;
DI f32x4 tile_ch64(const unsigned char* Am, int a0, const unsigned char* Bm, int b0, int c16, int g) {
    f32x4 acc = {0.f, 0.f, 0.f, 0.f};
#pragma unroll
    for (int ks = 0; ks < 2; ++ks) acc = mfma16(*(const bf16x8*)(Am + (a0 + c16) * 144 + (32 * ks + 8 * g) * 2), *(const bf16x8*)(Bm + (b0 + c16) * 144 + (32 * ks + 8 * g) * 2), acc);
    return acc;
}
constexpr int RC_XW = 46080, RC_XA = 55296;
constexpr int RC_RAWR = 64512, RC_RAWK = 73872, RC_RAWV = 83232;
constexpr int RC_RAWX = 120832;
constexpr int RC_SSK = 138512, RC_BSP = 139536, RC_GLV = 140560, RC_BS = 140816, RC_PRM = 141072, RC_CARRY = 143120, RC_MUX = 143760, RC_WLC = 144384;
DI void rwkv_head(Frame& F, int hd) {
    const int b = hd >> 4, h = hd & 15;
    unsigned char* L = F.lds; LAS unsigned char* L3 = F.lds3;
    const int lane0 = F.lane, w = F.wave;
    const bf16_t* PR = (const bf16_t*)(F.ws + WS_PR); const bf16_t* PK = (const bf16_t*)(F.ws + WS_PK); const bf16_t* PV = (const bf16_t*)(F.ws + WS_PV); const bf16_t* PMISC = (const bf16_t*)(F.ws + WS_PMISC);
    const bf16_t* GRW = (const bf16_t*)(F.ws + WS_GRW);
    bf16_t* OA = (bf16_t*)((char*)F.out + DO_OAB);
    const float* ln_w = F.in[16]; const float* ln_b = F.in[17]; const float* mu = F.in[7];
    float* SSK = (float*)(L + RC_SSK); float* BSP = (float*)(L + RC_BSP); float* GLV = (float*)(L + RC_GLV); float* BS = (float*)(L + RC_BS); float* PRM = (float*)(L + RC_PRM);
    u32x4 pre[5];
    auto fetch = [&](int c, int tid_) { const int srow = tid_ >> 3, sch = tid_ & 7, xrow = tid_ >> 4, xch = tid_ & 15; const size_t row = (size_t)b * T + 64 * c;
        const size_t off = (row + srow) * 1024 + h * 64 + 8 * sch;
        pre[0] = *(const u32x4*)(PR + off); pre[1] = *(const u32x4*)(PK + off); pre[2] = *(const u32x4*)(PV + off);
        pre[3] = *(const u32x4*)(PMISC + (row + xrow) * 512 + 8 * xch); pre[4] = *(const u32x4*)(PMISC + (row + xrow + 32) * 512 + 8 * xch); };
    auto commit = [&](int tid_) { const int srow = tid_ >> 3, sch = tid_ & 7, xrow = tid_ >> 4, xch = tid_ & 15;
        *(u32x4*)(L + RC_RAWR + (srow + 1) * 144 + sch * 16) = pre[0]; *(u32x4*)(L + RC_RAWK + (srow + 1) * 144 + sch * 16) = pre[1]; *(u32x4*)(L + RC_RAWV + (srow + 1) * 144 + sch * 16) = pre[2];
        *(u32x4*)(L + RC_RAWX + (xrow + 1) * 272 + xch * 16) = pre[3]; *(u32x4*)(L + RC_RAWX + (xrow + 33) * 272 + xch * 16) = pre[4];
        if (tid_ < 24) *(u32x4*)(L + RC_RAWR + (tid_ >> 3) * 9360 + (tid_ & 7) * 16) = *(const u32x4*)(L + RC_CARRY + tid_ * 16);
        if (tid_ >= 32 && tid_ < 48) *(u32x4*)(L + RC_RAWX + (tid_ & 15) * 16) = *(const u32x4*)(L + RC_CARRY + 384 + (tid_ & 15) * 16); };
    for (int i = F.tid; i < 8192 / 4; i += NTHREADS) ((unsigned*)(L + RC_S))[i] = 0u;
    if (F.tid < 40) *(u32x4*)(L + RC_CARRY + F.tid * 16) = (u32x4){0u, 0u, 0u, 0u};
    __syncthreads();
    { const float* w0 = F.in[8]; const float* a0 = F.in[10]; const float* k_k = F.in[13]; const float* k_a = F.in[14]; const float* r_k = F.in[15];
      const int arr = F.tid >> 6, ch = h * 64 + (F.tid & 63);
      PRM[F.tid] = (arr < 3) ? mu[arr * 1024 + ch] : (arr == 3) ? w0[ch] : (arr == 4) ? a0[ch] : (arr == 5) ? k_k[ch] : (arr == 6) ? k_a[ch] : r_k[ch]; }
    fetch(0, F.tid); commit(F.tid);
    const int ct = w & 3, th = w >> 2;
    bf16x8 fw[2], fa[2];
    { const bf16_t* W2T = (const bf16_t*)(F.ws + WS_W2T); const bf16_t* A2T = (const bf16_t*)(F.ws + WS_A2T); const int c16 = lane0 & 15, g = lane0 >> 4; const int chr = h * 64 + 16 * ct + c16;
#pragma unroll
      for (int ks = 0; ks < 2; ++ks) { fw[ks] = *(const bf16x8*)(W2T + (size_t)chr * 64 + 32 * ks + 8 * g); fa[ks] = *(const bf16x8*)(A2T + (size_t)chr * 64 + 32 * ks + 8 * g); } }
    __syncthreads();
    const int mytile = (w < 4) ? w : (w - 4);
    if (F.tid < 128) ((float*)(L + RC_MUX))[F.tid] = mu[3072 + F.tid];
    const float lnw = ln_w[h * 64 + lane0], lnb = ln_b[h * 64 + lane0];
    asm volatile("" :: "v"(lnw), "v"(lnb), "v"(fw[0]), "v"(fw[1]), "v"(fa[0]), "v"(fa[1]));
    __syncthreads();
#pragma unroll 1
    for (int c = 0; c < T / 64; ++c) {
        const int sb_cur = (c & 1) * 8192, sb_nxt = 8192 - sb_cur;
        int lane = lane0; asm volatile("" : "+v"(lane));
        const int c16 = lane & 15, g = lane >> 4;
        int tidl = F.tid; asm volatile("" : "+v"(tidl));
        if (c + 1 < T / 64) fetch(c + 1, tidl);
        unsigned short pgr[8];
#pragma unroll
        for (int it = 0; it < 8; ++it) { const size_t row = (size_t)b * T + 64 * c + w * 8 + it; pgr[it] = GRW[row * 1024 + h * 64 + lane]; }
        const f32x4 mxa = *(const f32x4*)(L + RC_MUX + (F.tid & 15) * 32), mxb = *(const f32x4*)(L + RC_MUX + (F.tid & 15) * 32 + 16);
        const float mux[8] = {mxa[0], mxa[1], mxa[2], mxa[3], mxb[0], mxb[1], mxb[2], mxb[3]};
#pragma unroll
        for (int i = 0; i < 2; ++i) { const int idx8 = F.tid + NTHREADS * i, tok = idx8 >> 4, cg = idx8 & 15;
            const u32x4 cu = *(const u32x4*)(L + RC_RAWX + (tok + 1) * 272 + cg * 16), pr = *(const u32x4*)(L + RC_RAWX + tok * 272 + cg * 16); u32x4 o;
#pragma unroll
            for (int e = 0; e < 4; ++e) { const float c0 = lo16(cu[e]), c1 = hi16(cu[e]), p0 = lo16(pr[e]), p1 = hi16(pr[e]);
                float m0 = c0 + (p0 - c0) * mux[2 * e], m1 = c1 + (p1 - c1) * mux[2 * e + 1];
                if (cg < 8) { m0 = fast_tanh(m0); m1 = fast_tanh(m1); }
                o[e] = pk2(m0, m1); }
            *(u32x4*)(L + ((cg < 8) ? (RC_XW + (tok * 72 + cg * 8) * 2) : (RC_XA + (tok * 72 + (cg - 8) * 8) * 2))) = o; }
        {
            const int tok = F.tid >> 3, c8 = F.tid & 7;
            const u32x4 kc = *(const u32x4*)(L + RC_RAWK + (tok + 1) * 144 + c8 * 16), kp = *(const u32x4*)(L + RC_RAWK + tok * 144 + c8 * 16);
            const f32x4 m0 = *(const f32x4*)(PRM + 64 + 8 * c8), m1 = *(const f32x4*)(PRM + 64 + 8 * c8 + 4), q0 = *(const f32x4*)(PRM + 5 * 64 + 8 * c8), q1 = *(const f32x4*)(PRM + 5 * 64 + 8 * c8 + 4);
            float ss = 0.f;
#pragma unroll
            for (int e = 0; e < 4; ++e) { const float c0 = lo16(kc[e]), c1 = hi16(kc[e]), p0 = lo16(kp[e]), p1 = hi16(kp[e]);
                const float mu0 = (e < 2) ? m0[2 * e] : m1[2 * e - 4], mu1 = (e < 2) ? m0[2 * e + 1] : m1[2 * e - 3], kq0 = (e < 2) ? q0[2 * e] : q1[2 * e - 4], kq1 = (e < 2) ? q0[2 * e + 1] : q1[2 * e - 3];
                const float k0 = (c0 + (p0 - c0) * mu0) * kq0, k1 = (c1 + (p1 - c1) * mu1) * kq1; ss += k0 * k0 + k1 * k1; }
            ss += dpp_mov<0xB1>(ss); ss += dpp_mov<0x4E>(ss); ss += dpp_mov<0x141>(ss);
            if (c8 == 0) SSK[tok] = ss; }
        lds_barrier();
        f32x4 axv[2], bxv[2];
        {
            f32x4 inc0 = {0.f, 0.f, 0.f, 0.f}, inc1 = inc0, wl0 = inc0, wl1 = inc0, carry = inc0;
            const float* prm = PRM + 16 * ct + 4 * g;
            const f32x4 w0v = *(const f32x4*)(prm + 3 * 64);
#pragma unroll
            for (int q2 = 0; q2 < 2; ++q2) { const int tt = 2 * th + q2;
                f32x4 aw = {0.f, 0.f, 0.f, 0.f};
#pragma unroll
                for (int ks = 0; ks < 2; ++ks) aw = mfma16(fw[ks], *(const bf16x8*)(L + RC_XW + ((16 * tt + c16) * 72 + 32 * ks + 8 * g) * 2), aw);
                f32x4 ic, wv;
#pragma unroll
                for (int e = 0; e < 4; ++e) { const float wpre = w0v[e] + aw[e]; const float wl = -0.6065306597126334f * __builtin_amdgcn_rcpf(1.f + __expf(-wpre));
                    float x = wl; x += row_shr<1>(x); x += row_shr<2>(x); x += row_shr<4>(x); x += row_shr<8>(x);
                    ic[e] = x + carry[e]; carry[e] += row_bcast15(x); wv[e] = wl; }
                if (q2 == 0) { inc0 = ic; wl0 = wv; } else { inc1 = ic; wl1 = wv; }
            }
            if (th == 0 && c16 == 0) *(f32x4*)(L + RC_WLC + (16 * ct + 4 * g) * 4) = carry;
            lds_barrier();
            if (th == 1) { const f32x4 c0 = *(const f32x4*)(L + RC_WLC + (16 * ct + 4 * g) * 4); inc0 += c0; inc1 += c0; }
            const f32x4 mur = *(const f32x4*)(prm), muk = *(const f32x4*)(prm + 64), muv = *(const f32x4*)(prm + 128);
            const f32x4 a0v = *(const f32x4*)(prm + 4 * 64), kkw = *(const f32x4*)(prm + 5 * 64), kaw = *(const f32x4*)(prm + 6 * 64), rkw = *(const f32x4*)(prm + 7 * 64);
#pragma unroll
            for (int j = 0; j < 2; ++j) {
                const int tok = 32 * th + 16 * j + c16;
                f32x4 aa = {0.f, 0.f, 0.f, 0.f};
#pragma unroll
                for (int ks = 0; ks < 2; ++ks) aa = mfma16(fa[ks], *(const bf16x8*)(L + RC_XA + (tok * 72 + 32 * ks + 8 * g) * 2), aa);
                const f32x4 inc = (j == 0) ? inc0 : inc1, wl4 = (j == 0) ? wl0 : wl1;
                const int ro = ((tok + 1) * 72 + 16 * ct + 4 * g) * 2;
                const u32x2 kc_ = *(const u32x2*)(L + RC_RAWK + ro), kp_ = *(const u32x2*)(L + RC_RAWK + ro - 144), rc_ = *(const u32x2*)(L + RC_RAWR + ro), rp_ = *(const u32x2*)(L + RC_RAWR + ro - 144),
                            vc_ = *(const u32x2*)(L + RC_RAWV + ro), vp_ = *(const u32x2*)(L + RC_RAWV + ro - 144);
                const f32x4 kc4 = {lo16(kc_.x), hi16(kc_.x), lo16(kc_.y), hi16(kc_.y)}, kp4 = {lo16(kp_.x), hi16(kp_.x), lo16(kp_.y), hi16(kp_.y)};
                const f32x4 rc4 = {lo16(rc_.x), hi16(rc_.x), lo16(rc_.y), hi16(rc_.y)}, rp4 = {lo16(rp_.x), hi16(rp_.x), lo16(rp_.y), hi16(rp_.y)};
                const f32x4 vc4 = {lo16(vc_.x), hi16(vc_.x), lo16(vc_.y), hi16(vc_.y)}, vp4 = {lo16(vp_.x), hi16(vp_.x), lo16(vp_.y), hi16(vp_.y)};
                const f32x4 km = kc4 + (kp4 - kc4) * muk, rm = rc4 + (rp4 - rc4) * mur, vm = vc4 + (vp4 - vc4) * muv; f32x4 kt, rt;
                float bs = 0.f;
                const float inv = __builtin_amdgcn_rsqf(fmaxf(SSK[tok], 1e-24f));
#pragma unroll
                for (int e = 0; e < 4; ++e) {
                    const float ei = __expf(inc[e]), eiv = __builtin_amdgcn_rcpf(ei);
                    const float a = __builtin_amdgcn_rcpf(1.f + __expf(-(a0v[e] + aa[e])));
                    const float kk = km[e] * kkw[e] * inv;
                    axv[j][e] = -kk * (ei * __expf(-wl4[e])); bxv[j][e] = kk * a * eiv;
                    const float kpn = km[e] * (1.f + (a - 1.f) * kaw[e]);
                    bs += rm[e] * kpn * rkw[e];
                    kt[e] = kpn * eiv; rt[e] = rm[e] * ei;
                    if (th == 1 && j == 1 && c16 == 15) GLV[16 * ct + 4 * g + e] = ei;
                }
                bs = swap32_sum(swap16_sum(bs));
                if (g == 0) BSP[ct * 64 + tok] = bs;
                { const int o = (tok * 72 + 16 * ct + 4 * g) * 2;
                  *(s16x4v*)(L + RC_AT + o) = packbf4(axv[j]); *(s16x4v*)(L + RC_BT + o) = packbf4(bxv[j]);
                  *(s16x4v*)(L + RC_KT + o) = packbf4(kt); *(s16x4v*)(L + RC_RT + o) = packbf4(rt); *(s16x4v*)(L + RC_VV + o) = packbf4(vm); }
            }
        }
        lds_barrier();
        if (F.tid < 64) BS[F.tid] = (BSP[F.tid] + BSP[64 + F.tid]) + (BSP[128 + F.tid] + BSP[192 + F.tid]);
        if (F.tid >= 64 && F.tid < 88) { const int i = F.tid - 64, arr = i >> 3, pc = i & 7; *(u32x4*)(L + RC_CARRY + i * 16) = *(const u32x4*)(L + RC_RAWR + arr * 9360 + 64 * 144 + pc * 16); }
        if (F.tid >= 96 && F.tid < 112) { const int pc = F.tid - 96; *(u32x4*)(L + RC_CARRY + 384 + pc * 16) = *(const u32x4*)(L + RC_RAWX + 64 * 272 + pc * 16); }
        f32x4 glv;
#pragma unroll
        for (int cb = 0; cb < 4; ++cb) glv[cb] = GLV[16 * cb + c16];
        f32x4 Nq, NTq;
        {
            auto other_tile = [&](int idx) {
                int sb, tb; bool isbr;
                if (idx < 6) { isbr = false; sb = (int)((0x211000u >> (4 * idx)) & 0xfu); tb = (int)((0x332321u >> (4 * idx)) & 0xfu); }
                else { isbr = true; const int k = idx - 6; sb = (int)((0x3221110000ull >> (4 * k)) & 0xfull); tb = (int)((0x3323213210ull >> (4 * k)) & 0xfull); }
                f32x4 acc = tile_ch64(L + RC_BT, 16 * sb, L + (isbr ? RC_RT : RC_AT), 16 * tb, c16, g);
                if (isbr && sb == tb) {
#pragma unroll
                    for (int e = 0; e < 4; ++e) if (4 * g + e > c16) acc[e] = 0.f;
                }
                *(s16x4v*)(L + (isbr ? RC_MBR : RC_MAB) + (sb * 4 + tb) * 512 + lane * 8) = packbf4(acc);
            };
            if (w < 4) {
                Nq = tile_ch64(L + RC_BT, 16 * w, L + RC_AT, 16 * w, c16, g);
                NTq = tile_ch64(L + RC_AT, 16 * w, L + RC_BT, 16 * w, c16, g);
#pragma unroll
                for (int e = 0; e < 4; ++e) { if (4 * g + e >= c16) Nq[e] = 0.f; if (c16 >= 4 * g + e) NTq[e] = 0.f; }
#pragma unroll
                for (int k = 0; k < 4; ++k) other_tile(4 * w + k);
            }
        }
        f32x4 maktT[4], mkr[4];
        if (w < 4) {
            const f32x4 zero = {0.f, 0.f, 0.f, 0.f};
            f32x4 Id;
#pragma unroll
            for (int e = 0; e < 4; ++e) Id[e] = (4 * g + e == c16) ? 1.f : 0.f;
            const s16x4v nb = packbf4(Nq), ntb = packbf4(NTq);
            const f32x4 N2 = mfma16k(ntb, nb, zero), N2T = mfma16k(nb, ntb, zero);
            const s16x4v n2b = packbf4(N2), n2tb = packbf4(N2T);
            const f32x4 N4 = mfma16k(n2tb, n2b, zero), N4T = mfma16k(n2b, n2tb, zero);
            const s16x4v n4b = packbf4(N4), n4tb = packbf4(N4T);
            const s16x4v n8b = packbf4(mfma16k(n4tb, n4b, zero));
            const f32x4 T1 = Id + Nq, T1T = Id + NTq; const s16x4v t1tb = packbf4(T1T);
            const f32x4 T2 = mfma16k(t1tb, n2b, T1), T2T = mfma16k(n2b, t1tb, T1T); const s16x4v t2tb = packbf4(T2T);
            const f32x4 T3 = mfma16k(t2tb, n4b, T2), T3T = mfma16k(n4b, t2tb, T2T);
            const f32x4 T4 = mfma16k(packbf4(T3T), n8b, T3);
            *(s16x4v*)(L + RC_T + w * 512 + lane * 8) = packbf4(T4);
#pragma unroll
            for (int q = 0; q < 4; ++q) { maktT[q] = zero; mkr[q] = zero; }
        } else {
            const int st = w - 4;
#pragma unroll
            for (int tb = 0; tb < 4; ++tb) {
                f32x4 a1 = {0.f, 0.f, 0.f, 0.f}, a2 = a1;
                if (tb >= st) {
                    a1 = tile_ch64(L + RC_AT, 16 * tb, L + RC_KT, 16 * st, c16, g);
                    a2 = tile_ch64(L + RC_KT, 16 * st, L + RC_RT, 16 * tb, c16, g);
                    if (tb == st) {
#pragma unroll
                        for (int e = 0; e < 4; ++e) { if (c16 >= 4 * g + e) a1[e] = 0.f; if (4 * g + e > c16) a2[e] = 0.f; }
                    }
                }
                maktT[tb] = a1; mkr[tb] = a2;
            }
        }
        lds_barrier();
        s16x4v xb[4];
        {
            s16x4v mabi[6], ti[4], yi[4];
            mabi[0] = *(const s16x4v*)(L + RC_MAB + (0 * 4 + 1) * 512 + lane * 8); mabi[1] = *(const s16x4v*)(L + RC_MAB + (0 * 4 + 2) * 512 + lane * 8); mabi[2] = *(const s16x4v*)(L + RC_MAB + (1 * 4 + 2) * 512 + lane * 8);
            mabi[3] = *(const s16x4v*)(L + RC_MAB + (0 * 4 + 3) * 512 + lane * 8); mabi[4] = *(const s16x4v*)(L + RC_MAB + (1 * 4 + 3) * 512 + lane * 8); mabi[5] = *(const s16x4v*)(L + RC_MAB + (2 * 4 + 3) * 512 + lane * 8);
#pragma unroll
            for (int q = 0; q < 4; ++q) { ti[q] = *(const s16x4v*)(L + RC_T + q * 512 + lane * 8);
                if (w < 4) yi[q] = trread(L3 + RC_AT + (16 * q + 4 * g + ((lane >> 2) & 3)) * 144 + (16 * w) * 2 + 8 * (lane & 3)); }
            __builtin_amdgcn_sched_barrier(0);
#pragma unroll
            for (int q = 0; q < 4; ++q) {
                f32x4 y = (w < 4) ? unpackbf4(yi[q]) : maktT[q];
#pragma unroll
                for (int p = 0; p < 4; ++p) if (p < q) y = mfma16k(mabi[(q == 1) ? 0 : (q == 2) ? (1 + p) : (3 + p)], xb[p], y);
                const f32x4 xq = mfma16k(ti[q], packbf4(y), (f32x4){0.f, 0.f, 0.f, 0.f});
                xb[q] = packbf4(xq);
            }
        }
        {
            s16x4v mbri[10]; u32x2 rvi[4];
#pragma unroll
            for (int tb = 0; tb < 4; ++tb) {
#pragma unroll
                for (int sb = 0; sb < 4; ++sb) if (sb <= tb) mbri[tb * (tb + 1) / 2 + sb] = *(const s16x4v*)(L + RC_MBR + (sb * 4 + tb) * 512 + lane * 8);
                if (w < 4) rvi[tb] = *(const u32x2*)(L + RC_RT + (16 * tb + c16) * 144 + (16 * w + 4 * g) * 2); }
            __builtin_amdgcn_sched_barrier(0);
#pragma unroll
            for (int tb = 0; tb < 4; ++tb) {
                f32x4 acc;
                if (w < 4) acc = (f32x4){lo16(rvi[tb].x), hi16(rvi[tb].x), lo16(rvi[tb].y), hi16(rvi[tb].y)};
                else acc = mkr[tb];
#pragma unroll
                for (int sb = 0; sb < 4; ++sb) if (sb <= tb) acc = mfma16k(xb[sb], mbri[tb * (tb + 1) / 2 + sb], acc);
                *(s16x4v*)(L + ((w < 4) ? RC_GY : RC_HY) + (mytile * 4 + tb) * 512 + lane * 8) = packbf4(acc);
            }
        }
#pragma unroll
        for (int ch2 = 0; ch2 < 2; ++ch2) {
            s16x4v bti[8], kti[2];
#pragma unroll
            for (int c1 = 0; c1 < 2; ++c1) { const int cb = 2 * ch2 + c1;
#pragma unroll
                for (int tb = 0; tb < 4; ++tb) bti[c1 * 4 + tb] = trread(L3 + RC_BT + (16 * tb + 4 * g + ((lane >> 2) & 3)) * 144 + (16 * cb) * 2 + 8 * (lane & 3));
                if (w >= 4) kti[c1] = trread(L3 + RC_KT + (16 * (w - 4) + 4 * g + ((lane >> 2) & 3)) * 144 + (16 * cb) * 2 + 8 * (lane & 3)); }
            __builtin_amdgcn_sched_barrier(0);
#pragma unroll
            for (int c1 = 0; c1 < 2; ++c1) { const int cb = 2 * ch2 + c1;
                f32x4 acc = {0.f, 0.f, 0.f, 0.f};
#pragma unroll
                for (int tb = 0; tb < 4; ++tb) acc = mfma16k(xb[tb], bti[c1 * 4 + tb], acc);
                if (w < 4) {
#pragma unroll
                    for (int e = 0; e < 4; ++e) if (16 * w + 4 * g + e == 16 * cb + c16) acc[e] += 1.f;
                } else acc += unpackbf4(kti[c1]);
                acc = acc * glv[cb];
                *(s16x4v*)(L + ((w < 4) ? RC_GS : RC_HS) + (mytile * 4 + cb) * 512 + lane * 8) = packbf4(acc);
            }
            __builtin_amdgcn_sched_barrier(0);
        }
        lds_barrier();
        {
            const int ib = w & 3, hf = w >> 2;
            s16x4v simg[4], vtr[4];
#pragma unroll
            for (int k = 0; k < 4; ++k) { simg[k] = *(const s16x4v*)(L + RC_S + sb_cur + (k * 4 + ib) * 512 + lane * 8);
                vtr[k] = trread(L3 + RC_VV + (16 * k + 4 * g + ((lane >> 2) & 3)) * 144 + (16 * ib) * 2 + 8 * (lane & 3)); }
#pragma unroll
            for (int j = 0; j < 2; ++j) {
                const int tb = 2 * hf + j, cb = 2 * hf + j;
                f32x4 y = {0.f, 0.f, 0.f, 0.f}, sn = y;
                { s16x4v gyi[4], hyi[4];
#pragma unroll
                  for (int k = 0; k < 4; ++k) { gyi[k] = *(const s16x4v*)(L + RC_GY + (k * 4 + tb) * 512 + lane * 8); hyi[k] = *(const s16x4v*)(L + RC_HY + (k * 4 + tb) * 512 + lane * 8); }
                  __builtin_amdgcn_sched_barrier(0);
#pragma unroll
                  for (int k = 0; k < 4; ++k) y = mfma16k(simg[k], gyi[k], y);
#pragma unroll
                  for (int k = 0; k < 4; ++k) if (k <= tb) y = mfma16k(vtr[k], hyi[k], y); }
                { s16x4v gsi[4], hsi[4];
#pragma unroll
                  for (int k = 0; k < 4; ++k) { gsi[k] = *(const s16x4v*)(L + RC_GS + (k * 4 + cb) * 512 + lane * 8); hsi[k] = *(const s16x4v*)(L + RC_HS + (k * 4 + cb) * 512 + lane * 8); }
                  __builtin_amdgcn_sched_barrier(0);
#pragma unroll
                  for (int k = 0; k < 4; ++k) sn = mfma16k(gsi[k], simg[k], sn);
#pragma unroll
                  for (int k = 0; k < 4; ++k) sn = mfma16k(hsi[k], vtr[k], sn); }
                *(f32x4*)(L + RC_YO + ((16 * tb + c16) * 68 + 16 * ib + 4 * g) * 4) = y;
                *(s16x4v*)(L + RC_S + sb_nxt + (cb * 4 + ib) * 512 + lane * 8) = packbf4(sn);
            }
        }
        lds_barrier();
        if (c + 1 < T / 64) commit(tidl);
        {
            float yv[8], mean[8], var[8];
#pragma unroll
            for (int it = 0; it < 8; ++it) yv[it] = *(const float*)(L + RC_YO + ((w * 8 + it) * 68 + lane) * 4);
#pragma unroll
            for (int it = 0; it < 8; ++it) mean[it] = wave_sum_dpp(yv[it]) * (1.f / 64.f);
#pragma unroll
            for (int it = 0; it < 8; ++it) { yv[it] -= mean[it]; var[it] = wave_sum_dpp(yv[it] * yv[it]) * (1.f / 64.f); }
            const float lw = lnw, lb = lnb;
#pragma unroll
            for (int it = 0; it < 8; ++it) { const size_t row = (size_t)b * T + 64 * c + w * 8 + it;
                const float yn = yv[it] * rsqrtf(var[it] + GN_EPS) * lw + lb;
                const int tk = w * 8 + it; const float vv = bf2f(*(const bf16_t*)(L + RC_VV + (tk * 72 + lane) * 2));
                OA[row * 2048 + h * 64 + lane] = (bf16_t)f2bf((yn + BS[tk] * vv) * bf2f(pgr[it])); }
        }
        lds_barrier();
    }
}

DI int crow(int reg, int hh) { return (reg & 3) + 8 * (reg >> 2) + 4 * hh; }
constexpr int NSA_KB = 0, NSA_VB = 18432, NSA_PSUM = 36864, NSA_IMP = 70144, NSA_SEL = 78848, NSA_UNI = 79104, NSA_ITEM = 79108, NSA_BT = 79360, NSA_Q = 90112;
constexpr float NEGBIG = -1e30f;
constexpr int NSA_EXT = 122880, EXT_STRIDE = 1040, NSA_WED = NSA_EXT + 16 * EXT_STRIDE, WED_STRIDE = 784, NSA_END = NSA_WED + 4 * WED_STRIDE;
static_assert(NSA_END <= LDS_BYTES - 16, "NSA tables overflow the LDS");
DI void add_ext(f32x16& s0, f32x16& s1, const unsigned char* tp) {
    f32x4 a[4], b[4];
#pragma unroll
    for (int q = 0; q < 4; ++q) { a[q] = *(const f32x4*)(tp + 32 * q); b[q] = *(const f32x4*)(tp + 128 + 32 * q); }
#pragma unroll
    for (int q = 0; q < 4; ++q)
#pragma unroll
        for (int e = 0; e < 4; ++e) { float x = s0[4 * q + e], y = s1[4 * q + e];
            asm("v_add_f32 %0, %0, %1" : "+v"(x) : "v"(a[q][e])); asm("v_add_f32 %0, %0, %1" : "+v"(y) : "v"(b[q][e]));
            s0[4 * q + e] = x; s1[4 * q + e] = y; }
}
struct TileRegs { u32x4 k, v; };
DI void tile_fetch(TileRegs& r, const bf16_t* Kp, size_t kstride, const bf16_t* Vp, size_t vstride, int tid) {
    const int row = tid >> 3, ch = tid & 7;
    r.k = *(const u32x4*)(Kp + (size_t)row * kstride + ch * 8);
    r.v = *(const u32x4*)(Vp + (size_t)row * vstride + ch * 8);
}
DI void tile_commit(const TileRegs& r, unsigned char* lds, int buf, int tid) {
    const int row = tid >> 3, ch = tid & 7;
    *(u32x4*)(lds + NSA_KB + buf * 9216 + row * 144 + ch * 16) = r.k;
    unsigned char* vp = lds + NSA_VB + buf * 8704 + row * 136 + ch * 16;
    *(u32x2*)vp = (u32x2){r.v.x, r.v.y}; *(u32x2*)(vp + 8) = (u32x2){r.v.z, r.v.w};
}
DI void tile_scores_q(f32x16& s0, f32x16& s1, const unsigned char* lds, int buf, const bf16x8 (&qf)[4], int r, int hh) {
    const unsigned char* kb = lds + NSA_KB + buf * 9216 + r * 144 + hh * 16;
    s0 = (f32x16){0.f, 0.f, 0.f, 0.f, 0.f, 0.f, 0.f, 0.f, 0.f, 0.f, 0.f, 0.f, 0.f, 0.f, 0.f, 0.f}; s1 = s0;
#pragma unroll
    for (int d0 = 0; d0 < 4; ++d0) {
        const bf16x8 k0 = *(const bf16x8*)(kb + d0 * 32), k1 = *(const bf16x8*)(kb + 32 * 144 + d0 * 32);
        s0 = mfma32(k0, qf[d0], s0); s1 = mfma32(k1, qf[d0], s1);
    }
}
DI void tile_scores(f32x16& s0, f32x16& s1, const unsigned char* lds, int buf, const unsigned char* qb, int r, int hh, const unsigned char* row = nullptr) {
    const unsigned char* kb = lds + NSA_KB + buf * 9216 + r * 144 + hh * 16;
    if (row) {
#pragma unroll
        for (int q = 0; q < 4; ++q) { const f32x4 a = *(const f32x4*)(row + 32 * q), b = *(const f32x4*)(row + 128 + 32 * q);
#pragma unroll
            for (int e = 0; e < 4; ++e) { s0[4 * q + e] = a[e]; s1[4 * q + e] = b[e]; } }
    } else { s0 = (f32x16){0.f, 0.f, 0.f, 0.f, 0.f, 0.f, 0.f, 0.f, 0.f, 0.f, 0.f, 0.f, 0.f, 0.f, 0.f, 0.f}; s1 = s0; }
#pragma unroll
    for (int d0 = 0; d0 < 4; ++d0) {
        const bf16x8 k0 = *(const bf16x8*)(kb + d0 * 32), k1 = *(const bf16x8*)(kb + 32 * 144 + d0 * 32);
        const bf16x8 qf = *(const bf16x8*)(qb + d0 * 8192);
        s0 = mfma32(k0, qf, s0); s1 = mfma32(k1, qf, s1);
    }
}
DI bf16x8 pack8(const f32x16& p, int s2) { u32x4 w; w.x = pk2(p[8 * s2], p[8 * s2 + 1]); w.y = pk2(p[8 * s2 + 2], p[8 * s2 + 3]); w.z = pk2(p[8 * s2 + 4], p[8 * s2 + 5]); w.w = pk2(p[8 * s2 + 6], p[8 * s2 + 7]); return __builtin_bit_cast(bf16x8, w); }
DI void tile_pv(f32x16 (&o)[2], const f32x16& p0, const f32x16& p1, const unsigned char* lds, int buf, int r, int hh) {
    const unsigned char* vb = lds + NSA_VB + buf * 8704;
#pragma unroll
    for (int half = 0; half < 2; ++half)
#pragma unroll
        for (int s2 = 0; s2 < 2; ++s2) {
            const bf16x8 pf = pack8(half ? p1 : p0, s2);
#pragma unroll
            for (int dh = 0; dh < 2; ++dh) { const unsigned char* vp = vb + (32 * dh + r) * 136 + (32 * half + 16 * s2 + 4 * hh) * 2;
                const u32x2 lo = *(const u32x2*)vp, hi = *(const u32x2*)(vp + 16); u32x4 vw = {lo.x, lo.y, hi.x, hi.y};
                o[dh] = mfma32(__builtin_bit_cast(bf16x8, vw), pf, o[dh]); }
        }
}
constexpr float MINIT = -1e20f;
DI float max3f(float a, float b, float c) { float r; asm("v_max3_f32 %0, %1, %2, %3" : "=v"(r) : "v"(a), "v"(b), "v"(c)); return r; }
DI void online_update(f32x16& s0, f32x16& s1, float& mrun, float& lrun, f32x16 (&o)[2], bool live = true) {
    float mt = max3f(s0[0], s1[0], s0[1]);
#pragma unroll
    for (int i = 2; i < 16; i += 2) mt = max3f(mt, s0[i], s0[i + 1]);
#pragma unroll
    for (int i = 1; i < 15; i += 2) mt = max3f(mt, s1[i], s1[i + 1]);
    mt = max3f(mt, s1[15], s1[15]);
    mt = live ? mt : NEGBIG;
    mt = swap32_max(mt);
    if (__any(mt > mrun)) {
        const float mnew = fmaxf(mrun, mt); const float alpha = __builtin_amdgcn_exp2f(mrun - mnew);
        lrun *= alpha; mrun = mnew;
#pragma unroll
        for (int i = 0; i < 16; ++i) { o[0][i] *= alpha; o[1][i] *= alpha; }
    }
    float ps0 = 0.f, ps1 = 0.f; const float msub = live ? mrun : 1e30f;
#pragma unroll
    for (int i = 0; i < 16; ++i) { s0[i] = __builtin_amdgcn_exp2f(s0[i] - msub); s1[i] = __builtin_amdgcn_exp2f(s1[i] - msub); ps0 += s0[i]; ps1 += s1[i]; }
    lrun += swap32_sum(ps0 + ps1);
}

template <int VAR> DI void nsa_worker(Frame& F) {
    unsigned char* lds = F.lds;
    float* PSUM = (float*)(lds + NSA_PSUM); float* IMP = (float*)(lds + NSA_IMP); unsigned* SEL = (unsigned*)(lds + NSA_SEL); unsigned* UNI = (unsigned*)(lds + NSA_UNI);
    int* ITEM = (int*)(lds + NSA_ITEM); float* BT = (float*)(lds + NSA_BT);
    const bf16_t* PQ = (const bf16_t*)(F.ws + WS_PQ); const bf16_t* PKV = (const bf16_t*)(F.ws + WS_PKV);
    const bf16_t* KC = (const bf16_t*)(F.ws + WS_KC); const bf16_t* VCT = (const bf16_t*)(F.ws + WS_VCT);
    const bf16_t* VST = (const bf16_t*)(F.ws + WS_VST); const bf16_t* VWT = (const bf16_t*)(F.ws + WS_VWT);
    const float* GATES = (const float*)(F.ws + WS_GATES); bf16_t* OB = (bf16_t*)((char*)F.out + DO_OAB) + 1024;
    unsigned* ctr = (unsigned*)(F.ws + WS_CTL) + 64;
    { int t0_ = (int)threadIdx.x; asm volatile("" : "+v"(t0_));
      for (int i = t0_; i < 2048; i += NTHREADS) BT[i] = ((const float*)(F.ws + WS_BIAS))[i] * LOG2E;
      for (int i = t0_; i < 4 * 196; i += NTHREADS) { const int sft = i / 196, w = i - sft * 196; ((float*)(lds + NSA_WED + sft * WED_STRIDE))[w] = (w + sft > 63) ? 0.f : NEGBIG; } }
    int g_tab = -1;
    const int hg = F.wave >> 1, th = F.wave & 1;
    const int myx = (int)((unsigned)__builtin_amdgcn_s_getreg((3 << 11) | 20) & 7u); int qsel = 0;
    for (;;) {
        lds_barrier();
        if (((int)threadIdx.x) == 0) { int it = -1;
            while (qsel < 8) { const int qx = (myx + qsel) & 7; const unsigned v = atomicAdd(ctr + 16 * qx, 1u); if (v < 128u) { it = (int)v * 8 + qx; break; } ++qsel; }
            *ITEM = it; }
        lds_barrier();
        const int item0 = *ITEM; if (item0 < 0) break;
        const int item = ((item0 >> 3) << 3) | (item0 & 7);
        int tidl = threadIdx.x; asm volatile("" : "+v"(tidl));
        const int r = tidl & 31, hh = (tidl >> 5) & 1, tl = 32 * th + r;
        const int qidx = item >> 3, qx_ = item & 7; const int qt = 31 - (qidx >> 2), bg = 8 * (qidx & 3) + qx_, b = bg >> 2, g = bg & 3, t0 = 64 * qt, cur = qt;
        const int hq = 4 * g + hg, t = t0 + tl; const size_t row = (size_t)b * T + t;
        const unsigned char* qr = lds + NSA_Q + tidl * 16;
#pragma unroll
        for (int d0 = 0; d0 < 4; ++d0) *(bf16x8*)(lds + NSA_Q + d0 * 8192 + tidl * 16) = *(const bf16x8*)(PQ + row * 1024 + hq * 64 + 16 * d0 + 8 * hh);
        const float gate_c = GATES[row * 48 + hq * 3], gate_s = GATES[row * 48 + hq * 3 + 1], gate_w = GATES[row * 48 + hq * 3 + 2];
        const float* bt = BT + hq * 128;
        if (g != g_tab) { g_tab = g;
#pragma unroll
            for (int k = 0; k < 8; ++k) { const int c = (tidl >> 8) + 2 * k, w = tidl & 255, rel = 191 - (w + (c & 3));
                ((float*)(lds + NSA_EXT + c * EXT_STRIDE))[w] = (rel < 0) ? NEGBIG : BT[(4 * g + (c >> 2)) * 128 + min(rel, 127)]; } }
        const int yb0 = 191 - tl + 4 * hh;
        const unsigned char* tp0 = lds + NSA_EXT + (hg * 4 + (yb0 & 3)) * EXT_STRIDE + (yb0 & ~3) * 4;
        const unsigned char* tpw = lds + NSA_WED + (yb0 & 3) * WED_STRIDE + ((yb0 - 128) & ~3) * 4;
        f32x16 oacc[2];
#pragma unroll
        for (int i = 0; i < 16; ++i) { oacc[0][i] = 0.f; oacc[1][i] = 0.f; }
        TileRegs tr;
        {
            const bf16_t* Kp = KC + ((size_t)b * 128 * 4 + g) * 64; const bf16_t* Vp = VCT + (size_t)(b * 4 + g) * 64 * 128;
            tile_fetch(tr, Kp, 256, Vp, 128, tidl); tile_commit(tr, lds, 0, tidl);
            tile_fetch(tr, Kp + (size_t)64 * 256, 256, Vp + 64, 128, tidl); tile_commit(tr, lds, 1, tidl);
            lds_barrier();
            tile_fetch(tr, PKV + (size_t)b * T * 1536 + 2 * 256 + g * 64, 1536, VST + (size_t)(b * 4 + g) * 64 * 2048, 2048, tidl);
            f32x16 sc[2][2];
            tile_scores(sc[0][0], sc[0][1], lds, 0, qr, r, hh); __builtin_amdgcn_sched_barrier(0); tile_scores(sc[1][0], sc[1][1], lds, 1, qr, r, hh); __builtin_amdgcn_sched_barrier(0);
            const int nmax = (t >= 31) ? ((t - 31) >> 4) : -1;
            float mx = NEGBIG;
            const int tmin_w = t0 + 32 * th;
#define CMP_MASK(S_, NB_) do { \
                if (16 * (NB_) + 31 > tmin_w + 31) { _Pragma("unroll") for (int i = 0; i < 16; ++i) S_[i] = NEGBIG; }                                     \
                else if (16 * ((NB_) + 31) + 31 + 128 <= tmin_w) { _Pragma("unroll") for (int i = 0; i < 16; ++i) mx = fmaxf(mx, S_[i]); }               \
                else { _Pragma("unroll") for (int i = 0; i < 16; ++i) { const int n = (NB_) + crow(i, hh); const int rel = t - 16 * n - 31; float s = S_[i]; \
                    const float bv = bt[min(max(rel, 0), 127)]; if (n <= nmax) { s += bv; mx = fmaxf(mx, s); } else s = NEGBIG; S_[i] = s; } } \
                __builtin_amdgcn_sched_barrier(0); } while (0)
            CMP_MASK(sc[0][0], 0); CMP_MASK(sc[0][1], 32); CMP_MASK(sc[1][0], 64); CMP_MASK(sc[1][1], 96);
#undef CMP_MASK
            mx = swap32_max(mx);
            float ps = 0.f;
#pragma unroll
            for (int kt = 0; kt < 2; ++kt)
#pragma unroll
                for (int half = 0; half < 2; ++half)
#pragma unroll
                    for (int i = 0; i < 16; ++i) { const float s = sc[kt][half][i]; const float p = (s > -1e29f) ? __builtin_amdgcn_exp2f(s - mx) : 0.f; sc[kt][half][i] = p; ps += p; }
            ps = swap32_sum(ps);
            const float inv = (ps > 0.f) ? 1.f / ps : 0.f;
#pragma unroll
            for (int kt = 0; kt < 2; ++kt)
#pragma unroll
                for (int half = 0; half < 2; ++half)
#pragma unroll
                    for (int i = 0; i < 16; ++i) sc[kt][half][i] *= inv;
            if (cur >= 8) {
#pragma unroll 1
                for (int hgi = 0; hgi < 4; ++hgi) {
                    if (hg == hgi) {
#pragma unroll
                        for (int kt = 0; kt < 2; ++kt)
#pragma unroll
                            for (int half = 0; half < 2; ++half)
                                { float* pb = PSUM + tl * 129 + 64 * kt + 32 * half + 4 * hh; float old[16];
#pragma unroll
                                  for (int i = 0; i < 16; ++i) old[i] = (hgi == 0) ? 0.f : pb[(i & 3) + 8 * (i >> 2)];
#pragma unroll
                                  for (int i = 0; i < 16; ++i) pb[(i & 3) + 8 * (i >> 2)] = old[i] + sc[kt][half][i]; }
                    }
                    lds_barrier();
                }
            }
#pragma unroll
            for (int kt = 0; kt < 2; ++kt)
#pragma unroll
                for (int half = 0; half < 2; ++half)
#pragma unroll
                    for (int i = 0; i < 16; ++i) sc[kt][half][i] *= gate_c;
            tile_pv(oacc, sc[0][0], sc[0][1], lds, 0, r, hh); __builtin_amdgcn_sched_barrier(0); tile_pv(oacc, sc[1][0], sc[1][1], lds, 1, r, hh); __builtin_amdgcn_sched_barrier(0);
            if (cur >= 8) {
#pragma unroll
                for (int i = 0; i < 4; ++i) { const int tok = tidl >> 3, j = (tidl & 7) + 8 * i; const float* pp = PSUM + tok * 129 + 4 * j;
                    float v = pp[0] + pp[1] + pp[2] + 0.5f * pp[3]; if (j > 0) v += 0.5f * pp[-1];
                    IMP[tok * 33 + j] = v; }
                lds_barrier();
                if (F.wave == 0) {
                    const int tok = tidl & 63; float scv[32];
#pragma unroll
                    for (int j = 0; j < 32; ++j) { const bool forced = (j == 0) || (j == cur) || (j == cur - 1); scv[j] = forced ? 1e4f : ((j <= cur) ? IMP[tok * 33 + j] : -1.f); }
                    unsigned msk = 1u | (1u << cur) | (1u << (cur - 1));
#pragma unroll 1
                    for (int k = 0; k < 5; ++k) { float best = -3e38f; int bi = 0;
#pragma unroll
                        for (int j = 0; j < 32; ++j) { const bool tk = ((msk >> j) & 1u) == 0u && scv[j] > best; best = tk ? scv[j] : best; bi = tk ? j : bi; }
                        msk |= 1u << bi; }
                    msk &= (cur >= 31) ? 0xffffffffu : ((1u << (cur + 1)) - 1u);
                    SEL[tok] = msk;
                    unsigned um = msk;
#pragma unroll
                    for (int o = 1; o < 64; o <<= 1) um |= (unsigned)__shfl_xor((int)um, o);
                    if ((tidl & 63) == 0) *UNI = um;
                }
            } else {
                if (tidl < 64) SEL[tidl] = (1u << (cur + 1)) - 1u;
                if (tidl == 0) *UNI = (1u << (cur + 1)) - 1u;
            }
            lds_barrier();
        }
        bf16x8 qreg[4];
#pragma unroll
        for (int d0 = 0; d0 < 4; ++d0) qreg[d0] = *(const bf16x8*)(qr + d0 * 8192);
        {
            const unsigned uni = *UNI, mysel = SEL[tl];
            const bf16_t* Kb = PKV + (size_t)b * T * 1536 + 2 * 256 + g * 64; const bf16_t* Vb = VST + (size_t)(b * 4 + g) * 64 * 2048;
            float mrun = MINIT, lrun = 0.f; f32x16 o[2];
#pragma unroll
            for (int i = 0; i < 16; ++i) { o[0][i] = 0.f; o[1][i] = 0.f; }
            unsigned rem = uni; int j = 0; rem &= rem - 1u; int buf = 0;
            const bf16_t* Kbw = PKV + (size_t)b * T * 1536 + 4 * 256 + g * 64; const bf16_t* Vbw = VWT + (size_t)(b * 4 + g) * 64 * 2048; const int jw0 = (cur >= 8) ? cur - 8 : 0;
            for (;;) {
                tile_commit(tr, lds, buf, tidl);
                lds_barrier();
                const int jn = rem ? __builtin_ctz(rem) : -1; rem &= rem - 1u;
                if (jn >= 0) tile_fetch(tr, Kb + (size_t)64 * jn * 1536, 1536, Vb + 64 * jn, 2048, tidl);
                else tile_fetch(tr, Kbw + (size_t)64 * jw0 * 1536, 1536, Vbw + 64 * jw0, 2048, tidl);
                f32x16 s0, s1;
                const bool selb = (mysel >> j) & 1u;
                if (VAR <= 1) tile_scores_q(s0, s1, lds, buf, qreg, r, hh); else { s0 = o[0]; s1 = o[1]; }
                if (VAR == 0 && j >= cur - 2) add_ext(s0, s1, tp0 - 256 * (cur - j));
                if (VAR == 0) online_update(s0, s1, mrun, lrun, o, selb);
                if (VAR <= 1) tile_pv(o, s0, s1, lds, buf, r, hh);
                if (jn < 0) break;
                j = jn; buf ^= 1;
            }
            const float sc_ = gate_s / lrun;
#pragma unroll
            for (int i = 0; i < 16; ++i) { oacc[0][i] += sc_ * o[0][i]; oacc[1][i] += sc_ * o[1][i]; }
            lds_barrier();
        }
        {
            const bf16_t* Kb = PKV + (size_t)b * T * 1536 + 4 * 256 + g * 64; const bf16_t* Vb = VWT + (size_t)(b * 4 + g) * 64 * 2048;
            float mrun = MINIT, lrun = 0.f; f32x16 o[2];
#pragma unroll
            for (int i = 0; i < 16; ++i) { o[0][i] = 0.f; o[1][i] = 0.f; }
            int j = (cur >= 8) ? cur - 8 : 0, buf = 0;
            for (;;) {
                tile_commit(tr, lds, buf, tidl);
                lds_barrier();
                const int jn = (j < cur) ? j + 1 : -1;
                if (jn >= 0) tile_fetch(tr, Kb + (size_t)64 * jn * 1536, 1536, Vb + 64 * jn, 2048, tidl);
                f32x16 s0, s1;
                if (VAR <= 1) tile_scores_q(s0, s1, lds, buf, qreg, r, hh); else { s0 = o[0]; s1 = o[1]; }
                if (VAR == 0 && (j >= cur - 2 || j == cur - 8)) add_ext(s0, s1, (j >= cur - 2) ? tp0 - 256 * (cur - j) : tpw);
                if (VAR == 0) online_update(s0, s1, mrun, lrun, o);
                if (VAR <= 1) tile_pv(o, s0, s1, lds, buf, r, hh);
                if (jn < 0) break;
                j = jn; buf ^= 1;
            }
            const float sc_ = gate_w / lrun;
#pragma unroll
            for (int i = 0; i < 16; ++i) { oacc[0][i] += sc_ * o[0][i]; oacc[1][i] += sc_ * o[1][i]; }
        }
        bf16_t* op = OB + row * 2048 + hq * 64;
        if (VAR != 0) { if (oacc[0][0] + oacc[1][5] == 123.456f) op[0] = 0; continue; }
#pragma unroll
        for (int dh = 0; dh < 2; ++dh)
#pragma unroll
            for (int gq = 0; gq < 4; ++gq) { u32x2 w; w.x = pk2(oacc[dh][4 * gq], oacc[dh][4 * gq + 1]); w.y = pk2(oacc[dh][4 * gq + 2], oacc[dh][4 * gq + 3]);
                *(u32x2*)(op + 32 * dh + 8 * gq + 4 * hh) = w; }
    }
}


#define XB_TMO      128
#define XB_XCNT(j)  (256  + 64 * (j))
#define XB_XSUB(j)  (1280 + 64 * (j))
#define XB_XGEN(j)  (2304 + 64 * (j))
#define XB_TOP      3328
#define XB_TOPGEN   3392
#define XCD_BAR_WORDS 3456
#define XB_SPIN_CAP (1u << 22)
DI unsigned xb_ld(unsigned* p)              { return __hip_atomic_load(p, __ATOMIC_RELAXED, __HIP_MEMORY_SCOPE_AGENT); }
DI unsigned xb_add(unsigned* p, unsigned v) { return __hip_atomic_fetch_add(p, v, __ATOMIC_RELAXED, __HIP_MEMORY_SCOPE_AGENT); }
DI unsigned xb_xcc_id() { return (unsigned)__builtin_amdgcn_s_getreg((3 << 11) | 20) & 0xFu; }
#define XB_SPIN(cond, bar) do { unsigned _sp = 0; while (cond) { __builtin_amdgcn_s_sleep(1); \
    if ((++_sp & 255u) == 0u) { if (xb_ld(&(bar)[XB_TMO])) break; if (_sp > XB_SPIN_CAP) { atomicAdd(&(bar)[XB_TMO], 1u); break; } } } } while (0)
struct XcdBarrier { unsigned* bar; unsigned x; volatile LAS unsigned* st; };
DI XcdBarrier xcd_barrier_post(unsigned* bar, volatile LAS unsigned* st) {
    XcdBarrier b; b.bar = bar; b.x = xb_xcc_id(); b.st = st;
    if (threadIdx.x == 0) (void)xb_add(&bar[XB_XCNT(b.x)], 1u);
    return b;
}
DI void xcd_barrier_complete(unsigned* bar, unsigned x, unsigned& nloc, unsigned& nx) {
    const unsigned G = gridDim.x * gridDim.y * gridDim.z;
    unsigned sum, cnt, mine, sp = 0u;
    for (;;) {
        sum = 0u; cnt = 0u; mine = 0u;
#pragma unroll
        for (unsigned j = 0; j < 16; ++j) { const unsigned c = xb_ld(&bar[XB_XCNT(j)]); sum += c; cnt += (c > 0u) ? 1u : 0u; mine = (j == x) ? c : mine; }
        if (sum == G) break;
        __builtin_amdgcn_s_sleep(1);
        if ((++sp & 255u) == 0u) { if (xb_ld(&bar[XB_TMO])) break; if (sp > XB_SPIN_CAP) { atomicAdd(&bar[XB_TMO], 1u); break; } }
    }
    nloc = mine > 0u ? mine : 1u; nx = cnt > 0u ? cnt : 1u;
}
DI void xcd_barrier(const XcdBarrier& b) {
    asm volatile("s_waitcnt vmcnt(0)" ::: "memory");
    __syncthreads();
    if (threadIdx.x == 0) {
        unsigned* bar = b.bar;
        __builtin_amdgcn_s_waitcnt(0);
        unsigned nloc = b.st[0], nx = b.st[1];
        if (nloc == 0u) { xcd_barrier_complete(bar, b.x, nloc, nx); b.st[0] = nloc; b.st[1] = nx; }
        const unsigned old = xb_add(&bar[XB_XSUB(b.x)], 1u);
        const unsigned gen = old / nloc;
        if (old + 1u == (gen + 1u) * nloc) {
            __builtin_amdgcn_fence(__ATOMIC_RELEASE, "agent");
            asm volatile("s_waitcnt vmcnt(0)" ::: "memory");
            const unsigned og = xb_add(&bar[XB_TOP], 1u);
            const unsigned tg = og / nx;
            if (og + 1u == (tg + 1u) * nx) xb_add(&bar[XB_TOPGEN], 1u);
            else XB_SPIN(xb_ld(&bar[XB_TOPGEN]) == tg, bar);
            __builtin_amdgcn_fence(__ATOMIC_ACQUIRE, "agent");
            xb_add(&bar[XB_XGEN(b.x)], 1u);
            asm volatile("s_waitcnt vmcnt(0)" ::: "memory");
        } else {
            XB_SPIN(xb_ld(&bar[XB_XGEN(b.x)]) == gen, bar);
            __builtin_amdgcn_fence(__ATOMIC_ACQUIRE, "agent");
            asm volatile("s_waitcnt vmcnt(0)" ::: "memory");
        }
    }
    __syncthreads();
}

constexpr int N_LAUNCHES = MK_N_LAUNCHES, N_PHASES = 9;
constexpr int WGM_C = 4, WGM_F = 4, WGM_G = 4, WGM_H = 4, WGM_I = 4;
__global__ void __launch_bounds__(NTHREADS, 2) hybrid_fwd(Args args) {
    extern __shared__ __attribute__((aligned(16))) unsigned char lds[];
    Frame F;
    F.lds = lds; F.lds3 = (LAS unsigned char*)lds;
    F.tid = threadIdx.x; F.lane = F.tid & 63; F.wave = __builtin_amdgcn_readfirstlane(F.tid >> 6);
    F.G = gridDim.x; F.blk = blockIdx.x; F.gw = F.blk * 8 + F.wave; F.NGW = F.G * 8;
    F.in = args.in; F.out = args.out; F.ws = args.ws;
    volatile LAS unsigned* bst = (volatile LAS unsigned*)(F.lds3 + LDS_BYTES - 16);
    if (F.tid < 2) bst[F.tid] = 0u;
    __syncthreads();
    XcdBarrier bar = xcd_barrier_post((unsigned*)(args.ws + WS_CTL) + 1024, bst);
    const int lo = args.ph_lo, hi = args.ph_hi;
#ifndef PH_MASK
#define PH_MASK 0x1ff
#endif
#ifndef REP_MASK
#define REP_MASK 0
#endif
#define REP(k) ((REP_MASK >> (k)) & 1)
#define IN(k) (((PH_MASK >> (k)) & 1) && lo <= (k) && (k) < hi)
#define SEAM(k) do { if (IN(k) && IN((k) + 1)) { xcd_barrier(bar); } } while (0)
    unsigned char* ws = args.ws;
#ifdef CLKP
    unsigned long long ck0 = 0, rt0 = 0, ck1 = 0, rt1 = 0;
#define CLK0(k) do { if (CLKP == (k)) { ck0 = __builtin_amdgcn_s_memtime(); rt0 = __builtin_amdgcn_s_memrealtime(); } } while (0)
#define CLK1(k) do { if (CLKP == (k)) { ck1 = __builtin_amdgcn_s_memtime(); rt1 = __builtin_amdgcn_s_memrealtime(); } } while (0)
#else
#define CLK0(k)
#define CLK1(k)
#endif
    if (IN(0)) { CLK0(0); phase_a(F, true); if (REP(0)) { __syncthreads(); phase_a(F, false); } CLK1(0); } SEAM(0);
    if (IN(1)) { CLK0(1); phase_b(F); if (REP(1)) { __syncthreads(); phase_b(F); } CLK1(1); } SEAM(1);
    if (IN(2)) { CLK0(2);
        pg8::Gemm g; g.A0 = g.A1 = (const bf16_t*)(ws + WS_H); g.B0 = g.B1 = (const bf16_t*)(ws + WS_WIN); g.K = D;
        pg8::StaticOrder S; S.init(M, NCOLS, F.G, F.blk, 1, WGM_C);
        EpiInProj E{ws};
        pg8::gemm_phase<EpiInProj, true, true>(F.lds3, g, S, E);
        if (REP(2)) { EpiInProjT<(REP_MASK >> 16) & 3> E2{ws}; if (REP_MASK & 0x100000) S.init(M, NCOLS, F.G, F.blk, 1, -1); pg8::gemm_phase<EpiInProjT<(REP_MASK >> 16) & 3>, true, true>(F.lds3, g, S, E2); }
    CLK1(2); } SEAM(2);
    if (IN(3)) { CLK0(3); phase_d<0>(F); if (REP(3)) { __syncthreads(); phase_d<((REP_MASK >> 16) & 3) ? ((REP_MASK >> 16) & 3) : 1, (REP_MASK >> 18) & 3>(F); } CLK1(3); } SEAM(3);
    if (IN(4)) { CLK0(4);
        const int nscan = (F.G >= 256) ? 128 : F.G / 2;
#ifndef NO_SCAN
        if (F.blk < nscan) { for (int hd = F.blk; hd < BATCH * RH; hd += nscan) rwkv_head(F, hd); }
#endif
#ifndef NO_NSA
        nsa_worker<0>(F);
#endif
        if (REP(4)) {
            xcd_barrier(bar); if (F.blk == 0 && F.tid < 8) __hip_atomic_store((unsigned*)(ws + WS_CTL) + 64 + 16 * F.tid, 0u, __ATOMIC_RELAXED, __HIP_MEMORY_SCOPE_AGENT); xcd_barrier(bar);
            if (REP_MASK & 0x1000) { if (F.blk < nscan) { for (int hd = F.blk; hd < BATCH * RH; hd += nscan) rwkv_head(F, hd); } }
            if (REP_MASK & 0x2000) { nsa_worker<(REP_MASK >> 16) & 3>(F); }
        }
    CLK1(4); } SEAM(4);
    if (IN(5)) { CLK0(5);
        pg8::Gemm g; g.A0 = g.A1 = (const bf16_t*)((const char*)args.out + DO_OAB); g.B0 = g.B1 = (const bf16_t*)(ws + WS_WOA); g.K = D;
        pg8::StaticOrder S; S.init(M, D, F.G, F.blk, 1, WGM_F);
        EpiMerge E{(const bf16_t*)(ws + WS_PMG), (bf16_t*)(ws + WS_MIXED)};
        pg8::gemm_phase<EpiMerge, true, true>(F.lds3, g, S, E);
        if (REP(5)) { if ((REP_MASK >> 16) & 3) { EpiInProjT<2> E2{ws}; pg8::gemm_phase<EpiInProjT<2>, true, true>(F.lds3, g, S, E2); } else pg8::gemm_phase<EpiMerge, true, true>(F.lds3, g, S, E); }
    CLK1(5); } SEAM(5);
    if (IN(6)) { CLK0(6);
        pg8::Gemm g; g.A0 = g.A1 = (const bf16_t*)(ws + WS_MIXED); g.B0 = g.B1 = (const bf16_t*)(ws + WS_WOUT); g.K = D;
        pg8::StaticOrder S; S.init(M, D, F.G, F.blk, 1, WGM_G);
        EpiWout E{args.in[0], (const float*)(ws + WS_MOD), (const float*)(ws + WS_M2V), args.out, (bf16_t*)(ws + WS_X1M), (float*)(ws + WS_SUMSQ)};
        pg8::gemm_phase<EpiWout, true, true>(F.lds3, g, S, E);
    CLK1(6); } SEAM(6);
    if (IN(7)) { CLK0(7);
        pg8::Gemm g; g.A0 = g.A1 = (const bf16_t*)(ws + WS_X1M); g.B0 = g.B1 = (const bf16_t*)(ws + WS_WUP); g.K = D;
        pg8::StaticOrder S; S.init(M, DFF, F.G, F.blk, 1, WGM_H);
        EpiUp E{(const float*)(ws + WS_SUMSQ), (const float*)(ws + WS_C2), (bf16_t*)(ws + WS_U)};
        pg8::gemm_phase<EpiUp, true, true>(F.lds3, g, S, E);
        if (REP(7)) pg8::gemm_phase<EpiUp, true, true>(F.lds3, g, S, E);
    CLK1(7); } SEAM(7);
    if (IN(8)) { CLK0(8);
        pg8::Gemm g; g.A0 = g.A1 = (const bf16_t*)(ws + WS_U); g.B0 = g.B1 = (const bf16_t*)(ws + WS_WDOWN); g.K = DFF;
        pg8::StaticOrder S; S.init(M, D, F.G, F.blk, 1, WGM_I);
        EpiDown E{(const float*)(ws + WS_MOD), args.out};
        pg8::gemm_phase<EpiDown, true, true>(F.lds3, g, S, E);
        CLK1(8);
    }
#ifdef CLKP
    if (F.blk == 0) { const float mhz = (float)(ck1 - ck0) * 100.f / (float)(rt1 - rt0); const unsigned long long t = __builtin_amdgcn_s_memrealtime(), dl = (unsigned long long)(mhz * 100.f);
        while (__builtin_amdgcn_s_memrealtime() - t < dl) __builtin_amdgcn_s_sleep(20); }
#endif
#undef IN
#undef SEAM
}

extern "C" void kernel_launch(void* const* d_in, const int* in_sizes, int n_in, void* d_out, int out_size, void* d_ws, size_t ws_size, hipStream_t stream) {
    static int grid = 0;
    if (grid == 0) {
        if (n_in != 32 || in_sizes[0] != M * D || out_size != M * D || ws_size < WS_END) {
            fprintf(stderr, "kernel_launch: unexpected shapes (n_in %d, in0 %d, out %d, ws %zu); nothing launched\n", n_in, n_in > 0 ? in_sizes[0] : -1, out_size, ws_size); grid = -1; return; }
        int dev = 0, cus = 0, per_cu = 0;
        if (hipGetDevice(&dev) != hipSuccess || hipDeviceGetAttribute(&cus, hipDeviceAttributeMultiprocessorCount, dev) != hipSuccess) { grid = -1; return; }
        if (hipFuncSetAttribute((const void*)hybrid_fwd, hipFuncAttributeMaxDynamicSharedMemorySize, LDS_BYTES) != hipSuccess) { fprintf(stderr, "kernel_launch: hipFuncSetAttribute failed\n"); grid = -1; return; }
        if (hipOccupancyMaxActiveBlocksPerMultiprocessor(&per_cu, (const void*)hybrid_fwd, NTHREADS, LDS_BYTES) != hipSuccess || per_cu < 1) { fprintf(stderr, "kernel_launch: occupancy query gives %d blocks per CU; nothing launched\n", per_cu); per_cu = 0; }
        (void)hipGetLastError();
        if (per_cu < 1) { grid = -1; return; }
        grid = cus;
        if (grid > 256) grid = 256;
    }
    if (grid < 0) return;
    if (hipMemsetAsync((char*)d_ws + WS_CTL, 0, CTL_ZERO_BYTES, stream) != hipSuccess) { fprintf(stderr, "kernel_launch: memset failed\n"); return; }
    Args a{};
    for (int i = 0; i < 32; ++i) a.in[i] = (const float*)d_in[i];
    a.out = (float*)d_out; a.ws = (unsigned char*)d_ws;
    if (N_LAUNCHES == 1) {
        a.ph_lo = 0; a.ph_hi = N_PHASES;
        hipLaunchKernelGGL(hybrid_fwd, dim3(grid), dim3(NTHREADS), LDS_BYTES, stream, a);
        const hipError_t e = hipPeekAtLastError();
        if (e != hipSuccess) fprintf(stderr, "kernel_launch: launch failed: %s (grid %d)\n", hipGetErrorString(e), grid);
    } else {
        for (int p = 0; p < N_PHASES; ++p) { a.ph_lo = p; a.ph_hi = p + 1; hipLaunchKernelGGL(hybrid_fwd, dim3(grid), dim3(NTHREADS), LDS_BYTES, stream, a); }
    }
}
```

```cpp
#include <hip/hip_runtime.h>
#include <cstdio>
#include <cstdint>

#ifndef MK_N_LAUNCHES
#define MK_N_LAUNCHES 1
#endif

#define DI __device__ __forceinline__
#define LAS __attribute__((address_space(3)))
typedef unsigned short bf16_t;
typedef short bf16x8 __attribute__((ext_vector_type(8)));
typedef short s16x4 __attribute__((ext_vector_type(4)));
typedef float f32x2 __attribute__((ext_vector_type(2)));
typedef float f32x4 __attribute__((ext_vector_type(4)));
typedef float f32x16 __attribute__((ext_vector_type(16)));
typedef unsigned u32x2 __attribute__((ext_vector_type(2)));
typedef unsigned u32x4 __attribute__((ext_vector_type(4)));
typedef __bf16 bf16x2_t __attribute__((ext_vector_type(2)));

constexpr int D = 2048, BATCH = 8, T = 2048, M = BATCH * T, DFF = 8192;
constexpr int RW = 1024, RH = 16, HD = 64;
constexpr int NCOLS = 10240;
constexpr int IN_COLS = 10064;
constexpr int NC = 127;
constexpr float NORM_EPS = 1e-6f, GN_EPS = 64e-5f;
constexpr float LOG2E = 1.4426950408889634f;

constexpr size_t MiB = 1u << 20;
constexpr size_t WS_CTL = 0, CTL_ZERO_BYTES = 1 * MiB;
constexpr size_t WS_MOD = 64 * 1024;
constexpr size_t WS_SUMSQ = 512 * 1024;
constexpr size_t WS_CPEP = 448 * 1024;
constexpr size_t WS_C2 = 1 * MiB;
constexpr size_t WS_M2V = WS_C2 + 256 * 1024;
constexpr size_t WS_BIAS = WS_M2V + 64 * 1024;
constexpr size_t WS_CPE = WS_BIAS + 8 * 1024;
constexpr size_t WS_W2T = WS_CPE + 1024;
constexpr size_t WS_A2T = WS_W2T + 128 * 1024;
constexpr size_t WS_G2T = WS_A2T + 128 * 1024;
constexpr size_t WS_CW1K = WS_G2T + 320 * 1024;
constexpr size_t WS_CW1V = WS_CW1K + 256 * 1024;
constexpr size_t WS_CW2K = WS_CW1V + 256 * 1024;
constexpr size_t WS_CW2V = WS_CW2K + 8 * 1024;
constexpr size_t WS_KC = WS_CW2V + 8 * 1024;
constexpr size_t WS_VCT = WS_KC + 512 * 1024;
constexpr size_t WS_BSUM = WS_VCT + 512 * 1024;
constexpr size_t WS_GATES = WS_BSUM + 1 * MiB;
static_assert(WS_GATES + 3 * MiB <= 8 * MiB, "small region");
constexpr size_t WS_WOA = 8 * MiB, WS_WOB = 12 * MiB, WS_WOUT = 16 * MiB, WS_WUP = 24 * MiB, WS_WDOWN = 56 * MiB, WS_WIN = 88 * MiB;
constexpr size_t WS_H = 128 * MiB;
constexpr size_t WS_PR = 192 * MiB, WS_PK = 224 * MiB, WS_PV = 256 * MiB, WS_PQ = 288 * MiB, WS_PKV = 320 * MiB, WS_PMG = 368 * MiB, WS_PMISC = 496 * MiB;
constexpr size_t WS_END = 512 * MiB;
constexpr size_t WS_GRW = 88 * MiB, WS_VST = 120 * MiB, WS_VWT = 128 * MiB;
constexpr size_t DO_OAB = 0;
constexpr size_t WS_STASH = 192 * MiB;
constexpr size_t WS_MIXED = 88 * MiB;
constexpr size_t WS_X1M = 368 * MiB;
constexpr size_t WS_U = 88 * MiB;
static_assert(WS_U + (size_t)M * DFF * 2 <= WS_X1M, "u vs x1m");
constexpr size_t DO_AT = 0, DO_BT = 32 * MiB, DO_KT = 64 * MiB, DO_RT = 96 * MiB;
constexpr size_t WS_VM = 136 * MiB, WS_GL = 168 * MiB;

constexpr int LDS_BYTES = 147456;
constexpr int NTHREADS = 512;

DI float bf2f(unsigned v) { return __uint_as_float(v << 16); }
DI unsigned pk2(float lo, float hi) { f32x2 v = {lo, hi}; bf16x2_t b = __builtin_convertvector(v, bf16x2_t); return __builtin_bit_cast(unsigned, b); }
DI unsigned f2bf(float f) { return pk2(f, 0.f) & 0xffffu; }
DI float lo16(unsigned u) { return __uint_as_float(u << 16); }
DI float hi16(unsigned u) { return __uint_as_float(u & 0xffff0000u); }
DI float wave_sum(float v) {
#pragma unroll
    for (int o = 1; o < 64; o <<= 1) v += __shfl_xor(v, o);
    return v;
}
DI void lds_barrier() { asm volatile("s_waitcnt lgkmcnt(0)\n\ts_barrier" ::: "memory"); }
DI float sigmoidf_(float x) { return __builtin_amdgcn_rcpf(1.f + __expf(-x)); }
template <int CTRL> DI float dpp_mov(float v) { return __builtin_bit_cast(float, __builtin_amdgcn_update_dpp(0, __builtin_bit_cast(int, v), CTRL, 0xf, 0xf, true)); }
DI float swap32_sum(float x) { auto r = __builtin_amdgcn_permlane32_swap(__float_as_uint(x), __float_as_uint(x), false, false); return __uint_as_float(r[0]) + __uint_as_float(r[1]); }
DI float swap32_max(float x) { auto r = __builtin_amdgcn_permlane32_swap(__float_as_uint(x), __float_as_uint(x), false, false); return fmaxf(__uint_as_float(r[0]), __uint_as_float(r[1])); }
DI float wave_sum_dpp(float x);
DI float swap16_sum(float x) { auto r = __builtin_amdgcn_permlane16_swap(__float_as_uint(x), __float_as_uint(x), false, false); return __uint_as_float(r[0]) + __uint_as_float(r[1]); }

DI float wave_sum_dpp(float x) {
    x += dpp_mov<0xB1>(x);
    x += dpp_mov<0x4E>(x);
    x += dpp_mov<0x141>(x);
    x += dpp_mov<0x140>(x);
    return swap32_sum(swap16_sum(x));
}

namespace pg8 {
constexpr int BM = 256, BK = 64, HALF = 128, HTB = HALF * BK * 2, STAGE_BYTES = 8 * HTB, NXCD = 8, WGM = 4;
__host__ __device__ __forceinline__ int lds_byte(int r, int c) { const int st = (r >> 4) * 2 + (c >> 5), rr = r & 15, cc = c & 31, ob = rr * 64 + cc * 2; return st * 1024 + (ob ^ (((ob >> 9) & 1) << 5)); }
__host__ __device__ __forceinline__ void stage_rc(int b, int& R, int& C) { const int st = b / 1024, sb = b % 1024, swz = sb ^ (((sb >> 9) & 1) << 5); R = (st >> 1) * 16 + swz / 64; C = (st & 1) * 32 + (swz % 64) / 2; }
__host__ __device__ __forceinline__ int perm32(int rho) { const int n = rho >> 4, i = rho & 15; return 8 * (i >> 2) + 4 * n + (i & 3); }

struct Unit { int pm, pn, z; };
struct Gemm { const bf16_t* A0; const bf16_t* A1; const bf16_t* B0; const bf16_t* B1; int K; };
struct StaticOrder {
    int nM, nN, nwg, G, c, nz, wgm;
    __device__ void init(int M_, int N_, int G_, int c_, int nz_, int wgm_ = WGM) { nM = M_ / BM; nN = N_ / BM; nwg = nM * nN; G = G_; c = c_; nz = nz_; wgm = wgm_; }
    __device__ bool next(int i, Unit& u) const {
        const int ti = i / nz; u.z = i - ti * nz;
        const long L = (long)ti * G + c; if (L >= nwg) return false;
        if (wgm < 0) { u.pm = c & 7; u.pn = 0; return true; }
        int wgid = (int)L; { const int q = nwg / NXCD, r = nwg % NXCD, xcd = wgid % NXCD, off = wgid / NXCD; wgid = (xcd < r ? xcd * (q + 1) : r * (q + 1) + (xcd - r) * q) + off; }
        const int nig = wgm * nN, gid = wgid / nig, fm = gid * wgm, gsz = (nM - fm) < wgm ? (nM - fm) : wgm;
        u.pm = fm + ((wgid % nig) % gsz); u.pn = (wgid % nig) / gsz; return true;
    }
};

template <class Epi, bool ALIGN_EPI, bool SP2>
__device__ __forceinline__ void gemm_phase(LAS unsigned char* lds, const Gemm g, const StaticOrder& S, const Epi& E) {
    const int tid = threadIdx.x, wid = __builtin_amdgcn_readfirstlane(tid >> 6), lane = tid & 63, wr = wid >> 2, wc = wid & 3, fr = lane & 15, fq = lane >> 4;
    const int K = g.K, nt = K / BK;
    unsigned voffA[2], voffB[2];
#pragma unroll
    for (int i = 0; i < 2; ++i) { int R, C; stage_rc(tid * 16 + i * 8192, R, C); const int Rb = Epi::PERM ? ((R & ~31) + perm32(R & 31)) : R;
        voffA[i] = (unsigned)(R * K + C) * 2u; voffB[i] = (unsigned)(Rb * K + C) * 2u; }
    const size_t kstep = (size_t)(BK * 2);
    const size_t hstep = (size_t)HALF * K * 2;
    const size_t tstep = 2 * hstep;
    const unsigned ldsw = (unsigned)wid * 1024u;
    const int aoff = lds_byte(wr * 64 + fr, fq * 8), boff = lds_byte(wc * 32 + fr, fq * 8);
#define PG8_SA(b, h) (((b) * 2 + (h)) * HTB)
#define PG8_SB(b, h) ((4 + (b) * 2 + (h)) * HTB)
#define PG8_STAGE(bufoff, gbase, voff) do { _Pragma("unroll") for (int _i = 0; _i < 2; ++_i) \
        __builtin_amdgcn_global_load_lds((const unsigned*)((const char*)(gbase) + (voff)[_i]), (LAS unsigned*)(lds + (bufoff) + ldsw + _i * 8192), 16, 0, 0); } while (0)
#define PG8_LDA(dst, b, h) do { _Pragma("unroll") for (int m = 0; m < 4; ++m) _Pragma("unroll") for (int k = 0; k < 2; ++k) dst[m][k] = *(const LAS bf16x8*)(lds + PG8_SA(b, h) + aoff + m * 2048 + k * 1024); } while (0)
#define PG8_LDB(dst, b, h) do { _Pragma("unroll") for (int n = 0; n < 2; ++n) _Pragma("unroll") for (int k = 0; k < 2; ++k) dst[n][k] = *(const LAS bf16x8*)(lds + PG8_SB(b, h) + boff + n * 2048 + k * 1024); } while (0)
#define PG8_MMA(ai, bj, At, Bt) do { __builtin_amdgcn_s_setprio(1); _Pragma("unroll") for (int m = 0; m < 4; ++m) _Pragma("unroll") for (int n = 0; n < 2; ++n) _Pragma("unroll") for (int k = 0; k < 2; ++k) \
        acc[ai][bj][m][n] = __builtin_amdgcn_mfma_f32_16x16x32_bf16(Bt[n][k], At[m][k], acc[ai][bj][m][n], 0, 0, 0); __builtin_amdgcn_s_setprio(0); } while (0)
#define PG8_WAIT_V(n) asm volatile("s_waitcnt vmcnt(" #n ")" ::: "memory")
#define PG8_WAIT_L(n) asm volatile("s_waitcnt lgkmcnt(" #n ")" ::: "memory")
#define PG8_BAR __builtin_amdgcn_s_barrier()
#define PG8_SCHED __builtin_amdgcn_sched_barrier(0)
    Unit cur, nxt; int ui = 0;
    if (!S.next(0, cur)) return;
    f32x4 acc[2][2][4][2];
#pragma unroll
    for (int a = 0; a < 2; ++a)
#pragma unroll
        for (int b = 0; b < 2; ++b)
#pragma unroll
            for (int m = 0; m < 4; ++m)
#pragma unroll
                for (int n = 0; n < 2; ++n) acc[a][b][m][n] = (f32x4){0.f, 0.f, 0.f, 0.f};
    bf16x8 At[4][2], B0[2][2], B1[2][2];
    const char* cA = (const char*)(cur.z ? g.A1 : g.A0) + (size_t)cur.pm * tstep; const char* cB = (const char*)(cur.z ? g.B1 : g.B0) + (size_t)cur.pn * tstep;
    if constexpr (SP2) {
        PG8_STAGE(PG8_SB(0, 0), cB, voffB); PG8_STAGE(PG8_SB(0, 1), cB + hstep, voffB); PG8_STAGE(PG8_SA(0, 0), cA, voffA); PG8_STAGE(PG8_SA(0, 1), cA + hstep, voffA);
        if (wr == 1) PG8_BAR;
        PG8_WAIT_V(2); PG8_BAR;
        PG8_STAGE(PG8_SB(1, 0), cB + kstep, voffB); PG8_STAGE(PG8_SA(1, 0), cA + kstep, voffA); PG8_STAGE(PG8_SB(1, 1), cB + hstep + kstep, voffB);
        PG8_WAIT_V(6); PG8_BAR;
    } else {
        PG8_STAGE(PG8_SB(0, 0), cB, voffB); PG8_STAGE(PG8_SA(0, 0), cA, voffA); PG8_STAGE(PG8_SB(0, 1), cB + hstep, voffB); PG8_STAGE(PG8_SA(0, 1), cA + hstep, voffA);
        if (wr == 1) PG8_BAR;
        PG8_WAIT_V(4); PG8_BAR;
        PG8_STAGE(PG8_SB(1, 0), cB + kstep, voffB); PG8_STAGE(PG8_SA(1, 0), cA + kstep, voffA); PG8_STAGE(PG8_SB(1, 1), cB + hstep + kstep, voffB);
        PG8_WAIT_V(6); PG8_BAR;
    }
    for (;;) {
        const bool has_next = S.next(ui + 1, nxt);
        const char* nA = has_next ? (const char*)(nxt.z ? g.A1 : g.A0) + (size_t)nxt.pm * tstep : cA; const char* nB = has_next ? (const char*)(nxt.z ? g.B1 : g.B0) + (size_t)nxt.pn * tstep : cB;
        for (int t = 0; t < nt; t += 2) {
            if constexpr (Epi::MID_T > 0) { if (t == Epi::MID_T) { E.mid(acc, cur, wr, wc, fr, fq); asm volatile("s_waitcnt vmcnt(0)" ::: "memory"); } }
            const bool last = (t == nt - 2);
            const char* a1 = cA + (size_t)(t + 1) * kstep;
            const char* a2 = last ? nA : cA + (size_t)(t + 2) * kstep; const char* b2 = last ? nB : cB + (size_t)(t + 2) * kstep;
            const char* a3 = a2 + kstep; const char* b3 = b2 + kstep;
            if constexpr (SP2) {
            PG8_LDB(B0, 0, 0); PG8_LDB(B1, 0, 1); PG8_SCHED; PG8_LDA(At, 0, 0); PG8_STAGE(PG8_SA(1, 1), a1 + hstep, voffA);
            PG8_WAIT_V(8); PG8_WAIT_L(0); PG8_BAR; PG8_MMA(0, 0, At, B0); PG8_MMA(0, 1, At, B1); PG8_BAR; PG8_SCHED;
            PG8_LDA(At, 0, 1); PG8_STAGE(PG8_SB(0, 0), b2, voffB); PG8_STAGE(PG8_SB(0, 1), b2 + hstep, voffB); PG8_STAGE(PG8_SA(0, 0), a2, voffA);
            PG8_WAIT_V(8); PG8_WAIT_L(0); PG8_BAR; PG8_MMA(1, 0, At, B0); PG8_MMA(1, 1, At, B1); PG8_BAR; PG8_SCHED;
            PG8_LDB(B0, 1, 0); PG8_LDB(B1, 1, 1); PG8_SCHED; PG8_LDA(At, 1, 0); PG8_STAGE(PG8_SA(0, 1), a2 + hstep, voffA);
            PG8_WAIT_V(8); PG8_WAIT_L(0); PG8_BAR; PG8_MMA(0, 0, At, B0); PG8_MMA(0, 1, At, B1); PG8_BAR; PG8_SCHED;
            PG8_LDA(At, 1, 1); PG8_STAGE(PG8_SB(1, 0), b3, voffB); PG8_STAGE(PG8_SB(1, 1), b3 + hstep, voffB); PG8_STAGE(PG8_SA(1, 0), a3, voffA);
            PG8_WAIT_V(8); PG8_WAIT_L(0); PG8_BAR; PG8_MMA(1, 0, At, B0); PG8_MMA(1, 1, At, B1); PG8_BAR; PG8_SCHED;
            } else {
            PG8_LDB(B0, 0, 0); PG8_SCHED; PG8_LDA(At, 0, 0); PG8_STAGE(PG8_SA(1, 1), a1 + hstep, voffA);
            PG8_WAIT_L(8); PG8_BAR; PG8_WAIT_L(0); PG8_MMA(0, 0, At, B0); PG8_BAR; PG8_SCHED;
            PG8_LDB(B1, 0, 1); PG8_STAGE(PG8_SB(0, 0), b2, voffB);
            PG8_BAR; PG8_WAIT_L(0); PG8_MMA(0, 1, At, B1); PG8_BAR;
            PG8_LDA(At, 0, 1); PG8_STAGE(PG8_SA(0, 0), a2, voffA);
            PG8_BAR; PG8_WAIT_L(0); PG8_MMA(1, 0, At, B0); PG8_BAR; PG8_SCHED;
            PG8_STAGE(PG8_SB(0, 1), b2 + hstep, voffB);
            PG8_WAIT_V(6); PG8_BAR; PG8_MMA(1, 1, At, B1); PG8_BAR;
            PG8_LDB(B0, 1, 0); PG8_SCHED; PG8_LDA(At, 1, 0); PG8_STAGE(PG8_SA(0, 1), a2 + hstep, voffA);
            PG8_WAIT_L(8); PG8_BAR; PG8_WAIT_L(0); PG8_MMA(0, 0, At, B0); PG8_BAR; PG8_SCHED;
            PG8_LDB(B1, 1, 1); PG8_STAGE(PG8_SB(1, 0), b3, voffB);
            PG8_BAR; PG8_WAIT_L(0); PG8_MMA(0, 1, At, B1); PG8_BAR;
            PG8_LDA(At, 1, 1); PG8_STAGE(PG8_SA(1, 0), a3, voffA);
            PG8_BAR; PG8_WAIT_L(0); PG8_MMA(1, 0, At, B0); PG8_BAR; PG8_SCHED;
            PG8_STAGE(PG8_SB(1, 1), b3 + hstep, voffB);
            PG8_WAIT_V(6); PG8_BAR; PG8_MMA(1, 1, At, B1); PG8_BAR;
            }
        }
        if constexpr (ALIGN_EPI) { if (wr == 0) PG8_BAR; }
        E(acc, cur, wr, wc, fr, fq);
        if (!has_next) break;
#pragma unroll
        for (int a = 0; a < 2; ++a)
#pragma unroll
            for (int b = 0; b < 2; ++b)
#pragma unroll
                for (int m = 0; m < 4; ++m)
#pragma unroll
                    for (int n = 0; n < 2; ++n) acc[a][b][m][n] = (f32x4){0.f, 0.f, 0.f, 0.f};
        cur = nxt; cA = nA; cB = nB; ++ui;
        if constexpr (ALIGN_EPI) { if (wr == 1) PG8_BAR; }
    }
    PG8_WAIT_V(0);
    if constexpr (!ALIGN_EPI) { if (wr == 0) PG8_BAR; }
    PG8_BAR;
#undef PG8_SA
#undef PG8_SB
#undef PG8_STAGE
#undef PG8_LDA
#undef PG8_LDB
#undef PG8_MMA
#undef PG8_WAIT_V
#undef PG8_WAIT_L
#undef PG8_BAR
#undef PG8_SCHED
}
}
using pg8::Unit; using pg8::HALF; using pg8::BM;
typedef const f32x4 (&AccRef)[2][2][4][2];

template <int MODE> struct EpiInProjT {
    static constexpr bool PERM = true; static constexpr int MID_T = 0;
    unsigned char* ws;
    DI void operator()(AccRef acc, const Unit& u, int wr, int wc, int fr, int fq) const {
        if (MODE == 2) { f32x4 t = {0.f, 0.f, 0.f, 0.f};
#pragma unroll
            for (int ai = 0; ai < 2; ++ai)
#pragma unroll
                for (int bj = 0; bj < 2; ++bj)
#pragma unroll
                    for (int m = 0; m < 4; ++m) { t += acc[ai][bj][m][0]; t += acc[ai][bj][m][1]; }
            if (t[0] + t[1] + t[2] + t[3] == 123.456f) *(float*)ws = 1.f; return; }
        const int pn = u.pn; bf16_t* base; int ld, ct; bool sig = false;
        if (pn < 4) { base = (bf16_t*)(ws + WS_PR); ld = 1024; ct = pn; }
        else if (pn < 8) { base = (bf16_t*)(ws + WS_PK); ld = 1024; ct = pn - 4; }
        else if (pn < 12) { base = (bf16_t*)(ws + WS_PV); ld = 1024; ct = pn - 8; }
        else if (pn < 16) { base = (bf16_t*)(ws + WS_PQ); ld = 1024; ct = pn - 12; }
        else if (pn < 22) { base = (bf16_t*)(ws + WS_PKV); ld = 1536; ct = pn - 16; }
        else if (pn < 38) { base = (bf16_t*)(ws + WS_PMG); ld = 4096; ct = pn - 22; sig = true; }
        else { base = (bf16_t*)(ws + WS_PMISC); ld = 512; ct = pn - 38; }
        const int row0 = u.pm * BM + wr * 64 + fr, col0 = ct * BM + wc * 32 + 8 * fq;
#pragma unroll
        for (int ai = 0; ai < 2; ++ai)
#pragma unroll
            for (int m = 0; m < 4; ++m) { bf16_t* rowp = base + (size_t)(row0 + ai * HALF + m * 16) * ld + col0;
#pragma unroll
                for (int bj = 0; bj < 2; ++bj) { f32x4 v0 = acc[ai][bj][m][0], v1 = acc[ai][bj][m][1];
                    if (sig) {
#pragma unroll
                        for (int e = 0; e < 4; ++e) { v0[e] = sigmoidf_(v0[e]); v1[e] = sigmoidf_(v1[e]); } }
                    u32x4 w; w.x = pk2(v0[0], v0[1]); w.y = pk2(v0[2], v0[3]); w.z = pk2(v1[0], v1[1]); w.w = pk2(v1[2], v1[3]);
                    if (MODE == 0) *(u32x4*)(rowp + bj * HALF) = w; else if (w.x == 0x12345678u && w.w == 0x9abcdef0u) *(u32x4*)(rowp + bj * HALF) = w; } }
    }
};
typedef EpiInProjT<0> EpiInProj;
struct EpiMerge {
    static constexpr bool PERM = true;
    static constexpr int MID_T = 16;
    const bf16_t* mg; bf16_t* mixed;
    DI void mid(f32x4 (&acc)[2][2][4][2], const Unit& u, int wr, int wc, int fr, int fq) const {
        int row0 = u.pm * BM + wr * 64 + fr, col0 = u.pn * BM + wc * 32 + 8 * fq;
        asm volatile("" : "+v"(row0), "+v"(col0));
#pragma unroll
        for (int ai = 0; ai < 2; ++ai)
#pragma unroll
            for (int m = 0; m < 4; ++m) { const size_t row = (size_t)(row0 + ai * HALF + m * 16);
#pragma unroll
                for (int bj = 0; bj < 2; ++bj) { const int col = col0 + bj * HALF;
                    const u32x4 ga = *(const u32x4*)(mg + row * 4096 + col), gb = *(const u32x4*)(mg + row * 4096 + 2048 + col);
#pragma unroll
                    for (int e = 0; e < 4; ++e) { const float s0 = lo16(ga[e]) * __builtin_amdgcn_rcpf(fmaxf(lo16(gb[e]), 1e-20f)), s1 = hi16(ga[e]) * __builtin_amdgcn_rcpf(fmaxf(hi16(gb[e]), 1e-20f));
                        acc[ai][bj][m][e >> 1][2 * (e & 1)] *= s0; acc[ai][bj][m][e >> 1][2 * (e & 1) + 1] *= s1; } }
                __builtin_amdgcn_sched_barrier(0); }
    }
    DI void operator()(AccRef acc, const Unit& u, int wr, int wc, int fr, int fq) const {
        const int row0 = u.pm * BM + wr * 64 + fr, col0 = u.pn * BM + wc * 32 + 8 * fq;
#pragma unroll
        for (int ai = 0; ai < 2; ++ai)
#pragma unroll
            for (int m = 0; m < 4; ++m) { const size_t row = (size_t)(row0 + ai * HALF + m * 16);
#pragma unroll
                for (int bj = 0; bj < 2; ++bj) { const int col = col0 + bj * HALF;
                    const u32x4 gb = *(const u32x4*)(mg + row * 4096 + 2048 + col); u32x4 w;
#pragma unroll
                    for (int e = 0; e < 4; ++e) w[e] = pk2(acc[ai][bj][m][e >> 1][2 * (e & 1)] * fmaxf(lo16(gb[e]), 1e-20f), acc[ai][bj][m][e >> 1][2 * (e & 1) + 1] * fmaxf(hi16(gb[e]), 1e-20f));
                    *(u32x4*)(mixed + row * 2048 + col) = w; } }
    }
};
struct EpiWout {
    static constexpr bool PERM = false; static constexpr int MID_T = 0;
    const float* x; const float* mod; const float* m2v; float* x1; bf16_t* x1m; float* sumsq;
    DI void operator()(AccRef acc, const Unit& u, int wr, int wc, int fr, int fq) const {
        const int row0 = u.pm * BM + wr * 64 + fr, col0 = u.pn * BM + wc * 32 + 4 * fq; const int b = (u.pm * BM) / T;
        const float* gt1 = mod + (size_t)b * 12288 + 4096; const float* mv = m2v + (size_t)b * 2048;
        f32x4 gv[2][2], m2[2][2];
#pragma unroll
        for (int bj = 0; bj < 2; ++bj)
#pragma unroll
            for (int n = 0; n < 2; ++n) { gv[bj][n] = *(const f32x4*)(gt1 + col0 + bj * HALF + n * 16); m2[bj][n] = *(const f32x4*)(mv + col0 + bj * HALF + n * 16); }
        f32x4 xn[2][2];
#pragma unroll
        for (int bj = 0; bj < 2; ++bj)
#pragma unroll
            for (int n = 0; n < 2; ++n) xn[bj][n] = *(const f32x4*)(x + (size_t)row0 * D + col0 + bj * HALF + n * 16);
#pragma unroll
        for (int gi = 0; gi < 8; ++gi) { const int ai = gi >> 2, m = gi & 3; const size_t row = (size_t)(row0 + ai * HALF + m * 16); float ss = 0.f;
            f32x4 xc[2][2];
#pragma unroll
            for (int bj = 0; bj < 2; ++bj)
#pragma unroll
                for (int n = 0; n < 2; ++n) xc[bj][n] = xn[bj][n];
            if (gi < 7) { const size_t rown = (size_t)(row0 + ((gi + 1) >> 2) * HALF + ((gi + 1) & 3) * 16);
#pragma unroll
                for (int bj = 0; bj < 2; ++bj)
#pragma unroll
                    for (int n = 0; n < 2; ++n) xn[bj][n] = *(const f32x4*)(x + rown * D + col0 + bj * HALF + n * 16); }
#pragma unroll
            for (int bj = 0; bj < 2; ++bj)
#pragma unroll
                for (int n = 0; n < 2; ++n) { const int col = col0 + bj * HALF + n * 16;
                    const f32x4 v = xc[bj][n] + gv[bj][n] * acc[ai][bj][m][n];
                    *(f32x4*)(x1 + row * D + col) = v; ss += (v[0] * v[0] + v[1] * v[1]) + (v[2] * v[2] + v[3] * v[3]);
                    const f32x4 vm = v * m2[bj][n]; u32x2 w; w.x = pk2(vm[0], vm[1]); w.y = pk2(vm[2], vm[3]); *(u32x2*)(x1m + row * D + col) = w; }
            ss += __shfl_xor(ss, 16); ss += __shfl_xor(ss, 32);
            if (fq == 0) atomicAdd(sumsq + row, ss);
            __builtin_amdgcn_sched_barrier(0); }
    }
};
struct EpiUp {
    static constexpr bool PERM = true; static constexpr int MID_T = 0;
    const float* sumsq; const float* c2; bf16_t* uo;
    DI void operator()(AccRef acc, const Unit& u, int wr, int wc, int fr, int fq) const {
        const int row0 = u.pm * BM + wr * 64 + fr, col0 = u.pn * BM + wc * 32 + 8 * fq; const int b = (u.pm * BM) / T;
        const float* cb = c2 + (size_t)b * DFF + col0;
        f32x4 cv[2][2];
#pragma unroll
        for (int bj = 0; bj < 2; ++bj)
#pragma unroll
            for (int n = 0; n < 2; ++n) cv[bj][n] = *(const f32x4*)(cb + bj * HALF + 4 * n);
#pragma unroll
        for (int ai = 0; ai < 2; ++ai)
#pragma unroll
            for (int m = 0; m < 4; ++m) { const size_t row = (size_t)(row0 + ai * HALF + m * 16);
                const float rstd = rsqrtf(sumsq[row] * (1.f / D) + NORM_EPS);
#pragma unroll
                for (int bj = 0; bj < 2; ++bj) { f32x4 v0 = acc[ai][bj][m][0] * rstd + cv[bj][0], v1 = acc[ai][bj][m][1] * rstd + cv[bj][1];
#pragma unroll
                    for (int e = 0; e < 4; ++e) { const float a0 = fmaxf(v0[e], 0.f), a1 = fmaxf(v1[e], 0.f); v0[e] = a0 * a0; v1[e] = a1 * a1; }
                    u32x4 w; w.x = pk2(v0[0], v0[1]); w.y = pk2(v0[2], v0[3]); w.z = pk2(v1[0], v1[1]); w.w = pk2(v1[2], v1[3]);
                    *(u32x4*)(uo + row * DFF + col0 + bj * HALF) = w; } }
    }
};
struct EpiDown {
    static constexpr bool PERM = false; static constexpr int MID_T = 0;
    const float* mod; float* out;
    DI void operator()(AccRef acc, const Unit& u, int wr, int wc, int fr, int fq) const {
        const int row0 = u.pm * BM + wr * 64 + fr, col0 = u.pn * BM + wc * 32 + 4 * fq; const int b = (u.pm * BM) / T;
        const float* gt2 = mod + (size_t)b * 12288 + 10240;
        f32x4 gv[2][2];
#pragma unroll
        for (int bj = 0; bj < 2; ++bj)
#pragma unroll
            for (int n = 0; n < 2; ++n) gv[bj][n] = *(const f32x4*)(gt2 + col0 + bj * HALF + n * 16);
        f32x4 xn[2][2];
#pragma unroll
        for (int bj = 0; bj < 2; ++bj)
#pragma unroll
            for (int n = 0; n < 2; ++n) xn[bj][n] = *(const f32x4*)(out + (size_t)row0 * D + col0 + bj * HALF + n * 16);
#pragma unroll
        for (int gi = 0; gi < 8; ++gi) { const int ai = gi >> 2, m = gi & 3; const size_t row = (size_t)(row0 + ai * HALF + m * 16);
            f32x4 xc[2][2];
#pragma unroll
            for (int bj = 0; bj < 2; ++bj)
#pragma unroll
                for (int n = 0; n < 2; ++n) xc[bj][n] = xn[bj][n];
            if (gi < 7) { const size_t rown = (size_t)(row0 + ((gi + 1) >> 2) * HALF + ((gi + 1) & 3) * 16);
#pragma unroll
                for (int bj = 0; bj < 2; ++bj)
#pragma unroll
                    for (int n = 0; n < 2; ++n) xn[bj][n] = *(const f32x4*)(out + rown * D + col0 + bj * HALF + n * 16); }
#pragma unroll
            for (int bj = 0; bj < 2; ++bj)
#pragma unroll
                for (int n = 0; n < 2; ++n) *(f32x4*)(out + row * D + col0 + bj * HALF + n * 16) = xc[bj][n] + gv[bj][n] * acc[ai][bj][m][n];
            __builtin_amdgcn_sched_barrier(0); }
    }
};

struct Args { const float* in[32]; float* out; unsigned char* ws; int ph_lo, ph_hi; };
struct Frame {
    unsigned char* lds; LAS unsigned char* lds3;
    int tid, lane, wave, gw, NGW, G, blk;
    const float* const* in; float* out; unsigned char* ws;
};
#define LDS_WAIT() asm volatile("s_waitcnt lgkmcnt(0)" ::: "memory")

DI int win_map(int n) {
    if (n < 3072) return n;
    if (n < 4096) return 3360 + (n - 3072);
    if (n < 5632) return 4384 + (n - 4096);
    if (n < 9728) return 5968 + (n - 5632);
    if (n < 10016) return 3072 + (n - 9728);
    if (n < 10064) return 5920 + (n - 10016);
    return -1;
}
DI void transpose_item(const float* __restrict__ W, int ldW, int K, bf16_t* __restrict__ WT, int ldT, int k0, int n0, bool wmap, unsigned* scr, int lane) {
    const int n4 = lane & 15, kq = lane >> 4; const int nn = n0 + 4 * n4; const int src = wmap ? win_map(nn) : nn;
    f32x4 v[16];
#pragma unroll
    for (int i = 0; i < 16; ++i) { const int k = k0 + 8 * (i >> 1) + 2 * kq + (i & 1);
        v[i] = (f32x4){0.f, 0.f, 0.f, 0.f}; if (src >= 0 && k < K) v[i] = *(const f32x4*)(W + (size_t)k * ldW + src); }
#pragma unroll
    for (int p = 0; p < 8; ++p)
#pragma unroll
        for (int e = 0; e < 4; ++e) scr[(4 * n4 + e) * 33 + 4 * p + kq] = pk2(v[2 * p][e], v[2 * p + 1][e]);
    LDS_WAIT(); asm volatile("" ::: "memory");
    const int c = lane & 7;
    if (k0 + 8 * c < K) {
#pragma unroll
        for (int j = 0; j < 8; ++j) { const int n = (lane >> 3) + 8 * j; const unsigned* sp = scr + n * 33 + 4 * c;
            *(u32x4*)(WT + (size_t)(n0 + n) * ldT + k0 + 8 * c) = (u32x4){sp[0], sp[1], sp[2], sp[3]}; }
    }
    LDS_WAIT(); asm volatile("" ::: "memory");
}
DI int rel_bucket_dev(int rel) {
    if (rel < 16) return rel;
    const int thr[15] = {19, 21, 24, 27, 31, 35, 40, 46, 52, 59, 67, 77, 87, 99, 113};
    int bkt = 16;
#pragma unroll
    for (int i = 0; i < 15; ++i) bkt += (rel >= thr[i]) ? 1 : 0;
    return bkt;
}
DI void phase_a(Frame& F, bool first) {
    unsigned* scr = (unsigned*)(F.lds + F.wave * 8448);
    float* sc = (float*)(F.lds + 73728);
    const float* c = F.in[1];
    for (int i = F.tid; i < BATCH * D; i += NTHREADS) { const int b = i >> 11, d = i & 2047; const float cv = c[i]; sc[d * 8 + b] = cv / (1.f + __expf(-cv)); }
    __syncthreads();
    if (first && F.blk * 8 < 1536) {
        const float* w_ada = F.in[2]; const float* b_ada = F.in[3]; float* mod = (float*)(F.ws + WS_MOD);
        const int cgi = F.blk % 48, dsg = F.blk / 48, ds = dsg * 8 + F.wave, c0 = 256 * cgi + 4 * F.lane, d0 = 64 * ds;
        f32x4 acc[8];
#pragma unroll
        for (int b = 0; b < 8; ++b) acc[b] = (f32x4){0.f, 0.f, 0.f, 0.f};
#pragma unroll 8
        for (int d = d0; d < d0 + 64; ++d) {
            const f32x4 wv = *(const f32x4*)(w_ada + (size_t)d * 12288 + c0);
            const f32x4 s0 = *(const f32x4*)(sc + d * 8), s1 = *(const f32x4*)(sc + d * 8 + 4);
            acc[0] += s0[0] * wv; acc[1] += s0[1] * wv; acc[2] += s0[2] * wv; acc[3] += s0[3] * wv;
            acc[4] += s1[0] * wv; acc[5] += s1[1] * wv; acc[6] += s1[2] * wv; acc[7] += s1[3] * wv;
        }
        f32x4* red = (f32x4*)F.lds;
#pragma unroll
        for (int b = 0; b < 8; ++b) red[(F.wave * 8 + b) * 64 + F.lane] = acc[b];
        __syncthreads();
        { const int b = F.wave; f32x4 t = (dsg == 0) ? *(const f32x4*)(b_ada + c0) : (f32x4){0.f, 0.f, 0.f, 0.f};
#pragma unroll
          for (int w = 0; w < 8; ++w) t += red[(w * 8 + b) * 64 + F.lane];
#pragma unroll
          for (int e = 0; e < 4; ++e) atomicAdd(mod + (size_t)b * 12288 + c0 + e, t[e]); }
        asm volatile("s_waitcnt vmcnt(0)" ::: "memory");
        if (F.lane == 0) __hip_atomic_fetch_add((unsigned*)(F.ws + WS_CTL) + 528, 1u, __ATOMIC_RELAXED, __HIP_MEMORY_SCOPE_AGENT);
        __syncthreads();
    }
    {
        struct MatD { const float* W; int ldW, K; size_t off; int ldT, nblk, kblk; bool wmap; };
        const MatD mats[13] = {
            {F.in[6], IN_COLS, 2048, WS_WIN, 2048, NCOLS / 64, 32, true},
            {F.in[27], 2048, 1024, WS_WOA, 2048, 32, 16, false},
            {F.in[28], 2048, 1024, WS_WOA + 2048, 2048, 32, 16, false},
            {F.in[29], 2048, 2048, WS_WOUT, 2048, 32, 32, false},
            {F.in[30], 8192, 2048, WS_WUP, 2048, 128, 32, false},
            {F.in[31], 2048, 8192, WS_WDOWN, 8192, 32, 128, false},
            {F.in[9], 1024, 64, WS_W2T, 64, 16, 1, false},
            {F.in[11], 1024, 64, WS_A2T, 64, 16, 1, false},
            {F.in[12], 1024, 160, WS_G2T, 160, 16, 3, false},
            {F.in[19], 64, 2048, WS_CW1K, 2048, 1, 32, false},
            {F.in[22], 64, 2048, WS_CW1V, 2048, 1, 32, false},
            {F.in[20], 64, 64, WS_CW2K, 64, 1, 1, false},
            {F.in[23], 64, 64, WS_CW2V, 64, 1, 1, false}};
        int total = 0;
#pragma unroll
        for (int i = 0; i < 13; ++i) total += mats[i].nblk * mats[i].kblk;
        for (int k = (F.gw < 1536) ? 3 : 0; ; ++k) {
            const int it = (k < 3) ? k * 512 + (F.gw - 1536) : 1536 + (k - 3) * F.NGW + F.gw; if (it >= total) break;
            int r = it, mi = 0;
#pragma unroll
            for (int i = 0; i < 12; ++i) { const int cnt = mats[i].nblk * mats[i].kblk; if (mi == i && r >= cnt) { r -= cnt; mi = i + 1; } }
            const float* W = mats[0].W; int ldW = mats[0].ldW, K = mats[0].K, ldT = mats[0].ldT, nblk = mats[0].nblk; size_t off = mats[0].off; bool wm = mats[0].wmap;
#pragma unroll
            for (int i = 1; i < 13; ++i) if (mi == i) { W = mats[i].W; ldW = mats[i].ldW; K = mats[i].K; ldT = mats[i].ldT; nblk = mats[i].nblk; off = mats[i].off; wm = mats[i].wmap; }
            const int kb = r / nblk, nb = r % nblk;
            transpose_item(W, ldW, K, (bf16_t*)(F.ws + off), ldT, 64 * kb, 64 * nb, wm, scr, F.lane);
        }
    }
    const int gt = F.blk * NTHREADS + F.tid;
    if (gt < 2048) { const int hq = gt >> 7, rel = gt & 127; const float* rb = F.in[26];
        ((float*)(F.ws + WS_BIAS))[gt] = rb[rel_bucket_dev(rel) * 16 + hq] - rb[31 * 16 + hq]; }
    if (gt >= 4096 && gt < 4096 + 2048) { const int i = gt - 4096, b = i >> 8, e = i & 255; ((bf16_t*)(F.ws + WS_KC))[((size_t)(b * 128 + 127)) * 256 + e] = 0; }
    if (gt >= 8192 && gt < 8192 + 2048) { const int i = gt - 8192, b = i >> 8, e = i & 255; ((bf16_t*)(F.ws + WS_VCT))[((size_t)(b * 128 + 127)) * 256 + e] = 0; }
    if (F.gw >= F.NGW - 64) {
        const int j = F.gw - (F.NGW - 64), kv = j >> 5, kc = j & 31; const float* pe = F.in[kv ? 21 : 18] + 64 * kc; const float* w1 = F.in[kv ? 22 : 19] + (size_t)(64 * kc) * 64 + F.lane;
        float a0 = 0.f, a1 = 0.f, a2 = 0.f, a3 = 0.f;
#pragma unroll
        for (int k = 0; k < 64; k += 4) { a0 += pe[k] * w1[(size_t)k * 64]; a1 += pe[k + 1] * w1[(size_t)(k + 1) * 64]; a2 += pe[k + 2] * w1[(size_t)(k + 2) * 64]; a3 += pe[k + 3] * w1[(size_t)(k + 3) * 64]; }
        ((float*)(F.ws + WS_CPEP))[(kv * 32 + kc) * 64 + F.lane] = (a0 + a1) + (a2 + a3);
    }
}

DI void phase_b(Frame& F) {
    const float* mod = (const float*)(F.ws + WS_MOD);
    const float* x = F.in[0]; const float* g1 = F.in[4]; const float* g2 = F.in[5];
    bf16_t* H = (bf16_t*)(F.ws + WS_H);
    if (F.tid < 64) { unsigned* mc = (unsigned*)(F.ws + WS_CTL) + 528; unsigned sp = 0u;
        while ((unsigned)__builtin_amdgcn_readfirstlane((int)__hip_atomic_load(mc, __ATOMIC_RELAXED, __HIP_MEMORY_SCOPE_AGENT)) < 1536u && ++sp < (1u << 22)) __builtin_amdgcn_s_sleep(4);
        __builtin_amdgcn_fence(__ATOMIC_ACQUIRE, "agent"); asm volatile("s_waitcnt vmcnt(0)" ::: "memory"); }
    __syncthreads();
    for (int m0 = F.gw * 8; m0 < M; m0 += F.NGW * 8) {
        const int b = m0 / T; const float* mb = mod + (size_t)b * 12288;
        f32x4 cf[8], sh[8], v[8], vn[8];
#pragma unroll
        for (int j = 0; j < 8; ++j) { const int col = 4 * F.lane + 256 * j; vn[j] = *(const f32x4*)(x + (size_t)m0 * D + col);
            cf[j] = *(const f32x4*)(g1 + col) * (1.f + *(const f32x4*)(mb + 2048 + col)); sh[j] = *(const f32x4*)(mb + col); }
#pragma unroll 1
        for (int k = 0; k < 8; ++k) { const int m = m0 + k;
#pragma unroll
            for (int j = 0; j < 8; ++j) v[j] = vn[j];
            const int mn = (k < 7) ? m + 1 : m;
#pragma unroll
            for (int j = 0; j < 8; ++j) vn[j] = *(const f32x4*)(x + (size_t)mn * D + 4 * F.lane + 256 * j);
            float ss = 0.f;
#pragma unroll
            for (int j = 0; j < 8; ++j) ss += (v[j][0] * v[j][0] + v[j][1] * v[j][1]) + (v[j][2] * v[j][2] + v[j][3] * v[j][3]);
            const float rstd = rsqrtf(wave_sum_dpp(ss) * (1.f / D) + NORM_EPS);
#pragma unroll
            for (int j = 0; j < 8; ++j) { const int col = 4 * F.lane + 256 * j;
                const f32x4 o = (v[j] * rstd) * cf[j] + sh[j];
                u32x2 w; w.x = pk2(o[0], o[1]); w.y = pk2(o[2], o[3]); *(u32x2*)(H + (size_t)m * D + col) = w; }
        }
    }
    for (int i = F.blk * NTHREADS + F.tid; i < BATCH * D; i += F.G * NTHREADS) { const int b = i >> 11, d = i & 2047;
        ((float*)(F.ws + WS_M2V))[i] = g2[d] * (1.f + mod[(size_t)b * 12288 + 8192 + d]); }
}

DI void phase_d_pre(Frame& F) {
    const float* mod = (const float*)(F.ws + WS_MOD);
    float* sh2 = (float*)F.lds;
    float* cpl = (float*)(F.lds + 65536);
    for (int i = F.tid; i < BATCH * D; i += NTHREADS) { const int b = i >> 11, d = i & 2047; sh2[i] = mod[(size_t)b * 12288 + 6144 + d]; }
    if (F.tid < 128) { const float* pp = (const float*)(F.ws + WS_CPEP) + (F.tid >> 6) * 32 * 64 + (F.tid & 63); float a = 0.f;
#pragma unroll
        for (int kc = 0; kc < 32; ++kc) a += pp[kc * 64];
        cpl[F.tid] = a; }
    __syncthreads();
    const bf16_t* wup = (const bf16_t*)(F.ws + WS_WUP); float* c2 = (float*)(F.ws + WS_C2);
    for (int n = F.gw; n < DFF; n += F.NGW) {
        u32x4 wv[4];
#pragma unroll
        for (int j = 0; j < 4; ++j) wv[j] = *(const u32x4*)(wup + (size_t)n * D + 8 * F.lane + 512 * j);
#pragma unroll 1
        for (int b = 0; b < 8; ++b) { float p = 0.f;
#pragma unroll
            for (int j = 0; j < 4; ++j) { const float* s = sh2 + b * 2048 + 8 * F.lane + 512 * j; const f32x4 s0 = *(const f32x4*)s, s1 = *(const f32x4*)(s + 4);
                p += lo16(wv[j].x) * s0[0] + hi16(wv[j].x) * s0[1] + lo16(wv[j].y) * s0[2] + hi16(wv[j].y) * s0[3]
                   + lo16(wv[j].z) * s1[0] + hi16(wv[j].z) * s1[1] + lo16(wv[j].w) * s1[2] + hi16(wv[j].w) * s1[3]; }
            p = wave_sum_dpp(p); if (F.lane == 0) c2[(size_t)b * DFF + n] = p; }
    }
    __syncthreads();
}

DI f32x4 mfma16(bf16x8 a, bf16x8 b, f32x4 c) { return __builtin_amdgcn_mfma_f32_16x16x32_bf16(a, b, c, 0, 0, 0); }
DI f32x16 mfma32(bf16x8 a, bf16x8 b, f32x16 c) { return __builtin_amdgcn_mfma_f32_32x32x16_bf16(a, b, c, 0, 0, 0); }
DI float fast_tanh(float x) { const float xc = fminf(fmaxf(x, -15.f), 15.f); const float t = __expf(2.f * xc); return (t - 1.f) * __builtin_amdgcn_rcpf(t + 1.f); }
DI float gelu_tanh(float x) { const float u = 0.7978845608028654f * (x + 0.044715f * x * x * x); return 0.5f * x * (1.f + fast_tanh(u)); }
DI float softplusf_(float x) { return fmaxf(x, 0.f) + __logf(1.f + __expf(-fabsf(x))); }
DI unsigned short f2h(float f) { return __builtin_bit_cast(unsigned short, (_Float16)f); }
DI float h2f(unsigned short u) { return (float)__builtin_bit_cast(_Float16, u); }

DI void compress_pair(Frame& F, int pair) {
    const int grp = F.wave >> 2, wq = F.wave & 3, it = 2 * pair + grp;
    const int kv = it >> 8, r_ = it & 255, b = r_ >> 5, g = (r_ >> 3) & 3, nb = r_ & 7;
    const int m = F.lane & 15, q = F.lane >> 4, n = 16 * nb + m; const bool nvalid = n < NC;
    const bf16_t* PKV = (const bf16_t*)(F.ws + WS_PKV);
    const bf16_t* xbase = PKV + (size_t)(b * T + 16 * n) * 1536 + kv * 256 + g * 64;
    const bf16_t* w1t = (const bf16_t*)(F.ws + (kv ? WS_CW1V : WS_CW1K));
    const bf16_t* w2t = (const bf16_t*)(F.ws + (kv ? WS_CW2V : WS_CW2K));
    const float* cpe = (const float*)(F.lds + 65536) + kv * 64;
    f32x4* part = (f32x4*)F.lds;
    f32x4 acc[4];
#pragma unroll
    for (int i = 0; i < 4; ++i) acc[i] = (f32x4){0.f, 0.f, 0.f, 0.f};
#pragma unroll 4
    for (int ks = 16 * wq; ks < 16 * wq + 16; ++ks) {
        const int k = 32 * ks + 8 * q, tok = k >> 6, d = k & 63;
        bf16x8 bfr = (bf16x8){0, 0, 0, 0, 0, 0, 0, 0};
        if (nvalid) bfr = *(const bf16x8*)(xbase + (size_t)tok * 1536 + d);
#pragma unroll
        for (int ht = 0; ht < 4; ++ht) { const bf16x8 afr = *(const bf16x8*)(w1t + (size_t)(16 * ht + m) * 2048 + k); acc[ht] = mfma16(afr, bfr, acc[ht]); }
    }
#pragma unroll
    for (int ht = 0; ht < 4; ++ht) part[((grp * 4 + wq) * 4 + ht) * 64 + F.lane] = acc[ht];
    __syncthreads();
    if (wq == 0) {
#pragma unroll
        for (int ht = 0; ht < 4; ++ht) { acc[ht] = (part[((grp * 4 + 0) * 4 + ht) * 64 + F.lane] + part[((grp * 4 + 1) * 4 + ht) * 64 + F.lane]) + (part[((grp * 4 + 2) * 4 + ht) * 64 + F.lane] + part[((grp * 4 + 3) * 4 + ht) * 64 + F.lane]);
            const f32x4 cp = *(const f32x4*)(cpe + 16 * ht + 4 * q);
#pragma unroll
            for (int e = 0; e < 4; ++e) acc[ht][e] = gelu_tanh(acc[ht][e] + cp[e]); }
        f32x4 out[4];
#pragma unroll
        for (int i = 0; i < 4; ++i) out[i] = (f32x4){0.f, 0.f, 0.f, 0.f};
#pragma unroll
        for (int kk2 = 0; kk2 < 2; ++kk2) {
            u32x4 bw; bw.x = pk2(acc[2 * kk2][0], acc[2 * kk2][1]); bw.y = pk2(acc[2 * kk2][2], acc[2 * kk2][3]); bw.z = pk2(acc[2 * kk2 + 1][0], acc[2 * kk2 + 1][1]); bw.w = pk2(acc[2 * kk2 + 1][2], acc[2 * kk2 + 1][3]);
            const bf16x8 bfr = __builtin_bit_cast(bf16x8, bw);
#pragma unroll
            for (int dt = 0; dt < 4; ++dt) { const bf16_t* wp = w2t + (size_t)(16 * dt + m) * 64 + 32 * kk2 + 4 * q;
                const u32x2 lo = *(const u32x2*)wp, hi = *(const u32x2*)(wp + 16); u32x4 aw = {lo.x, lo.y, hi.x, hi.y};
                out[dt] = mfma16(__builtin_bit_cast(bf16x8, aw), bfr, out[dt]); }
        }
        if (kv == 0) {
            float ss = 0.f;
#pragma unroll
            for (int dt = 0; dt < 4; ++dt)
#pragma unroll
                for (int e = 0; e < 4; ++e) ss += out[dt][e] * out[dt][e];
            ss += __shfl_xor(ss, 16); ss += __shfl_xor(ss, 32);
            const float rstd = rsqrtf(ss * (1.f / 64.f) + NORM_EPS); const float* kg = F.in[25];
            if (nvalid) {
                bf16_t* kc = (bf16_t*)(F.ws + WS_KC) + ((size_t)(b * 128 + n) * 4 + g) * 64;
#pragma unroll
                for (int dt = 0; dt < 4; ++dt) { const int d = 16 * dt + 4 * q; const f32x4 gv = *(const f32x4*)(kg + d); const f32x4 o = out[dt] * rstd * gv;
                    u32x2 w; w.x = pk2(o[0], o[1]); w.y = pk2(o[2], o[3]); *(u32x2*)(kc + d) = w; }
            }
        } else if (nvalid) {
            bf16_t* vc = (bf16_t*)(F.ws + WS_VCT) + ((size_t)(b * 128 + n) * 4 + g) * 64;
#pragma unroll
            for (int dt = 0; dt < 4; ++dt) { u32x2 w; w.x = pk2(out[dt][0], out[dt][1]); w.y = pk2(out[dt][2], out[dt][3]); *(u32x2*)(vc + 16 * dt + 4 * q) = w; }
        }
    }
    __syncthreads();
}

template <int N> DI float row_shr(float v) { return __builtin_bit_cast(float, __builtin_amdgcn_update_dpp(0, __builtin_bit_cast(int, v), 0x110 + N, 0xf, 0xf, true)); }
DI float row_bcast15(float v) { return __builtin_bit_cast(float, __builtin_amdgcn_update_dpp(0, __builtin_bit_cast(int, v), 0x150 + 15, 0xf, 0xf, true)); }
template <int DMODE, int SV = 0> DI void phase_d(Frame& F) {
    constexpr bool first = (DMODE == 0);
    if (DMODE == 0) phase_d_pre(F);
    if (DMODE != 3) for (int pr = F.blk; pr < 256; pr += F.G) compress_pair(F, pr);
    const bf16_t* PR = (const bf16_t*)(F.ws + WS_PR); const bf16_t* PK = (const bf16_t*)(F.ws + WS_PK); const bf16_t* PV = (const bf16_t*)(F.ws + WS_PV);
    const bf16_t* PMISC = (const bf16_t*)(F.ws + WS_PMISC);
    bf16_t* PQ = (bf16_t*)(F.ws + WS_PQ); bf16_t* PKV = (bf16_t*)(F.ws + WS_PKV);
    bf16_t* AT = (bf16_t*)((char*)F.out + DO_AT); bf16_t* BT = (bf16_t*)((char*)F.out + DO_BT); bf16_t* KT = (bf16_t*)((char*)F.out + DO_KT); bf16_t* RT = (bf16_t*)((char*)F.out + DO_RT);
    bf16_t* VM = (bf16_t*)(F.ws + WS_VM); float* GL = (float*)(F.ws + WS_GL);
    bf16_t* GRW = (bf16_t*)(F.ws + WS_GRW); float* BSUM = (float*)(F.ws + WS_BSUM); float* GATES = (float*)(F.ws + WS_GATES);
    const bf16_t* W2T = (const bf16_t*)(F.ws + WS_W2T); const bf16_t* A2T = (const bf16_t*)(F.ws + WS_A2T); const bf16_t* G2T = (const bf16_t*)(F.ws + WS_G2T);
    const float* mu = F.in[7]; const float* w0 = F.in[8]; const float* a0 = F.in[10]; const float* k_k = F.in[13]; const float* k_a = F.in[14]; const float* r_k = F.in[15];
    const float* q_g = F.in[24]; const float* k_g = F.in[25];
    bf16_t* XW = (bf16_t*)F.lds; bf16_t* XA = (bf16_t*)(F.lds + 9216); bf16_t* XG = (bf16_t*)(F.lds + 18432); bf16_t* VT = (bf16_t*)(F.lds + 40960);
    const int q = F.lane >> 4, l16 = F.lane & 15;
    for (int tl = F.blk; tl < M / 64; tl += F.G) {
        const int rowbase = tl * 64, b = rowbase / T, t0 = rowbase % T;
        int tidl = threadIdx.x; asm volatile("" : "+v"(tidl));
#pragma unroll 10
        for (int idx = tidl; idx < 64 * 160; idx += NTHREADS) { const int tok = idx / 160, c = 128 + (idx - tok * 160); const size_t row = rowbase + tok;
            const float cur = bf2f(PMISC[row * 512 + c]); const float prev = (t0 + tok > 0) ? bf2f(PMISC[(row - 1) * 512 + c]) : 0.f;
            const float mv = cur + (prev - cur) * mu[3072 + c];
            XG[tok * 168 + c - 128] = (bf16_t)f2bf(sigmoidf_(mv)); }
#pragma unroll 3
        for (int idx = tidl; idx < 64 * 48; idx += NTHREADS) { const int tok = idx / 48, j = idx - tok * 48; const size_t row = rowbase + tok;
            GATES[row * 48 + j] = sigmoidf_(bf2f(PMISC[row * 512 + 288 + j])); }
        __syncthreads();
#pragma unroll 1
        for (int hh = 0; hh < ((DMODE == 2) ? 0 : 2); ++hh) {
            const int head = 2 * F.wave + hh;
            const unsigned rowoff0 = (unsigned)(rowbase + l16) * 1024u + (unsigned)(head * 64 + 4 * q);
            bf16x8 fgn[5];
#pragma unroll
            for (int ks = 0; ks < 5; ++ks) fgn[ks] = *(const bf16x8*)(G2T + (size_t)(head * 64 + l16) * 160 + 32 * ks + 8 * q);
#pragma unroll 1
            for (int ct = 0; ct < 4; ++ct) {
                bf16x8 fg[5];
#pragma unroll
                for (int ks = 0; ks < 5; ++ks) fg[ks] = fgn[ks];
                { const int ctn = (ct < 3) ? ct + 1 : ct;
#pragma unroll
                  for (int ks = 0; ks < 5; ++ks) fgn[ks] = *(const bf16x8*)(G2T + (size_t)(head * 64 + 16 * ctn + l16) * 160 + 32 * ks + 8 * q); }
#pragma unroll
                for (int tt = 0; tt < 4; ++tt) { const int tokl = 16 * tt + l16; f32x4 ag = {0.f, 0.f, 0.f, 0.f};
#pragma unroll
                    for (int ks = 0; ks < 5; ++ks) ag = mfma16(fg[ks], *(const bf16x8*)(XG + tokl * 168 + 32 * ks + 8 * q), ag);
                    u32x2 w; w.x = pk2(ag[0], ag[1]); w.y = pk2(ag[2], ag[3]); *(u32x2*)(GRW + (rowoff0 + (unsigned)(tt * 16384) + (unsigned)(ct * 16))) = w; }
            }
        }
        {
            const int l8 = F.lane & 7, v8 = F.lane >> 3;
            u32x4 kv[8];
#pragma unroll
            for (int it = 0; it < (first ? 8 : 0); ++it) { const int pair = (F.wave * 8 + it) * 8 + v8, tok = pair >> 3, sg = pair & 7, slot = (sg >> 2) ? 4 : 2, g = sg & 3;
                kv[it] = *(const u32x4*)(PKV + (size_t)(rowbase + tok) * 1536 + slot * 256 + g * 64 + 8 * l8); }
#pragma unroll
            for (int it = 0; it < (first ? 8 : 0); ++it) { const int pair = (F.wave * 8 + it) * 8 + v8, tok = pair >> 3, sg = pair & 7, slot = (sg >> 2) ? 4 : 2, g = sg & 3;
                const u32x4 v = kv[it]; f32x4 f0 = {lo16(v.x), hi16(v.x), lo16(v.y), hi16(v.y)}, f1 = {lo16(v.z), hi16(v.z), lo16(v.w), hi16(v.w)};
                float ss = ((f0[0] * f0[0] + f0[1] * f0[1]) + (f0[2] * f0[2] + f0[3] * f0[3])) + ((f1[0] * f1[0] + f1[1] * f1[1]) + (f1[2] * f1[2] + f1[3] * f1[3]));
                ss += dpp_mov<0xB1>(ss); ss += dpp_mov<0x4E>(ss); ss += dpp_mov<0x141>(ss);
                const float rstd = rsqrtf(ss * (1.f / 64.f) + NORM_EPS); const float* kg = k_g + ((slot == 2) ? 64 : 128) + 8 * l8;
                f0 = f0 * rstd * *(const f32x4*)kg; f1 = f1 * rstd * *(const f32x4*)(kg + 4);
                u32x4 w; w.x = pk2(f0[0], f0[1]); w.y = pk2(f0[2], f0[3]); w.z = pk2(f1[0], f1[1]); w.w = pk2(f1[2], f1[3]);
                *(u32x4*)(PKV + (size_t)(rowbase + tok) * 1536 + slot * 256 + g * 64 + 8 * l8) = w; }
        }
        __syncthreads();
    }
}

typedef short s16x4v __attribute__((ext_vector_type(4)));
DI f32x4 mfma16k(s16x4v a, s16x4v b, f32x4 c) { return __builtin_amdgcn_mfma_f32_16x16x16bf16_1k(a, b, c, 0, 0, 0); }
DI s16x4v packbf4(f32x4 v) { u32x2 w = {pk2(v[0], v[1]), pk2(v[2], v[3])}; return __builtin_bit_cast(s16x4v, w); }
DI f32x4 unpackbf4(s16x4v v) { const u32x2 w = __builtin_bit_cast(u32x2, v); return (f32x4){lo16(w.x), hi16(w.x), lo16(w.y), hi16(w.y)}; }
DI s16x4v trread(LAS unsigned char* p) { return __builtin_bit_cast(s16x4v, __builtin_amdgcn_ds_read_tr16_b64_v4i16((LAS s16x4v*)p)); }
constexpr int RC_AT = 0, RC_BT = 9216, RC_KT = 18432, RC_RT = 27648, RC_VV = 36864;
constexpr int RC_MAB = 46080, RC_T = 54272, RC_YO = 46080;
constexpr int RC_MBR = 63488, RC_GY = 71680, RC_GS = 79872, RC_HY = 88064, RC_HS = 96256, RC_S = 104448;
DI f32x4 tile_ch64(const unsigned char* Am, int a0, const unsigned char* Bm, int b0, int c16, int g) {
    f32x4 acc = {0.f, 0.f, 0.f, 0.f};
#pragma unroll
    for (int ks = 0; ks < 2; ++ks) acc = mfma16(*(const bf16x8*)(Am + (a0 + c16) * 144 + (32 * ks + 8 * g) * 2), *(const bf16x8*)(Bm + (b0 + c16) * 144 + (32 * ks + 8 * g) * 2), acc);
    return acc;
}
constexpr int RC_XW = 46080, RC_XA = 55296;
constexpr int RC_RAWR = 64512, RC_RAWK = 73872, RC_RAWV = 83232;
constexpr int RC_RAWX = 120832;
constexpr int RC_SSK = 138512, RC_BSP = 139536, RC_GLV = 140560, RC_BS = 140816, RC_PRM = 141072, RC_CARRY = 143120, RC_MUX = 143760, RC_WLC = 144384, RC_LNW = 144640, RC_LNB = 144896;
DI void rwkv_head(Frame& F, int hd) {
    const int b = hd >> 4, h = hd & 15;
    unsigned char* L = F.lds; LAS unsigned char* L3 = F.lds3;
    const int lane0 = F.lane, w = F.wave;
    const bf16_t* PR = (const bf16_t*)(F.ws + WS_PR); const bf16_t* PK = (const bf16_t*)(F.ws + WS_PK); const bf16_t* PV = (const bf16_t*)(F.ws + WS_PV); const bf16_t* PMISC = (const bf16_t*)(F.ws + WS_PMISC);
    const bf16_t* GRW = (const bf16_t*)(F.ws + WS_GRW);
    bf16_t* OA = (bf16_t*)((char*)F.out + DO_OAB);
    const float* ln_w = F.in[16]; const float* ln_b = F.in[17]; const float* mu = F.in[7];
    float* SSK = (float*)(L + RC_SSK); float* BSP = (float*)(L + RC_BSP); float* GLV = (float*)(L + RC_GLV); float* BS = (float*)(L + RC_BS); float* PRM = (float*)(L + RC_PRM);
    u32x4 pre[5];
    auto fetch = [&](int c, int tid_) { const int srow = tid_ >> 3, sch = tid_ & 7, xrow = tid_ >> 4, xch = tid_ & 15; const size_t row = (size_t)b * T + 64 * c;
        const size_t off = (row + srow) * 1024 + h * 64 + 8 * sch;
        pre[0] = *(const u32x4*)(PR + off); pre[1] = *(const u32x4*)(PK + off); pre[2] = *(const u32x4*)(PV + off);
        pre[3] = *(const u32x4*)(PMISC + (row + xrow) * 512 + 8 * xch); pre[4] = *(const u32x4*)(PMISC + (row + xrow + 32) * 512 + 8 * xch); };
    auto commit = [&](int tid_) { const int srow = tid_ >> 3, sch = tid_ & 7, xrow = tid_ >> 4, xch = tid_ & 15;
        *(u32x4*)(L + RC_RAWR + (srow + 1) * 144 + sch * 16) = pre[0]; *(u32x4*)(L + RC_RAWK + (srow + 1) * 144 + sch * 16) = pre[1]; *(u32x4*)(L + RC_RAWV + (srow + 1) * 144 + sch * 16) = pre[2];
        *(u32x4*)(L + RC_RAWX + (xrow + 1) * 272 + xch * 16) = pre[3]; *(u32x4*)(L + RC_RAWX + (xrow + 33) * 272 + xch * 16) = pre[4];
        if (tid_ < 24) *(u32x4*)(L + RC_RAWR + (tid_ >> 3) * 9360 + (tid_ & 7) * 16) = *(const u32x4*)(L + RC_CARRY + tid_ * 16);
        if (tid_ >= 32 && tid_ < 48) *(u32x4*)(L + RC_RAWX + (tid_ & 15) * 16) = *(const u32x4*)(L + RC_CARRY + 384 + (tid_ & 15) * 16); };
    for (int i = F.tid; i < 8192 / 4; i += NTHREADS) ((unsigned*)(L + RC_S))[i] = 0u;
    if (F.tid < 40) *(u32x4*)(L + RC_CARRY + F.tid * 16) = (u32x4){0u, 0u, 0u, 0u};
    __syncthreads();
    { const float* w0 = F.in[8]; const float* a0 = F.in[10]; const float* k_k = F.in[13]; const float* k_a = F.in[14]; const float* r_k = F.in[15];
      const int arr = F.tid >> 6, ch = h * 64 + (F.tid & 63);
      PRM[F.tid] = (arr < 3) ? mu[arr * 1024 + ch] : (arr == 3) ? w0[ch] : (arr == 4) ? a0[ch] : (arr == 5) ? k_k[ch] : (arr == 6) ? k_a[ch] : r_k[ch]; }
    fetch(0, F.tid); commit(F.tid);
    const int ct = w & 3, th = w >> 2;
    bf16x8 fw[2], fa[2];
    { const bf16_t* W2T = (const bf16_t*)(F.ws + WS_W2T); const bf16_t* A2T = (const bf16_t*)(F.ws + WS_A2T); const int c16 = lane0 & 15, g = lane0 >> 4; const int chr = h * 64 + 16 * ct + c16;
#pragma unroll
      for (int ks = 0; ks < 2; ++ks) { fw[ks] = *(const bf16x8*)(W2T + (size_t)chr * 64 + 32 * ks + 8 * g); fa[ks] = *(const bf16x8*)(A2T + (size_t)chr * 64 + 32 * ks + 8 * g); } }
    __syncthreads();
    const int mytile = (w < 4) ? w : (w - 4);
    if (F.tid < 128) ((float*)(L + RC_MUX))[F.tid] = mu[3072 + F.tid];
    if (F.tid < 64) { ((float*)(L + RC_LNW))[F.tid] = ln_w[h * 64 + F.tid]; ((float*)(L + RC_LNB))[F.tid] = ln_b[h * 64 + F.tid]; }
    asm volatile("" :: "v"(fw[0]), "v"(fw[1]), "v"(fa[0]), "v"(fa[1]));
    __syncthreads();
#pragma unroll 1
    for (int c = 0; c < T / 64; ++c) {
        const int sb_cur = (c & 1) * 8192, sb_nxt = 8192 - sb_cur;
        int lane = lane0; asm volatile("" : "+v"(lane));
        const int c16 = lane & 15, g = lane >> 4;
        int tidl = F.tid; asm volatile("" : "+v"(tidl));
        if (c + 1 < T / 64) fetch(c + 1, tidl);
        u32x4 pgr;
        { int tq = F.tid; asm volatile("" : "+v"(tq)); const size_t row = (size_t)b * T + 64 * c + (tq >> 3); pgr = *(const u32x4*)(GRW + row * 1024 + h * 64 + 8 * (tq & 7)); }
        const f32x4 mxa = *(const f32x4*)(L + RC_MUX + (F.tid & 15) * 32), mxb = *(const f32x4*)(L + RC_MUX + (F.tid & 15) * 32 + 16);
        const float mux[8] = {mxa[0], mxa[1], mxa[2], mxa[3], mxb[0], mxb[1], mxb[2], mxb[3]};
#pragma unroll
        for (int i = 0; i < 2; ++i) { const int idx8 = F.tid + NTHREADS * i, tok = idx8 >> 4, cg = idx8 & 15;
            const u32x4 cu = *(const u32x4*)(L + RC_RAWX + (tok + 1) * 272 + cg * 16), pr = *(const u32x4*)(L + RC_RAWX + tok * 272 + cg * 16); u32x4 o;
#pragma unroll
            for (int e = 0; e < 4; ++e) { const float c0 = lo16(cu[e]), c1 = hi16(cu[e]), p0 = lo16(pr[e]), p1 = hi16(pr[e]);
                float m0 = c0 + (p0 - c0) * mux[2 * e], m1 = c1 + (p1 - c1) * mux[2 * e + 1];
                if (cg < 8) { m0 = fast_tanh(m0); m1 = fast_tanh(m1); }
                o[e] = pk2(m0, m1); }
            *(u32x4*)(L + ((cg < 8) ? (RC_XW + (tok * 72 + cg * 8) * 2) : (RC_XA + (tok * 72 + (cg - 8) * 8) * 2))) = o; }
        {
            const int tok = F.tid >> 3, c8 = F.tid & 7;
            const u32x4 kc = *(const u32x4*)(L + RC_RAWK + (tok + 1) * 144 + c8 * 16), kp = *(const u32x4*)(L + RC_RAWK + tok * 144 + c8 * 16);
            const f32x4 m0 = *(const f32x4*)(PRM + 64 + 8 * c8), m1 = *(const f32x4*)(PRM + 64 + 8 * c8 + 4), q0 = *(const f32x4*)(PRM + 5 * 64 + 8 * c8), q1 = *(const f32x4*)(PRM + 5 * 64 + 8 * c8 + 4);
            float ss = 0.f;
#pragma unroll
            for (int e = 0; e < 4; ++e) { const float c0 = lo16(kc[e]), c1 = hi16(kc[e]), p0 = lo16(kp[e]), p1 = hi16(kp[e]);
                const float mu0 = (e < 2) ? m0[2 * e] : m1[2 * e - 4], mu1 = (e < 2) ? m0[2 * e + 1] : m1[2 * e - 3], kq0 = (e < 2) ? q0[2 * e] : q1[2 * e - 4], kq1 = (e < 2) ? q0[2 * e + 1] : q1[2 * e - 3];
                const float k0 = (c0 + (p0 - c0) * mu0) * kq0, k1 = (c1 + (p1 - c1) * mu1) * kq1; ss += k0 * k0 + k1 * k1; }
            ss += dpp_mov<0xB1>(ss); ss += dpp_mov<0x4E>(ss); ss += dpp_mov<0x141>(ss);
            if (c8 == 0) SSK[tok] = ss; }
        lds_barrier();
        f32x4 axv[2], bxv[2];
        {
            f32x4 inc0 = {0.f, 0.f, 0.f, 0.f}, inc1 = inc0, wl0 = inc0, wl1 = inc0, carry = inc0;
            const float* prm = PRM + 16 * ct + 4 * g;
            const f32x4 w0v = *(const f32x4*)(prm + 3 * 64);
#pragma unroll
            for (int q2 = 0; q2 < 2; ++q2) { const int tt = 2 * th + q2;
                f32x4 aw = {0.f, 0.f, 0.f, 0.f};
#pragma unroll
                for (int ks = 0; ks < 2; ++ks) aw = mfma16(fw[ks], *(const bf16x8*)(L + RC_XW + ((16 * tt + c16) * 72 + 32 * ks + 8 * g) * 2), aw);
                f32x4 ic, wv;
#pragma unroll
                for (int e = 0; e < 4; ++e) { const float wpre = w0v[e] + aw[e]; const float wl = -0.6065306597126334f * __builtin_amdgcn_rcpf(1.f + __expf(-wpre));
                    float x = wl; x += row_shr<1>(x); x += row_shr<2>(x); x += row_shr<4>(x); x += row_shr<8>(x);
                    ic[e] = x + carry[e]; carry[e] += row_bcast15(x); wv[e] = wl; }
                if (q2 == 0) { inc0 = ic; wl0 = wv; } else { inc1 = ic; wl1 = wv; }
            }
            if (th == 0 && c16 == 0) *(f32x4*)(L + RC_WLC + (16 * ct + 4 * g) * 4) = carry;
            lds_barrier();
            if (th == 1) { const f32x4 c0 = *(const f32x4*)(L + RC_WLC + (16 * ct + 4 * g) * 4); inc0 += c0; inc1 += c0; }
            const f32x4 mur = *(const f32x4*)(prm), muk = *(const f32x4*)(prm + 64), muv = *(const f32x4*)(prm + 128);
            const f32x4 a0v = *(const f32x4*)(prm + 4 * 64), kkw = *(const f32x4*)(prm + 5 * 64), kaw = *(const f32x4*)(prm + 6 * 64), rkw = *(const f32x4*)(prm + 7 * 64);
#pragma unroll
            for (int j = 0; j < 2; ++j) {
                const int tok = 32 * th + 16 * j + c16;
                f32x4 aa = {0.f, 0.f, 0.f, 0.f};
#pragma unroll
                for (int ks = 0; ks < 2; ++ks) aa = mfma16(fa[ks], *(const bf16x8*)(L + RC_XA + (tok * 72 + 32 * ks + 8 * g) * 2), aa);
                const f32x4 inc = (j == 0) ? inc0 : inc1, wl4 = (j == 0) ? wl0 : wl1;
                const int ro = ((tok + 1) * 72 + 16 * ct + 4 * g) * 2;
                const u32x2 kc_ = *(const u32x2*)(L + RC_RAWK + ro), kp_ = *(const u32x2*)(L + RC_RAWK + ro - 144), rc_ = *(const u32x2*)(L + RC_RAWR + ro), rp_ = *(const u32x2*)(L + RC_RAWR + ro - 144),
                            vc_ = *(const u32x2*)(L + RC_RAWV + ro), vp_ = *(const u32x2*)(L + RC_RAWV + ro - 144);
                const f32x4 kc4 = {lo16(kc_.x), hi16(kc_.x), lo16(kc_.y), hi16(kc_.y)}, kp4 = {lo16(kp_.x), hi16(kp_.x), lo16(kp_.y), hi16(kp_.y)};
                const f32x4 rc4 = {lo16(rc_.x), hi16(rc_.x), lo16(rc_.y), hi16(rc_.y)}, rp4 = {lo16(rp_.x), hi16(rp_.x), lo16(rp_.y), hi16(rp_.y)};
                const f32x4 vc4 = {lo16(vc_.x), hi16(vc_.x), lo16(vc_.y), hi16(vc_.y)}, vp4 = {lo16(vp_.x), hi16(vp_.x), lo16(vp_.y), hi16(vp_.y)};
                const f32x4 km = kc4 + (kp4 - kc4) * muk, rm = rc4 + (rp4 - rc4) * mur, vm = vc4 + (vp4 - vc4) * muv; f32x4 kt, rt;
                float bs = 0.f;
                const float inv = __builtin_amdgcn_rsqf(fmaxf(SSK[tok], 1e-24f));
#pragma unroll
                for (int e = 0; e < 4; ++e) {
                    const float ei = __expf(inc[e]), eiv = __builtin_amdgcn_rcpf(ei);
                    const float a = __builtin_amdgcn_rcpf(1.f + __expf(-(a0v[e] + aa[e])));
                    const float kk = km[e] * kkw[e] * inv;
                    axv[j][e] = -kk * (ei * __expf(-wl4[e])); bxv[j][e] = kk * a * eiv;
                    const float kpn = km[e] * (1.f + (a - 1.f) * kaw[e]);
                    bs += rm[e] * kpn * rkw[e];
                    kt[e] = kpn * eiv; rt[e] = rm[e] * ei;
                    if (th == 1 && j == 1 && c16 == 15) GLV[16 * ct + 4 * g + e] = ei;
                }
                bs = swap32_sum(swap16_sum(bs));
                if (g == 0) BSP[ct * 64 + tok] = bs;
                { const int o = (tok * 72 + 16 * ct + 4 * g) * 2;
                  *(s16x4v*)(L + RC_AT + o) = packbf4(axv[j]); *(s16x4v*)(L + RC_BT + o) = packbf4(bxv[j]);
                  *(s16x4v*)(L + RC_KT + o) = packbf4(kt); *(s16x4v*)(L + RC_RT + o) = packbf4(rt); *(s16x4v*)(L + RC_VV + o) = packbf4(vm); }
            }
        }
        lds_barrier();
        if (F.tid < 64) BS[F.tid] = (BSP[F.tid] + BSP[64 + F.tid]) + (BSP[128 + F.tid] + BSP[192 + F.tid]);
        if (F.tid >= 64 && F.tid < 88) { const int i = F.tid - 64, arr = i >> 3, pc = i & 7; *(u32x4*)(L + RC_CARRY + i * 16) = *(const u32x4*)(L + RC_RAWR + arr * 9360 + 64 * 144 + pc * 16); }
        if (F.tid >= 96 && F.tid < 112) { const int pc = F.tid - 96; *(u32x4*)(L + RC_CARRY + 384 + pc * 16) = *(const u32x4*)(L + RC_RAWX + 64 * 272 + pc * 16); }
        f32x4 glv;
#pragma unroll
        for (int cb = 0; cb < 4; ++cb) glv[cb] = GLV[16 * cb + c16];
        f32x4 Nq, NTq;
        {
            auto other_tile = [&](int idx) {
                int sb, tb; bool isbr;
                if (idx < 6) { isbr = false; sb = (int)((0x211000u >> (4 * idx)) & 0xfu); tb = (int)((0x332321u >> (4 * idx)) & 0xfu); }
                else { isbr = true; const int k = idx - 6; sb = (int)((0x3221110000ull >> (4 * k)) & 0xfull); tb = (int)((0x3323213210ull >> (4 * k)) & 0xfull); }
                f32x4 acc = tile_ch64(L + RC_BT, 16 * sb, L + (isbr ? RC_RT : RC_AT), 16 * tb, c16, g);
                if (isbr && sb == tb) {
#pragma unroll
                    for (int e = 0; e < 4; ++e) if (4 * g + e > c16) acc[e] = 0.f;
                }
                *(s16x4v*)(L + (isbr ? RC_MBR : RC_MAB) + (sb * 4 + tb) * 512 + lane * 8) = packbf4(acc);
            };
            if (w < 4) {
                Nq = tile_ch64(L + RC_BT, 16 * w, L + RC_AT, 16 * w, c16, g);
                NTq = tile_ch64(L + RC_AT, 16 * w, L + RC_BT, 16 * w, c16, g);
#pragma unroll
                for (int e = 0; e < 4; ++e) { if (4 * g + e >= c16) Nq[e] = 0.f; if (c16 >= 4 * g + e) NTq[e] = 0.f; }
#pragma unroll
                for (int k = 0; k < 4; ++k) other_tile(4 * w + k);
            }
        }
        f32x4 maktT[4], mkr[4];
        if (w < 4) {
            const f32x4 zero = {0.f, 0.f, 0.f, 0.f};
            f32x4 Id;
#pragma unroll
            for (int e = 0; e < 4; ++e) Id[e] = (4 * g + e == c16) ? 1.f : 0.f;
            const s16x4v nb = packbf4(Nq), ntb = packbf4(NTq);
            const f32x4 N2 = mfma16k(ntb, nb, zero), N2T = mfma16k(nb, ntb, zero);
            const s16x4v n2b = packbf4(N2), n2tb = packbf4(N2T);
            const f32x4 N4 = mfma16k(n2tb, n2b, zero), N4T = mfma16k(n2b, n2tb, zero);
            const s16x4v n4b = packbf4(N4), n4tb = packbf4(N4T);
            const s16x4v n8b = packbf4(mfma16k(n4tb, n4b, zero));
            const f32x4 T1 = Id + Nq, T1T = Id + NTq; const s16x4v t1tb = packbf4(T1T);
            const f32x4 T2 = mfma16k(t1tb, n2b, T1), T2T = mfma16k(n2b, t1tb, T1T); const s16x4v t2tb = packbf4(T2T);
            const f32x4 T3 = mfma16k(t2tb, n4b, T2), T3T = mfma16k(n4b, t2tb, T2T);
            const f32x4 T4 = mfma16k(packbf4(T3T), n8b, T3);
            *(s16x4v*)(L + RC_T + w * 512 + lane * 8) = packbf4(T4);
#pragma unroll
            for (int q = 0; q < 4; ++q) { maktT[q] = zero; mkr[q] = zero; }
        } else {
            const int st = w - 4;
#pragma unroll
            for (int tb = 0; tb < 4; ++tb) {
                f32x4 a1 = {0.f, 0.f, 0.f, 0.f}, a2 = a1;
                if (tb >= st) {
                    a1 = tile_ch64(L + RC_AT, 16 * tb, L + RC_KT, 16 * st, c16, g);
                    a2 = tile_ch64(L + RC_KT, 16 * st, L + RC_RT, 16 * tb, c16, g);
                    if (tb == st) {
#pragma unroll
                        for (int e = 0; e < 4; ++e) { if (c16 >= 4 * g + e) a1[e] = 0.f; if (4 * g + e > c16) a2[e] = 0.f; }
                    }
                }
                maktT[tb] = a1; mkr[tb] = a2;
            }
        }
        lds_barrier();
        s16x4v xb[4];
        {
            s16x4v mabi[6], ti[4], yi[4];
            mabi[0] = *(const s16x4v*)(L + RC_MAB + (0 * 4 + 1) * 512 + lane * 8); mabi[1] = *(const s16x4v*)(L + RC_MAB + (0 * 4 + 2) * 512 + lane * 8); mabi[2] = *(const s16x4v*)(L + RC_MAB + (1 * 4 + 2) * 512 + lane * 8);
            mabi[3] = *(const s16x4v*)(L + RC_MAB + (0 * 4 + 3) * 512 + lane * 8); mabi[4] = *(const s16x4v*)(L + RC_MAB + (1 * 4 + 3) * 512 + lane * 8); mabi[5] = *(const s16x4v*)(L + RC_MAB + (2 * 4 + 3) * 512 + lane * 8);
#pragma unroll
            for (int q = 0; q < 4; ++q) { ti[q] = *(const s16x4v*)(L + RC_T + q * 512 + lane * 8);
                if (w < 4) yi[q] = trread(L3 + RC_AT + (16 * q + 4 * g + ((lane >> 2) & 3)) * 144 + (16 * w) * 2 + 8 * (lane & 3)); }
            __builtin_amdgcn_sched_barrier(0);
#pragma unroll
            for (int q = 0; q < 4; ++q) {
                f32x4 y = (w < 4) ? unpackbf4(yi[q]) : maktT[q];
#pragma unroll
                for (int p = 0; p < 4; ++p) if (p < q) y = mfma16k(mabi[(q == 1) ? 0 : (q == 2) ? (1 + p) : (3 + p)], xb[p], y);
                const f32x4 xq = mfma16k(ti[q], packbf4(y), (f32x4){0.f, 0.f, 0.f, 0.f});
                xb[q] = packbf4(xq);
            }
        }
        {
            s16x4v mbri[10]; u32x2 rvi[4];
#pragma unroll
            for (int tb = 0; tb < 4; ++tb) {
#pragma unroll
                for (int sb = 0; sb < 4; ++sb) if (sb <= tb) mbri[tb * (tb + 1) / 2 + sb] = *(const s16x4v*)(L + RC_MBR + (sb * 4 + tb) * 512 + lane * 8);
                if (w < 4) rvi[tb] = *(const u32x2*)(L + RC_RT + (16 * tb + c16) * 144 + (16 * w + 4 * g) * 2); }
            __builtin_amdgcn_sched_barrier(0);
#pragma unroll
            for (int tb = 0; tb < 4; ++tb) {
                f32x4 acc;
                if (w < 4) acc = (f32x4){lo16(rvi[tb].x), hi16(rvi[tb].x), lo16(rvi[tb].y), hi16(rvi[tb].y)};
                else acc = mkr[tb];
#pragma unroll
                for (int sb = 0; sb < 4; ++sb) if (sb <= tb) acc = mfma16k(xb[sb], mbri[tb * (tb + 1) / 2 + sb], acc);
                *(s16x4v*)(L + ((w < 4) ? RC_GY : RC_HY) + (mytile * 4 + tb) * 512 + lane * 8) = packbf4(acc);
            }
        }
#pragma unroll
        for (int ch2 = 0; ch2 < 2; ++ch2) {
            s16x4v bti[8], kti[2];
#pragma unroll
            for (int c1 = 0; c1 < 2; ++c1) { const int cb = 2 * ch2 + c1;
#pragma unroll
                for (int tb = 0; tb < 4; ++tb) bti[c1 * 4 + tb] = trread(L3 + RC_BT + (16 * tb + 4 * g + ((lane >> 2) & 3)) * 144 + (16 * cb) * 2 + 8 * (lane & 3));
                if (w >= 4) kti[c1] = trread(L3 + RC_KT + (16 * (w - 4) + 4 * g + ((lane >> 2) & 3)) * 144 + (16 * cb) * 2 + 8 * (lane & 3)); }
            __builtin_amdgcn_sched_barrier(0);
#pragma unroll
            for (int c1 = 0; c1 < 2; ++c1) { const int cb = 2 * ch2 + c1;
                f32x4 acc = {0.f, 0.f, 0.f, 0.f};
#pragma unroll
                for (int tb = 0; tb < 4; ++tb) acc = mfma16k(xb[tb], bti[c1 * 4 + tb], acc);
                if (w < 4) {
#pragma unroll
                    for (int e = 0; e < 4; ++e) if (16 * w + 4 * g + e == 16 * cb + c16) acc[e] += 1.f;
                } else acc += unpackbf4(kti[c1]);
                acc = acc * glv[cb];
                *(s16x4v*)(L + ((w < 4) ? RC_GS : RC_HS) + (mytile * 4 + cb) * 512 + lane * 8) = packbf4(acc);
            }
            __builtin_amdgcn_sched_barrier(0);
        }
        lds_barrier();
        {
            const int ib = w & 3, hf = w >> 2;
            s16x4v simg[4], vtr[4];
#pragma unroll
            for (int k = 0; k < 4; ++k) { simg[k] = *(const s16x4v*)(L + RC_S + sb_cur + (k * 4 + ib) * 512 + lane * 8);
                vtr[k] = trread(L3 + RC_VV + (16 * k + 4 * g + ((lane >> 2) & 3)) * 144 + (16 * ib) * 2 + 8 * (lane & 3)); }
#pragma unroll
            for (int j = 0; j < 2; ++j) {
                const int tb = 2 * hf + j, cb = 2 * hf + j;
                f32x4 y = {0.f, 0.f, 0.f, 0.f}, sn = y;
                { s16x4v gyi[4], hyi[4];
#pragma unroll
                  for (int k = 0; k < 4; ++k) { gyi[k] = *(const s16x4v*)(L + RC_GY + (k * 4 + tb) * 512 + lane * 8); hyi[k] = *(const s16x4v*)(L + RC_HY + (k * 4 + tb) * 512 + lane * 8); }
                  __builtin_amdgcn_sched_barrier(0);
#pragma unroll
                  for (int k = 0; k < 4; ++k) y = mfma16k(simg[k], gyi[k], y);
#pragma unroll
                  for (int k = 0; k < 4; ++k) if (k <= tb) y = mfma16k(vtr[k], hyi[k], y); }
                { s16x4v gsi[4], hsi[4];
#pragma unroll
                  for (int k = 0; k < 4; ++k) { gsi[k] = *(const s16x4v*)(L + RC_GS + (k * 4 + cb) * 512 + lane * 8); hsi[k] = *(const s16x4v*)(L + RC_HS + (k * 4 + cb) * 512 + lane * 8); }
                  __builtin_amdgcn_sched_barrier(0);
#pragma unroll
                  for (int k = 0; k < 4; ++k) sn = mfma16k(gsi[k], simg[k], sn);
#pragma unroll
                  for (int k = 0; k < 4; ++k) sn = mfma16k(hsi[k], vtr[k], sn); }
                *(f32x4*)(L + RC_YO + ((16 * tb + c16) * 68 + 16 * ib + 4 * g) * 4) = y;
                *(s16x4v*)(L + RC_S + sb_nxt + (cb * 4 + ib) * 512 + lane * 8) = packbf4(sn);
            }
        }
        lds_barrier();
        if (c + 1 < T / 64) commit(tidl);
        {
            int tq = F.tid; asm volatile("" : "+v"(tq));
            const int tok = tq >> 3, oc = tq & 7;
            const f32x4 y0 = *(const f32x4*)(L + RC_YO + (tok * 68 + 8 * oc) * 4), y1 = *(const f32x4*)(L + RC_YO + (tok * 68 + 8 * oc + 4) * 4);
            float sm = ((y0[0] + y0[1]) + (y0[2] + y0[3])) + ((y1[0] + y1[1]) + (y1[2] + y1[3]));
            sm += dpp_mov<0xB1>(sm); sm += dpp_mov<0x4E>(sm); sm += dpp_mov<0x141>(sm);
            const float mean = sm * (1.f / 64.f);
            const f32x4 d0 = y0 - mean, d1 = y1 - mean;
            float sq = ((d0[0] * d0[0] + d0[1] * d0[1]) + (d0[2] * d0[2] + d0[3] * d0[3])) + ((d1[0] * d1[0] + d1[1] * d1[1]) + (d1[2] * d1[2] + d1[3] * d1[3]));
            sq += dpp_mov<0xB1>(sq); sq += dpp_mov<0x4E>(sq); sq += dpp_mov<0x141>(sq);
            const float rs = rsqrtf(sq * (1.f / 64.f) + GN_EPS), bs = BS[tok];
            const f32x4 lw0 = *(const f32x4*)(L + RC_LNW + 32 * oc), lw1 = *(const f32x4*)(L + RC_LNW + 32 * oc + 16), lb0 = *(const f32x4*)(L + RC_LNB + 32 * oc), lb1 = *(const f32x4*)(L + RC_LNB + 32 * oc + 16);
            const u32x4 vv = *(const u32x4*)(L + RC_VV + (tok * 72 + 8 * oc) * 2);
            u32x4 ow;
#pragma unroll
            for (int e = 0; e < 4; ++e) { const float da = (e < 2) ? d0[2 * e] : d1[2 * e - 4], db = (e < 2) ? d0[2 * e + 1] : d1[2 * e - 3];
                const float wa = (e < 2) ? lw0[2 * e] : lw1[2 * e - 4], wb = (e < 2) ? lw0[2 * e + 1] : lw1[2 * e - 3], ba = (e < 2) ? lb0[2 * e] : lb1[2 * e - 4], bb = (e < 2) ? lb0[2 * e + 1] : lb1[2 * e - 3];
                const float oa = ((da * rs) * wa + ba + bs * lo16(vv[e])) * lo16(pgr[e]), ob = ((db * rs) * wb + bb + bs * hi16(vv[e])) * hi16(pgr[e]);
                ow[e] = pk2(oa, ob); }
            *(u32x4*)(OA + ((size_t)b * T + 64 * c + tok) * 2048 + h * 64 + 8 * oc) = ow;
        }
        lds_barrier();
    }
}

DI int crow(int reg, int hh) { return (reg & 3) + 8 * (reg >> 2) + 4 * hh; }
constexpr int NSA_KB = 0, NSA_VB = 18432, NSA_PSUM = 36864, NSA_IMP = 70656, NSA_SEL = 79360, NSA_UNI = 79616, NSA_ITEM = 79620, NSA_BT = 79872, NSA_Q = 90112;
constexpr float NEGBIG = -1e30f;
constexpr int NSA_EXT = 122880, EXT_STRIDE = 1040, NSA_WED = NSA_EXT + 16 * EXT_STRIDE, WED_STRIDE = 784, NSA_QG = NSA_WED + 4 * WED_STRIDE, NSA_END = NSA_QG + 256;
static_assert(NSA_END <= LDS_BYTES - 16, "NSA tables overflow the LDS");
DI void add_ext(f32x16& s0, f32x16& s1, const unsigned char* tp) {
    f32x4 a[4], b[4];
#pragma unroll
    for (int q = 0; q < 4; ++q) { a[q] = *(const f32x4*)(tp + 32 * q); b[q] = *(const f32x4*)(tp + 128 + 32 * q); }
#pragma unroll
    for (int q = 0; q < 4; ++q)
#pragma unroll
        for (int e = 0; e < 4; ++e) { float x = s0[4 * q + e], y = s1[4 * q + e];
            asm("v_add_f32 %0, %0, %1" : "+v"(x) : "v"(a[q][e])); asm("v_add_f32 %0, %0, %1" : "+v"(y) : "v"(b[q][e]));
            s0[4 * q + e] = x; s1[4 * q + e] = y; }
}
struct TileRegs { u32x4 k, v; };
DI void tile_fetch(TileRegs& r, const bf16_t* Kp, size_t kstride, const bf16_t* Vp, size_t vstride, int tid) {
    const int row = tid >> 3, ch = tid & 7;
    r.k = *(const u32x4*)(Kp + (size_t)row * kstride + ch * 8);
    r.v = *(const u32x4*)(Vp + (size_t)row * vstride + ch * 8);
}
DI void tile_commit(const TileRegs& r, unsigned char* lds, int buf, int tid) {
    const int row = tid >> 3, ch = tid & 7;
    *(u32x4*)(lds + NSA_KB + buf * 9216 + row * 144 + ch * 16) = r.k;
    *(u32x4*)(lds + NSA_VB + buf * 9216 + row * 144 + ch * 16) = r.v;
}
DI void tile_scores_q(f32x16& s0, f32x16& s1, const unsigned char* lds, int buf, const bf16x8 (&qf)[4], int r, int hh) {
    const unsigned char* kb = lds + NSA_KB + buf * 9216 + r * 144 + hh * 16;
    s0 = (f32x16){0.f, 0.f, 0.f, 0.f, 0.f, 0.f, 0.f, 0.f, 0.f, 0.f, 0.f, 0.f, 0.f, 0.f, 0.f, 0.f}; s1 = s0;
#pragma unroll
    for (int d0 = 0; d0 < 4; ++d0) {
        const bf16x8 k0 = *(const bf16x8*)(kb + d0 * 32), k1 = *(const bf16x8*)(kb + 32 * 144 + d0 * 32);
        s0 = mfma32(k0, qf[d0], s0); s1 = mfma32(k1, qf[d0], s1);
    }
}
DI void tile_scores(f32x16& s0, f32x16& s1, const unsigned char* lds, int buf, const unsigned char* qb, int r, int hh, const unsigned char* row = nullptr) {
    const unsigned char* kb = lds + NSA_KB + buf * 9216 + r * 144 + hh * 16;
    if (row) {
#pragma unroll
        for (int q = 0; q < 4; ++q) { const f32x4 a = *(const f32x4*)(row + 32 * q), b = *(const f32x4*)(row + 128 + 32 * q);
#pragma unroll
            for (int e = 0; e < 4; ++e) { s0[4 * q + e] = a[e]; s1[4 * q + e] = b[e]; } }
    } else { s0 = (f32x16){0.f, 0.f, 0.f, 0.f, 0.f, 0.f, 0.f, 0.f, 0.f, 0.f, 0.f, 0.f, 0.f, 0.f, 0.f, 0.f}; s1 = s0; }
#pragma unroll
    for (int d0 = 0; d0 < 4; ++d0) {
        const bf16x8 k0 = *(const bf16x8*)(kb + d0 * 32), k1 = *(const bf16x8*)(kb + 32 * 144 + d0 * 32);
        const bf16x8 qf = *(const bf16x8*)(qb + d0 * 8192);
        s0 = mfma32(k0, qf, s0); s1 = mfma32(k1, qf, s1);
    }
}
DI bf16x8 pack8(const f32x16& p, int s2) { u32x4 w; w.x = pk2(p[8 * s2], p[8 * s2 + 1]); w.y = pk2(p[8 * s2 + 2], p[8 * s2 + 3]); w.z = pk2(p[8 * s2 + 4], p[8 * s2 + 5]); w.w = pk2(p[8 * s2 + 6], p[8 * s2 + 7]); return __builtin_bit_cast(bf16x8, w); }
DI void tile_pv(f32x16 (&o)[2], const f32x16& p0, const f32x16& p1, const unsigned char* lds, int buf, int r, int hh) {
    LAS unsigned char* vb = (LAS unsigned char*)(lds) + NSA_VB + buf * 9216;
    const int lane_ = (int)threadIdx.x & 63, j16 = lane_ & 15, db = (lane_ >> 4) & 1;
#pragma unroll
    for (int half = 0; half < 2; ++half)
#pragma unroll
        for (int s2 = 0; s2 < 2; ++s2) {
            const bf16x8 pf = pack8(half ? p1 : p0, s2);
#pragma unroll
            for (int dh = 0; dh < 2; ++dh) { LAS unsigned char* vp = vb + (32 * half + 16 * s2 + 4 * hh + (j16 >> 2)) * 144 + (32 * dh + 16 * db) * 2 + 8 * (j16 & 3);
                const s16x4v lo = trread(vp), hi = trread(vp + 8 * 144);
                const u32x2 l2 = __builtin_bit_cast(u32x2, lo), h2 = __builtin_bit_cast(u32x2, hi); u32x4 vw = {l2.x, l2.y, h2.x, h2.y};
                o[dh] = mfma32(__builtin_bit_cast(bf16x8, vw), pf, o[dh]); }
        }
}
constexpr float MINIT = -1e20f, RESC_THR = 8.f;
DI float max3f(float a, float b, float c) { float r; asm("v_max3_f32 %0, %1, %2, %3" : "=v"(r) : "v"(a), "v"(b), "v"(c)); return r; }
DI void online_update(f32x16& s0, f32x16& s1, float& mrun, float& lrun, f32x16 (&o)[2], bool live = true) {
    float mt = max3f(s0[0], s1[0], s0[1]);
#pragma unroll
    for (int i = 2; i < 16; i += 2) mt = max3f(mt, s0[i], s0[i + 1]);
#pragma unroll
    for (int i = 1; i < 15; i += 2) mt = max3f(mt, s1[i], s1[i + 1]);
    mt = max3f(mt, s1[15], s1[15]);
    mt = live ? mt : NEGBIG;
    mt = swap32_max(mt);
    if (__any(mt > mrun + RESC_THR)) {
        const float mnew = fmaxf(mrun, mt); const float alpha = __builtin_amdgcn_exp2f(mrun - mnew);
        lrun *= alpha; mrun = mnew;
#pragma unroll
        for (int i = 0; i < 16; ++i) { o[0][i] *= alpha; o[1][i] *= alpha; }
    }
    float ps0 = 0.f, ps1 = 0.f; const float msub = live ? mrun : 1e30f;
#pragma unroll
    for (int i = 0; i < 16; ++i) { s0[i] = __builtin_amdgcn_exp2f(s0[i] - msub); s1[i] = __builtin_amdgcn_exp2f(s1[i] - msub); ps0 += s0[i]; ps1 += s1[i]; }
    lrun += swap32_sum(ps0 + ps1);
}

template <int VAR> DI void nsa_worker(Frame& F) {
    unsigned char* lds = F.lds;
    float* PSUM = (float*)(lds + NSA_PSUM); float* IMP = (float*)(lds + NSA_IMP); unsigned* SEL = (unsigned*)(lds + NSA_SEL); unsigned* UNI = (unsigned*)(lds + NSA_UNI);
    int* ITEM = (int*)(lds + NSA_ITEM); float* BT = (float*)(lds + NSA_BT);
    const bf16_t* PQ = (const bf16_t*)(F.ws + WS_PQ); const bf16_t* PKV = (const bf16_t*)(F.ws + WS_PKV);
    const bf16_t* KC = (const bf16_t*)(F.ws + WS_KC); const bf16_t* VCT = (const bf16_t*)(F.ws + WS_VCT);
    const float* GATES = (const float*)(F.ws + WS_GATES); bf16_t* OB = (bf16_t*)((char*)F.out + DO_OAB) + 1024;
    unsigned* ctr = (unsigned*)(F.ws + WS_CTL) + 64;
    { int t0_ = (int)threadIdx.x; asm volatile("" : "+v"(t0_));
      for (int i = t0_; i < 2048; i += NTHREADS) BT[i] = ((const float*)(F.ws + WS_BIAS))[i] * LOG2E;
      for (int i = t0_; i < 4 * 196; i += NTHREADS) { const int sft = i / 196, w = i - sft * 196; ((float*)(lds + NSA_WED + sft * WED_STRIDE))[w] = (w + sft > 63) ? 0.f : NEGBIG; }
      if (t0_ < 64) ((float*)(lds + NSA_QG))[t0_] = F.in[24][t0_] * (0.125f * LOG2E); }
    int g_tab = -1;
    const int hg = F.wave >> 1, th = F.wave & 1;
    const int myx = (int)((unsigned)__builtin_amdgcn_s_getreg((3 << 11) | 20) & 7u); int qsel = 0;
    unsigned pv = 0u; int pq = 0;
    if (((int)threadIdx.x) == 0) { pq = myx & 7; pv = atomicAdd(ctr + 16 * pq, 1u); }
    for (;;) {
        lds_barrier();
        if (F.wave == 0) { int it = -1;
            const unsigned pv0 = (unsigned)__builtin_amdgcn_readfirstlane((int)pv); const int pq0 = __builtin_amdgcn_readfirstlane(pq);
            if (pv0 < 128u) it = (int)pv0 * 8 + pq0;
            else {
                const int lane_ = (int)threadIdx.x & 63; qsel = 8;
                for (;;) {
                    const unsigned cv = (lane_ < 8) ? __hip_atomic_load(ctr + 16 * ((myx + lane_) & 7), __ATOMIC_RELAXED, __HIP_MEMORY_SCOPE_AGENT) : 128u;
                    const unsigned long long m = __ballot(cv < 128u);
                    if (m == 0ull) break;
                    const int l = __builtin_ctzll(m), qx = (myx + l) & 7;
                    unsigned v = 0u; if (lane_ == 0) v = atomicAdd(ctr + 16 * qx, 1u);
                    v = (unsigned)__builtin_amdgcn_readfirstlane((int)v);
                    if (v < 128u) { it = (int)v * 8 + qx; qsel = l; break; }
                }
            }
            if (((int)threadIdx.x) == 0) *ITEM = it; }
        lds_barrier();
        const int item0 = *ITEM; if (item0 < 0) break;
        const int item = ((item0 >> 3) << 3) | (item0 & 7);
        int tidl = threadIdx.x; asm volatile("" : "+v"(tidl));
        const int r = tidl & 31, hh = (tidl >> 5) & 1, tl = 32 * th + r;
        const int qidx = item >> 3, qx_ = item & 7; const int qt = 31 - (qidx >> 2), bg = 8 * (qidx & 3) + qx_, b = bg >> 2, g = bg & 3, t0 = 64 * qt, cur = qt;
        const int hq = 4 * g + hg, t = t0 + tl; const size_t row = (size_t)b * T + t;
        const unsigned char* qr = lds + NSA_Q + tidl * 16;
        bf16x8 q4[4]; TileRegs c0, c1;
#pragma unroll
        for (int d0 = 0; d0 < 4; ++d0) q4[d0] = *(const bf16x8*)(PQ + row * 1024 + hq * 64 + 16 * d0 + 8 * hh);
        { const bf16_t* Kp = KC + ((size_t)b * 128 * 4 + g) * 64; const bf16_t* Vp = VCT + ((size_t)b * 128 * 4 + g) * 64;
          tile_fetch(c0, Kp, 256, Vp, 256, tidl); tile_fetch(c1, Kp + (size_t)64 * 256, 256, Vp + (size_t)64 * 256, 256, tidl); }
        const float gate_c = GATES[row * 48 + hq * 3], gate_s = GATES[row * 48 + hq * 3 + 1], gate_w = GATES[row * 48 + hq * 3 + 2];
        const float* bt = BT + hq * 128;
        if (g != g_tab) { g_tab = g;
#pragma unroll
            for (int k = 0; k < 8; ++k) { const int c = (tidl >> 8) + 2 * k, w = tidl & 255, rel = 191 - (w + (c & 3));
                ((float*)(lds + NSA_EXT + c * EXT_STRIDE))[w] = (rel < 0) ? NEGBIG : BT[(4 * g + (c >> 2)) * 128 + min(rel, 127)]; } }
        const int yb0 = 191 - tl + 4 * hh;
        const unsigned char* tp0 = lds + NSA_EXT + (hg * 4 + (yb0 & 3)) * EXT_STRIDE + (yb0 & ~3) * 4;
        const unsigned char* tpw = lds + NSA_WED + (yb0 & 3) * WED_STRIDE + ((yb0 - 128) & ~3) * 4;
        f32x16 oacc[2];
#pragma unroll
        for (int i = 0; i < 16; ++i) { oacc[0][i] = 0.f; oacc[1][i] = 0.f; }
        TileRegs tr;
        {
            {
                float ss = 0.f; f32x4 qa[4][2];
#pragma unroll
                for (int d0 = 0; d0 < 4; ++d0) { const u32x4 w = __builtin_bit_cast(u32x4, q4[d0]);
                    qa[d0][0] = (f32x4){lo16(w.x), hi16(w.x), lo16(w.y), hi16(w.y)}; qa[d0][1] = (f32x4){lo16(w.z), hi16(w.z), lo16(w.w), hi16(w.w)};
#pragma unroll
                    for (int e = 0; e < 4; ++e) ss += qa[d0][0][e] * qa[d0][0][e] + qa[d0][1][e] * qa[d0][1][e]; }
                ss = swap32_sum(ss);
                const float rstd = rsqrtf(ss * (1.f / 64.f) + NORM_EPS);
#pragma unroll
                for (int d0 = 0; d0 < 4; ++d0) { const float* gp = (const float*)(lds + NSA_QG) + 16 * d0 + 8 * hh; const f32x4 g0 = *(const f32x4*)gp, g1 = *(const f32x4*)(gp + 4);
                    const f32x4 a = qa[d0][0] * rstd * g0, b = qa[d0][1] * rstd * g1;
                    u32x4 w; w.x = pk2(a[0], a[1]); w.y = pk2(a[2], a[3]); w.z = pk2(b[0], b[1]); w.w = pk2(b[2], b[3]); q4[d0] = __builtin_bit_cast(bf16x8, w); }
            }
#pragma unroll
            for (int d0 = 0; d0 < 4; ++d0) *(bf16x8*)(lds + NSA_Q + d0 * 8192 + tidl * 16) = q4[d0];
            tile_commit(c0, lds, 0, tidl); tile_commit(c1, lds, 1, tidl);
            lds_barrier();
            tile_fetch(tr, PKV + (size_t)b * T * 1536 + 2 * 256 + g * 64, 1536, PKV + (size_t)b * T * 1536 + 3 * 256 + g * 64, 1536, tidl);
            f32x16 sc[2][2];
            tile_scores(sc[0][0], sc[0][1], lds, 0, qr, r, hh); __builtin_amdgcn_sched_barrier(0); tile_scores(sc[1][0], sc[1][1], lds, 1, qr, r, hh); __builtin_amdgcn_sched_barrier(0);
            const int nmax = (t >= 31) ? ((t - 31) >> 4) : -1;
            float mx = NEGBIG;
            const int tmin_w = t0 + 32 * th;
#define CMP_MASK(S_, NB_) do { \
                if (16 * (NB_) + 31 > tmin_w + 31) { _Pragma("unroll") for (int i = 0; i < 16; ++i) S_[i] = NEGBIG; }                                     \
                else if (16 * ((NB_) + 31) + 31 + 128 <= tmin_w) { _Pragma("unroll") for (int i = 0; i < 16; ++i) mx = fmaxf(mx, S_[i]); }               \
                else { _Pragma("unroll") for (int i = 0; i < 16; ++i) { const int n = (NB_) + crow(i, hh); const int rel = t - 16 * n - 31; float s = S_[i]; \
                    const float bv = bt[min(max(rel, 0), 127)]; if (n <= nmax) { s += bv; mx = fmaxf(mx, s); } else s = NEGBIG; S_[i] = s; } } \
                __builtin_amdgcn_sched_barrier(0); } while (0)
            CMP_MASK(sc[0][0], 0); CMP_MASK(sc[0][1], 32); CMP_MASK(sc[1][0], 64); CMP_MASK(sc[1][1], 96);
#undef CMP_MASK
            mx = swap32_max(mx);
            float ps = 0.f;
#pragma unroll
            for (int kt = 0; kt < 2; ++kt)
#pragma unroll
                for (int half = 0; half < 2; ++half)
#pragma unroll
                    for (int i = 0; i < 16; ++i) { const float s = sc[kt][half][i]; const float p = (s > -1e29f) ? __builtin_amdgcn_exp2f(s - mx) : 0.f; sc[kt][half][i] = p; ps += p; }
            ps = swap32_sum(ps);
            const float inv = (ps > 0.f) ? 1.f / ps : 0.f;
#pragma unroll
            for (int kt = 0; kt < 2; ++kt)
#pragma unroll
                for (int half = 0; half < 2; ++half)
#pragma unroll
                    for (int i = 0; i < 16; ++i) sc[kt][half][i] *= inv;
            if (cur >= 8) {
                if (hg == 0) {
#pragma unroll
                    for (int kt = 0; kt < 2; ++kt)
#pragma unroll
                        for (int half = 0; half < 2; ++half) { float* pb = PSUM + tl * 132 + 64 * kt + 32 * half + 4 * hh;
#pragma unroll
                            for (int q = 0; q < 4; ++q) *(f32x4*)(pb + 8 * q) = (f32x4){sc[kt][half][4 * q], sc[kt][half][4 * q + 1], sc[kt][half][4 * q + 2], sc[kt][half][4 * q + 3]}; }
                }
                lds_barrier();
#pragma unroll 1
                for (int hgi = 1; hgi < 4; ++hgi) {
                    if (hg == hgi) {
#pragma unroll
                        for (int kt = 0; kt < 2; ++kt)
#pragma unroll
                            for (int half = 0; half < 2; ++half) { float* pb = PSUM + tl * 132 + 64 * kt + 32 * half + 4 * hh; f32x4 old[4];
#pragma unroll
                                for (int q = 0; q < 4; ++q) old[q] = *(const f32x4*)(pb + 8 * q);
#pragma unroll
                                for (int q = 0; q < 4; ++q) *(f32x4*)(pb + 8 * q) = old[q] + (f32x4){sc[kt][half][4 * q], sc[kt][half][4 * q + 1], sc[kt][half][4 * q + 2], sc[kt][half][4 * q + 3]}; }
                    }
                    lds_barrier();
                }
            }
#pragma unroll
            for (int kt = 0; kt < 2; ++kt)
#pragma unroll
                for (int half = 0; half < 2; ++half)
#pragma unroll
                    for (int i = 0; i < 16; ++i) sc[kt][half][i] *= gate_c;
            tile_pv(oacc, sc[0][0], sc[0][1], lds, 0, r, hh); __builtin_amdgcn_sched_barrier(0); tile_pv(oacc, sc[1][0], sc[1][1], lds, 1, r, hh); __builtin_amdgcn_sched_barrier(0);
            if (cur >= 8) {
#pragma unroll
                for (int i = 0; i < 4; ++i) { const int tok = tidl >> 3, j = (tidl & 7) + 8 * i; const float* pp = PSUM + tok * 132 + 4 * j;
                    float v = pp[0] + pp[1] + pp[2] + 0.5f * pp[3]; if (j > 0) v += 0.5f * pp[-1];
                    IMP[tok * 33 + j] = v; }
                lds_barrier();
                if (F.wave == 0) {
                    const int tok = tidl & 63; float scv[32];
#pragma unroll
                    for (int j = 0; j < 32; ++j) { const bool forced = (j == 0) || (j == cur) || (j == cur - 1); scv[j] = forced ? 1e4f : ((j <= cur) ? IMP[tok * 33 + j] : -1.f); }
                    unsigned msk = 1u | (1u << cur) | (1u << (cur - 1));
#pragma unroll 1
                    for (int k = 0; k < 5; ++k) { float best = -3e38f; int bi = 0;
#pragma unroll
                        for (int j = 0; j < 32; ++j) { const bool tk = ((msk >> j) & 1u) == 0u && scv[j] > best; best = tk ? scv[j] : best; bi = tk ? j : bi; }
                        msk |= 1u << bi; }
                    msk &= (cur >= 31) ? 0xffffffffu : ((1u << (cur + 1)) - 1u);
                    SEL[tok] = msk;
                    unsigned um = msk;
#pragma unroll
                    for (int o = 1; o < 64; o <<= 1) um |= (unsigned)__shfl_xor((int)um, o);
                    if ((tidl & 63) == 0) *UNI = um;
                }
            } else {
                if (tidl < 64) SEL[tidl] = (1u << (cur + 1)) - 1u;
                if (tidl == 0) *UNI = (1u << (cur + 1)) - 1u;
            }
            lds_barrier();
        }
        bf16x8 qreg[4];
#pragma unroll
        for (int d0 = 0; d0 < 4; ++d0) qreg[d0] = *(const bf16x8*)(qr + d0 * 8192);
        {
            const unsigned uni = *UNI, mysel = SEL[tl];
            const bf16_t* Kb = PKV + (size_t)b * T * 1536 + 2 * 256 + g * 64; const bf16_t* Vb = PKV + (size_t)b * T * 1536 + 3 * 256 + g * 64;
            float mrun = MINIT, lrun = 0.f; f32x16 o[2];
#pragma unroll
            for (int i = 0; i < 16; ++i) { o[0][i] = 0.f; o[1][i] = 0.f; }
            unsigned rem = uni; int j = 0; rem &= rem - 1u; int buf = 0;
            const bf16_t* Kbw = PKV + (size_t)b * T * 1536 + 4 * 256 + g * 64; const bf16_t* Vbw = PKV + (size_t)b * T * 1536 + 5 * 256 + g * 64; const int jw0 = (cur >= 8) ? cur - 8 : 0;
            for (;;) {
                tile_commit(tr, lds, buf, tidl);
                lds_barrier();
                const int jn = rem ? __builtin_ctz(rem) : -1; rem &= rem - 1u;
                if (jn >= 0) tile_fetch(tr, Kb + (size_t)64 * jn * 1536, 1536, Vb + (size_t)64 * jn * 1536, 1536, tidl);
                else tile_fetch(tr, Kbw + (size_t)64 * jw0 * 1536, 1536, Vbw + (size_t)64 * jw0 * 1536, 1536, tidl);
                f32x16 s0, s1;
                const bool selb = (mysel >> j) & 1u;
                if (VAR <= 1) tile_scores_q(s0, s1, lds, buf, qreg, r, hh); else { s0 = o[0]; s1 = o[1]; }
                if (VAR == 0 && j >= cur - 2) add_ext(s0, s1, tp0 - 256 * (cur - j));
                if (VAR == 0) online_update(s0, s1, mrun, lrun, o, selb);
                if (VAR <= 1) tile_pv(o, s0, s1, lds, buf, r, hh);
                if (jn < 0) break;
                j = jn; buf ^= 1;
            }
            const float sc_ = gate_s / lrun;
#pragma unroll
            for (int i = 0; i < 16; ++i) { oacc[0][i] += sc_ * o[0][i]; oacc[1][i] += sc_ * o[1][i]; }
            lds_barrier();
        }
        if (((int)threadIdx.x) == 0 && qsel < 8) { pq = (myx + qsel) & 7; pv = atomicAdd(ctr + 16 * pq, 1u); }
        {
            const bf16_t* Kb = PKV + (size_t)b * T * 1536 + 4 * 256 + g * 64; const bf16_t* Vb = PKV + (size_t)b * T * 1536 + 5 * 256 + g * 64;
            float mrun = MINIT, lrun = 0.f; f32x16 o[2];
#pragma unroll
            for (int i = 0; i < 16; ++i) { o[0][i] = 0.f; o[1][i] = 0.f; }
            int j = (cur >= 8) ? cur - 8 : 0, buf = 0;
            for (;;) {
                tile_commit(tr, lds, buf, tidl);
                lds_barrier();
                const int jn = (j < cur) ? j + 1 : -1;
                if (jn >= 0) tile_fetch(tr, Kb + (size_t)64 * jn * 1536, 1536, Vb + (size_t)64 * jn * 1536, 1536, tidl);
                f32x16 s0, s1;
                if (VAR <= 1) tile_scores_q(s0, s1, lds, buf, qreg, r, hh); else { s0 = o[0]; s1 = o[1]; }
                if (VAR == 0 && (j >= cur - 2 || j == cur - 8)) add_ext(s0, s1, (j >= cur - 2) ? tp0 - 256 * (cur - j) : tpw);
                if (VAR == 0) online_update(s0, s1, mrun, lrun, o);
                if (VAR <= 1) tile_pv(o, s0, s1, lds, buf, r, hh);
                if (jn < 0) break;
                j = jn; buf ^= 1;
            }
            const float sc_ = gate_w / lrun;
#pragma unroll
            for (int i = 0; i < 16; ++i) { oacc[0][i] += sc_ * o[0][i]; oacc[1][i] += sc_ * o[1][i]; }
        }
        bf16_t* op = OB + row * 2048 + hq * 64;
        if (VAR != 0) { if (oacc[0][0] + oacc[1][5] == 123.456f) op[0] = 0; continue; }
#pragma unroll
        for (int dh = 0; dh < 2; ++dh)
#pragma unroll
            for (int gq = 0; gq < 4; ++gq) { u32x2 w; w.x = pk2(oacc[dh][4 * gq], oacc[dh][4 * gq + 1]); w.y = pk2(oacc[dh][4 * gq + 2], oacc[dh][4 * gq + 3]);
                *(u32x2*)(op + 32 * dh + 8 * gq + 4 * hh) = w; }
    }
}


#define XB_TMO      128
#define XB_XCNT(j)  (256  + 64 * (j))
#define XB_XSUB(j)  (1280 + 64 * (j))
#define XB_XGEN(j)  (2304 + 64 * (j))
#define XB_TOP      3328
#define XB_TOPGEN   3392
#define XCD_BAR_WORDS 3456
#define XB_SPIN_CAP (1u << 22)
DI unsigned xb_ld(unsigned* p)              { return __hip_atomic_load(p, __ATOMIC_RELAXED, __HIP_MEMORY_SCOPE_AGENT); }
DI unsigned xb_add(unsigned* p, unsigned v) { return __hip_atomic_fetch_add(p, v, __ATOMIC_RELAXED, __HIP_MEMORY_SCOPE_AGENT); }
DI unsigned xb_xcc_id() { return (unsigned)__builtin_amdgcn_s_getreg((3 << 11) | 20) & 0xFu; }
#define XB_SPIN(cond, bar) do { unsigned _sp = 0; while (cond) { __builtin_amdgcn_s_sleep(1); \
    if ((++_sp & 255u) == 0u) { if (xb_ld(&(bar)[XB_TMO])) break; if (_sp > XB_SPIN_CAP) { atomicAdd(&(bar)[XB_TMO], 1u); break; } } } } while (0)
struct XcdBarrier { unsigned* bar; unsigned x; volatile LAS unsigned* st; };
DI XcdBarrier xcd_barrier_post(unsigned* bar, volatile LAS unsigned* st) {
    XcdBarrier b; b.bar = bar; b.x = xb_xcc_id(); b.st = st;
    if (threadIdx.x == 0) (void)xb_add(&bar[XB_XCNT(b.x)], 1u);
    return b;
}
DI void xcd_barrier_complete(unsigned* bar, unsigned x, unsigned& nloc, unsigned& nx) {
    const unsigned G = gridDim.x * gridDim.y * gridDim.z;
    unsigned sum, cnt, mine, sp = 0u;
    for (;;) {
        sum = 0u; cnt = 0u; mine = 0u;
#pragma unroll
        for (unsigned j = 0; j < 16; ++j) { const unsigned c = xb_ld(&bar[XB_XCNT(j)]); sum += c; cnt += (c > 0u) ? 1u : 0u; mine = (j == x) ? c : mine; }
        if (sum == G) break;
        __builtin_amdgcn_s_sleep(1);
        if ((++sp & 255u) == 0u) { if (xb_ld(&bar[XB_TMO])) break; if (sp > XB_SPIN_CAP) { atomicAdd(&bar[XB_TMO], 1u); break; } }
    }
    nloc = mine > 0u ? mine : 1u; nx = cnt > 0u ? cnt : 1u;
}
DI void xcd_barrier(const XcdBarrier& b) {
    asm volatile("s_waitcnt vmcnt(0)" ::: "memory");
    __syncthreads();
    if (threadIdx.x == 0) {
        unsigned* bar = b.bar;
        __builtin_amdgcn_s_waitcnt(0);
        unsigned nloc = b.st[0], nx = b.st[1];
        if (nloc == 0u) { xcd_barrier_complete(bar, b.x, nloc, nx); b.st[0] = nloc; b.st[1] = nx; }
        const unsigned old = xb_add(&bar[XB_XSUB(b.x)], 1u);
        const unsigned gen = old / nloc;
        if (old + 1u == (gen + 1u) * nloc) {
            __builtin_amdgcn_fence(__ATOMIC_RELEASE, "agent");
            asm volatile("s_waitcnt vmcnt(0)" ::: "memory");
            const unsigned og = xb_add(&bar[XB_TOP], 1u);
            const unsigned tg = og / nx;
            if (og + 1u == (tg + 1u) * nx) xb_add(&bar[XB_TOPGEN], 1u);
            else XB_SPIN(xb_ld(&bar[XB_TOPGEN]) == tg, bar);
            __builtin_amdgcn_fence(__ATOMIC_ACQUIRE, "agent");
            xb_add(&bar[XB_XGEN(b.x)], 1u);
            asm volatile("s_waitcnt vmcnt(0)" ::: "memory");
        } else {
            XB_SPIN(xb_ld(&bar[XB_XGEN(b.x)]) == gen, bar);
            __builtin_amdgcn_fence(__ATOMIC_ACQUIRE, "agent");
            asm volatile("s_waitcnt vmcnt(0)" ::: "memory");
        }
    }
    __syncthreads();
}

constexpr int N_LAUNCHES = MK_N_LAUNCHES, N_PHASES = 9;
constexpr int WGM_C = 4, WGM_F = 4, WGM_G = 4, WGM_H = 4, WGM_I = 4;
__global__ void __launch_bounds__(NTHREADS, 2) hybrid_fwd(Args args) {
    extern __shared__ __attribute__((aligned(16))) unsigned char lds[];
    Frame F;
    F.lds = lds; F.lds3 = (LAS unsigned char*)lds;
    F.tid = threadIdx.x; F.lane = F.tid & 63; F.wave = __builtin_amdgcn_readfirstlane(F.tid >> 6);
    F.G = gridDim.x; F.blk = blockIdx.x; F.gw = F.blk * 8 + F.wave; F.NGW = F.G * 8;
    F.in = args.in; F.out = args.out; F.ws = args.ws;
    volatile LAS unsigned* bst = (volatile LAS unsigned*)(F.lds3 + LDS_BYTES - 16);
    if (F.tid < 2) bst[F.tid] = 0u;
    __syncthreads();
    XcdBarrier bar = xcd_barrier_post((unsigned*)(args.ws + WS_CTL) + 1024, bst);
    const int lo = args.ph_lo, hi = args.ph_hi;
#ifndef PH_MASK
#define PH_MASK 0x1ff
#endif
#ifndef REP_MASK
#define REP_MASK 0
#endif
#define REP(k) ((REP_MASK >> (k)) & 1)
#define IN(k) (((PH_MASK >> (k)) & 1) && lo <= (k) && (k) < hi)
#define SEAM(k) do { if (IN(k) && IN((k) + 1)) { xcd_barrier(bar); } } while (0)
    unsigned char* ws = args.ws;
#ifdef CLKP
    unsigned long long ck0 = 0, rt0 = 0, ck1 = 0, rt1 = 0;
#define CLK0(k) do { if (CLKP == (k)) { ck0 = __builtin_amdgcn_s_memtime(); rt0 = __builtin_amdgcn_s_memrealtime(); } } while (0)
#define CLK1(k) do { if (CLKP == (k)) { ck1 = __builtin_amdgcn_s_memtime(); rt1 = __builtin_amdgcn_s_memrealtime(); } } while (0)
#else
#define CLK0(k)
#define CLK1(k)
#endif
    if (IN(0)) { CLK0(0); phase_a(F, true); if (REP(0)) { __syncthreads(); phase_a(F, false); } CLK1(0); }
    if (IN(1)) { CLK0(1); phase_b(F); if (REP(1)) { __syncthreads(); phase_b(F); } CLK1(1); } SEAM(1);
    if (IN(2)) { CLK0(2);
        pg8::Gemm g; g.A0 = g.A1 = (const bf16_t*)(ws + WS_H); g.B0 = g.B1 = (const bf16_t*)(ws + WS_WIN); g.K = D;
        pg8::StaticOrder S; S.init(M, NCOLS, F.G, F.blk, 1, WGM_C);
        EpiInProj E{ws};
        pg8::gemm_phase<EpiInProj, true, true>(F.lds3, g, S, E);
        if (REP(2)) { EpiInProjT<(REP_MASK >> 16) & 3> E2{ws}; if (REP_MASK & 0x100000) S.init(M, NCOLS, F.G, F.blk, 1, -1); pg8::gemm_phase<EpiInProjT<(REP_MASK >> 16) & 3>, true, true>(F.lds3, g, S, E2); }
    CLK1(2); } SEAM(2);
    if (IN(3)) { CLK0(3); phase_d<0>(F); if (REP(3)) { __syncthreads(); phase_d<((REP_MASK >> 16) & 3) ? ((REP_MASK >> 16) & 3) : 1, (REP_MASK >> 18) & 3>(F); } CLK1(3); } SEAM(3);
    if (IN(4)) { CLK0(4);
        const int nscan = (F.G >= 256) ? 128 : F.G / 2;
#ifndef NO_SCAN
        if (F.blk < nscan) { for (int hd = F.blk; hd < BATCH * RH; hd += nscan) rwkv_head(F, hd); }
#endif
#ifndef NO_NSA
        nsa_worker<0>(F);
#endif
        if (REP(4)) {
            xcd_barrier(bar); if (F.blk == 0 && F.tid < 8) __hip_atomic_store((unsigned*)(ws + WS_CTL) + 64 + 16 * F.tid, 0u, __ATOMIC_RELAXED, __HIP_MEMORY_SCOPE_AGENT); xcd_barrier(bar);
            if (REP_MASK & 0x1000) { if (F.blk < nscan) { for (int hd = F.blk; hd < BATCH * RH; hd += nscan) rwkv_head(F, hd); } }
            if (REP_MASK & 0x2000) { nsa_worker<(REP_MASK >> 16) & 3>(F); }
        }
    CLK1(4); } SEAM(4);
    if (IN(5)) { CLK0(5);
        pg8::Gemm g; g.A0 = g.A1 = (const bf16_t*)((const char*)args.out + DO_OAB); g.B0 = g.B1 = (const bf16_t*)(ws + WS_WOA); g.K = D;
        pg8::StaticOrder S; S.init(M, D, F.G, F.blk, 1, WGM_F);
        EpiMerge E{(const bf16_t*)(ws + WS_PMG), (bf16_t*)(ws + WS_MIXED)};
        pg8::gemm_phase<EpiMerge, true, true>(F.lds3, g, S, E);
        if (REP(5)) { if ((REP_MASK >> 16) & 3) { EpiInProjT<2> E2{ws}; pg8::gemm_phase<EpiInProjT<2>, true, true>(F.lds3, g, S, E2); } else pg8::gemm_phase<EpiMerge, true, true>(F.lds3, g, S, E); }
    CLK1(5); } SEAM(5);
    if (IN(6)) { CLK0(6);
        pg8::Gemm g; g.A0 = g.A1 = (const bf16_t*)(ws + WS_MIXED); g.B0 = g.B1 = (const bf16_t*)(ws + WS_WOUT); g.K = D;
        pg8::StaticOrder S; S.init(M, D, F.G, F.blk, 1, WGM_G);
        EpiWout E{args.in[0], (const float*)(ws + WS_MOD), (const float*)(ws + WS_M2V), args.out, (bf16_t*)(ws + WS_X1M), (float*)(ws + WS_SUMSQ)};
        pg8::gemm_phase<EpiWout, true, true>(F.lds3, g, S, E);
    CLK1(6); } SEAM(6);
    if (IN(7)) { CLK0(7);
        pg8::Gemm g; g.A0 = g.A1 = (const bf16_t*)(ws + WS_X1M); g.B0 = g.B1 = (const bf16_t*)(ws + WS_WUP); g.K = D;
        pg8::StaticOrder S; S.init(M, DFF, F.G, F.blk, 1, WGM_H);
        EpiUp E{(const float*)(ws + WS_SUMSQ), (const float*)(ws + WS_C2), (bf16_t*)(ws + WS_U)};
        pg8::gemm_phase<EpiUp, true, true>(F.lds3, g, S, E);
        if (REP(7)) pg8::gemm_phase<EpiUp, true, true>(F.lds3, g, S, E);
    CLK1(7); } SEAM(7);
    if (IN(8)) { CLK0(8);
        pg8::Gemm g; g.A0 = g.A1 = (const bf16_t*)(ws + WS_U); g.B0 = g.B1 = (const bf16_t*)(ws + WS_WDOWN); g.K = DFF;
        pg8::StaticOrder S; S.init(M, D, F.G, F.blk, 1, WGM_I);
        EpiDown E{(const float*)(ws + WS_MOD), args.out};
        pg8::gemm_phase<EpiDown, true, true>(F.lds3, g, S, E);
        CLK1(8);
    }
#ifdef CLKP
    if (F.blk == 0) { const float mhz = (float)(ck1 - ck0) * 100.f / (float)(rt1 - rt0); const unsigned long long t = __builtin_amdgcn_s_memrealtime(), dl = (unsigned long long)(mhz * 100.f);
        while (__builtin_amdgcn_s_memrealtime() - t < dl) __builtin_amdgcn_s_sleep(20); }
#endif
#undef IN
#undef SEAM
}

extern "C" void kernel_launch(void* const* d_in, const int* in_sizes, int n_in, void* d_out, int out_size, void* d_ws, size_t ws_size, hipStream_t stream) {
    static int grid = 0;
    if (grid == 0) {
        if (n_in != 32 || in_sizes[0] != M * D || out_size != M * D || ws_size < WS_END) {
            fprintf(stderr, "kernel_launch: unexpected shapes (n_in %d, in0 %d, out %d, ws %zu); nothing launched\n", n_in, n_in > 0 ? in_sizes[0] : -1, out_size, ws_size); grid = -1; return; }
        int dev = 0, cus = 0, per_cu = 0;
        if (hipGetDevice(&dev) != hipSuccess || hipDeviceGetAttribute(&cus, hipDeviceAttributeMultiprocessorCount, dev) != hipSuccess) { grid = -1; return; }
        if (hipFuncSetAttribute((const void*)hybrid_fwd, hipFuncAttributeMaxDynamicSharedMemorySize, LDS_BYTES) != hipSuccess) { fprintf(stderr, "kernel_launch: hipFuncSetAttribute failed\n"); grid = -1; return; }
        if (hipOccupancyMaxActiveBlocksPerMultiprocessor(&per_cu, (const void*)hybrid_fwd, NTHREADS, LDS_BYTES) != hipSuccess || per_cu < 1) { fprintf(stderr, "kernel_launch: occupancy query gives %d blocks per CU; nothing launched\n", per_cu); per_cu = 0; }
        (void)hipGetLastError();
        if (per_cu < 1) { grid = -1; return; }
        grid = cus;
        if (grid > 256) grid = 256;
    }
    if (grid < 0) return;
    if (hipMemsetAsync((char*)d_ws + WS_CTL, 0, CTL_ZERO_BYTES, stream) != hipSuccess) { fprintf(stderr, "kernel_launch: memset failed\n"); return; }
    Args a{};
    for (int i = 0; i < 32; ++i) a.in[i] = (const float*)d_in[i];
    a.out = (float*)d_out; a.ws = (unsigned char*)d_ws;
    if (N_LAUNCHES == 1) {
        a.ph_lo = 0; a.ph_hi = N_PHASES;
        hipLaunchKernelGGL(hybrid_fwd, dim3(grid), dim3(NTHREADS), LDS_BYTES, stream, a);
        const hipError_t e = hipPeekAtLastError();
        if (e != hipSuccess) fprintf(stderr, "kernel_launch: launch failed: %s (grid %d)\n", hipGetErrorString(e), grid);
    } else {
        for (int p = 0; p < N_PHASES; ++p) { a.ph_lo = p; a.ph_hi = p + 1; hipLaunchKernelGGL(hybrid_fwd, dim3(grid), dim3(NTHREADS), LDS_BYTES, stream, a); }
    }
}
```
